# Optimizing an MI355X kernel written in HIP

```python
import jax, jax.numpy as jnp
from jax import lax
import numpy as np

D_MODEL = 4096
BATCH = 4
SEQ = 4096
DEPTH = 1
DEC_BATCH = 2
DEC_SEQ = 8192
PAST_LEN = 128

HEAD_DIM = 128
MIX_W = D_MODEL
RET_HEADS = (MIX_W // 2) // HEAD_DIM
ATT_HEADS = (MIX_W // 2) // HEAD_DIM
ATT_KV_HEADS = ATT_HEADS // 4
RET_W = RET_HEADS * HEAD_DIM
ATT_Q_W = ATT_HEADS * HEAD_DIM
ATT_KV_W = ATT_KV_HEADS * HEAD_DIM
IN_W = 4 * RET_W + ATT_Q_W + 2 * ATT_KV_W
RET_CHUNK = 128
WINDOW = 128
BLOCK = 128
N_BUCKETS = 32
MAX_DISTANCE = 128
MEM_TOKENS = 256
MEM_HEADS = 4
MEM_W = MEM_HEADS * HEAD_DIM
D_FF = 4 * D_MODEL
ROPE_BASE = 10000.0
RMS_EPS = 1e-6
NEG_INF = -1e30

kernel_name = "hymba_retention_swa_t5bias_encoder"


def rmsnorm(x, g):
    xf = x.astype(jnp.float32)
    var = jnp.mean(xf * xf, axis=-1, keepdims=True)
    return (xf * lax.rsqrt(var + RMS_EPS) * g.astype(jnp.float32)).astype(x.dtype)


def head_rmsnorm(y):
    yf = y.astype(jnp.float32)
    var = jnp.mean(yf * yf, axis=-1, keepdims=True)
    return (yf * lax.rsqrt(var + RMS_EPS)).astype(y.dtype)


def rope(x, pos):
    half = x.shape[-1] // 2
    inv = ROPE_BASE ** (-jnp.arange(half, dtype=jnp.float32) / half)
    ang = pos[:, None] * inv[None, :]
    cos = jnp.cos(ang)[None, :, None, :]
    sin = jnp.sin(ang)[None, :, None, :]
    xf = x.astype(jnp.float32)
    x1, x2 = xf[..., :half], xf[..., half:]
    return jnp.concatenate([x1 * cos - x2 * sin, x1 * sin + x2 * cos], axis=-1).astype(x.dtype)


def chunk_retention(q, k, v, log_g, strict):
    b, s, h, d = q.shape
    dt = q.dtype
    nc = s // RET_CHUNK
    qc = q.reshape(b, nc, RET_CHUNK, h, d)
    kc = k.reshape(b, nc, RET_CHUNK, h, d)
    vc = v.reshape(b, nc, RET_CHUNK, h, d)
    pos = np.arange(RET_CHUNK)
    diff = pos[:, None] - pos[None, :]
    mask = (diff > 0) if strict else (diff >= 0)
    decay = jnp.where(mask[None], jnp.exp(log_g[:, None, None] * np.maximum(diff, 0).astype(np.float32)), 0.0).astype(dt)
    att = jnp.einsum('bcihd,bcjhd->bchij', qc, kc) * decay[None, None]
    y_inner = jnp.einsum('bchij,bcjhd->bcihd', att, vc)
    posf = pos.astype(np.float32)
    zeta = jnp.exp(log_g[:, None] * (RET_CHUNK - 1 - posf)[None, :]).astype(dt)
    xi = jnp.exp(log_g[:, None] * (posf + 1.0)[None, :]).astype(dt)
    chunk_decay = jnp.exp(log_g * RET_CHUNK).astype(dt)
    kv = jnp.einsum('bcjhd,hj,bcjhe->bchde', kc, zeta, vc)

    def step(state, kv_c):
        return state * chunk_decay[None, :, None, None] + kv_c, state

    _, r_prev = lax.scan(step, jnp.zeros((b, h, d, d), dt), jnp.moveaxis(kv, 1, 0))
    r_prev = jnp.moveaxis(r_prev, 0, 1)
    y_cross = jnp.einsum('bcihd,hi,bchde->bcihe', qc, xi, r_prev)
    return (y_inner + y_cross).reshape(b, s, h, d)


def t5_buckets(rel):
    nb = N_BUCKETS // 2
    max_exact = nb // 2
    base = np.where(rel > 0, nb, 0)
    n = np.abs(rel)
    large = max_exact + (np.log(np.maximum(n, 1) / max_exact) / np.log(MAX_DISTANCE / max_exact) * (nb - max_exact)).astype(np.int32)
    large = np.minimum(large, nb - 1)
    return (base + np.where(n < max_exact, n, large)).astype(np.int32)


def windowed_gqa(q, k, v, sink, rel_bias):
    b, s, H, d = q.shape
    KV = k.shape[2]
    G = H // KV
    nb = s // BLOCK
    qb = q.reshape(b, nb, BLOCK, KV, G, d)
    pad = ((0, 0), (BLOCK, BLOCK), (0, 0), (0, 0))
    kp = jnp.pad(k, pad).reshape(b, nb + 2, BLOCK, KV, d)
    vp = jnp.pad(v, pad).reshape(b, nb + 2, BLOCK, KV, d)
    kband = jnp.concatenate([kp[:, :-2], kp[:, 1:-1], kp[:, 2:]], axis=2)
    vband = jnp.concatenate([vp[:, :-2], vp[:, 1:-1], vp[:, 2:]], axis=2)
    qi = np.arange(BLOCK)[:, None]
    kj = np.arange(3 * BLOCK)[None, :] - BLOCK
    rel = kj - qi
    in_window = np.abs(rel) <= WINDOW
    bias = rel_bias.astype(jnp.float32)[t5_buckets(rel)]
    bias = jnp.transpose(bias, (2, 0, 1)).reshape(KV, G, BLOCK, 3 * BLOCK)
    key_pos = jnp.arange(nb)[:, None] * BLOCK + kj
    valid = (key_pos >= 0) & (key_pos < s)
    mask = jnp.asarray(in_window)[None] & valid[:, None, :]
    scores = jnp.einsum('bnqkgd,bnjkd->bnkgqj', qb, kband).astype(jnp.float32) * (HEAD_DIM ** -0.5)
    scores = jnp.where(mask[None, :, None, None], scores + bias[None, None], NEG_INF)
    sink_f = sink.astype(jnp.float32).reshape(KV, G)[None, None, :, :, None]
    m = jnp.maximum(jnp.max(scores, axis=-1), sink_f)
    p = jnp.exp(scores - m[..., None])
    denom = jnp.sum(p, axis=-1) + jnp.exp(sink_f - m)
    p = (p / denom[..., None]).astype(v.dtype)
    out = jnp.einsum('bnkgqj,bnjkd->bnqkgd', p, vband)
    return out.reshape(b, s, H * d)


def parallel_mixer(h, w_in, dec_f, dec_b, sink, rel_bias, w_out):
    b, s, _ = h.shape
    proj = h @ w_in
    splits = [RET_W, 2 * RET_W, 3 * RET_W, 4 * RET_W, 4 * RET_W + ATT_Q_W, 4 * RET_W + ATT_Q_W + ATT_KV_W]
    q_r, k_r, v_r, g_r, q_a, k_a, v_a = jnp.split(proj, splits, axis=-1)
    pos = jnp.arange(s, dtype=jnp.float32)
    q_r = rope(q_r.reshape(b, s, RET_HEADS, HEAD_DIM), pos)
    k_r = rope(k_r.reshape(b, s, RET_HEADS, HEAD_DIM), pos) * (HEAD_DIM ** -0.5)
    v_r = v_r.reshape(b, s, RET_HEADS, HEAD_DIM)
    log_gf = -jnp.exp(dec_f.astype(jnp.float32))
    log_gb = -jnp.exp(dec_b.astype(jnp.float32))
    y_f = chunk_retention(q_r, k_r, v_r, log_gf, strict=False)
    y_b = jnp.flip(chunk_retention(jnp.flip(q_r, 1), jnp.flip(k_r, 1), jnp.flip(v_r, 1), log_gb, strict=True), 1)
    y_ret = head_rmsnorm(y_f + y_b) * jax.nn.silu(g_r.reshape(b, s, RET_HEADS, HEAD_DIM))
    y_ret = y_ret.reshape(b, s, RET_W)
    y_att = windowed_gqa(q_a.reshape(b, s, ATT_HEADS, HEAD_DIM),
                         k_a.reshape(b, s, ATT_KV_HEADS, HEAD_DIM),
                         v_a.reshape(b, s, ATT_KV_HEADS, HEAD_DIM), sink, rel_bias)
    return jnp.concatenate([y_ret, y_att], axis=-1) @ w_out


def memory_cross_attention(h, m, w_cq, w_ckv, w_co):
    b, s, _ = h.shape
    M = m.shape[1]
    q = (h @ w_cq).reshape(b, s, MEM_HEADS, HEAD_DIM)
    k, v = jnp.split(m @ w_ckv, 2, axis=-1)
    k = k.reshape(b, M, MEM_HEADS, HEAD_DIM)
    v = v.reshape(b, M, MEM_HEADS, HEAD_DIM)
    sc = jnp.einsum('bshd,bmhd->bhsm', q, k).astype(jnp.float32) * (HEAD_DIM ** -0.5)
    p = jax.nn.softmax(sc, axis=-1).astype(v.dtype)
    o = jnp.einsum('bhsm,bmhd->bshd', p, v).reshape(b, s, MEM_W)
    return o @ w_co


def squared_relu_mlp(h, w1, w2):
    a = jax.nn.relu(h @ w1)
    return (a * a) @ w2


def encode(x, mem, norm_mix, w_in, ret_decay_f, ret_decay_b, attn_sink, rel_bias, w_out,
           norm_cross, norm_mem, w_cq, w_ckv, w_co, norm_mlp, w_mlp_in, w_mlp_out, norm_final):
    for l in range(DEPTH):
        x = x + parallel_mixer(rmsnorm(x, norm_mix[l]), w_in[l], ret_decay_f[l], ret_decay_b[l],
                               attn_sink[l], rel_bias, w_out[l])
        x = x + memory_cross_attention(rmsnorm(x, norm_cross[l]), rmsnorm(mem, norm_mem[l]),
                                       w_cq[l], w_ckv[l], w_co[l])
        x = x + squared_relu_mlp(rmsnorm(x, norm_mlp[l]), w_mlp_in[l], w_mlp_out[l])
    return rmsnorm(x, norm_final)


def setup_inputs(seed: int = 0) -> dict:
    key = jax.random.key(seed)
    ks = jax.random.split(key, 20)
    f32 = jnp.float32

    def nrm(k, shape, fan_in):
        return jax.random.normal(k, shape, f32) * (fan_in ** -0.5)

    def gain(k, shape):
        return 1.0 + 0.01 * jax.random.normal(k, shape, f32)

    base_decay = jnp.log(-jnp.log(1.0 - 2.0 ** (-5.0 - jnp.arange(RET_HEADS, dtype=f32))))
    return {
        "x_prompt": jax.random.normal(ks[0], (BATCH, SEQ, D_MODEL), f32),
        "x_sample": jax.random.normal(ks[1], (DEC_BATCH, DEC_SEQ, D_MODEL), f32),
        "mem_prompt": jax.random.normal(ks[2], (BATCH, MEM_TOKENS, D_MODEL), f32),
        "mem_sample": jax.random.normal(ks[3], (DEC_BATCH, MEM_TOKENS, D_MODEL), f32),
        "norm_mix": gain(ks[4], (DEPTH, D_MODEL)),
        "w_in": nrm(ks[5], (DEPTH, D_MODEL, IN_W), D_MODEL),
        "ret_decay_f": base_decay[None] + 0.01 * jax.random.normal(ks[6], (DEPTH, RET_HEADS), f32),
        "ret_decay_b": base_decay[None] + 0.01 * jax.random.normal(ks[7], (DEPTH, RET_HEADS), f32),
        "attn_sink": 0.5 * jax.random.normal(ks[8], (DEPTH, ATT_HEADS), f32),
        "rel_bias": 0.5 * jax.random.normal(ks[9], (N_BUCKETS, ATT_HEADS), f32),
        "w_out": nrm(ks[10], (DEPTH, MIX_W, D_MODEL), MIX_W),
        "norm_cross": gain(ks[11], (DEPTH, D_MODEL)),
        "norm_mem": gain(ks[12], (DEPTH, D_MODEL)),
        "w_cq": nrm(ks[13], (DEPTH, D_MODEL, MEM_W), D_MODEL),
        "w_ckv": nrm(ks[14], (DEPTH, D_MODEL, 2 * MEM_W), D_MODEL),
        "w_co": nrm(ks[15], (DEPTH, MEM_W, D_MODEL), MEM_W),
        "norm_mlp": gain(ks[16], (DEPTH, D_MODEL)),
        "w_mlp_in": nrm(ks[17], (DEPTH, D_MODEL, D_FF), D_MODEL),
        "w_mlp_out": nrm(ks[18], (DEPTH, D_FF, D_MODEL), D_FF),
        "norm_final": gain(ks[19], (D_MODEL,)),
    }


def reference(x_prompt, x_sample, mem_prompt, mem_sample, norm_mix, w_in, ret_decay_f, ret_decay_b,
              attn_sink, rel_bias, w_out, norm_cross, norm_mem, w_cq, w_ckv, w_co, norm_mlp,
              w_mlp_in, w_mlp_out, norm_final):
    y_prompt = encode(x_prompt, mem_prompt, norm_mix, w_in, ret_decay_f, ret_decay_b, attn_sink, rel_bias,
                      w_out, norm_cross, norm_mem, w_cq, w_ckv, w_co, norm_mlp, w_mlp_in, w_mlp_out, norm_final)
    y_sample = encode(x_sample, mem_sample, norm_mix, w_in, ret_decay_f, ret_decay_b, attn_sink, rel_bias,
                      w_out, norm_cross, norm_mem, w_cq, w_ckv, w_co, norm_mlp, w_mlp_in, w_mlp_out, norm_final)
    return (y_prompt, y_sample)
```

```cpp
#include <hip/hip_runtime.h>
#include <cstdio>
#include <cstdint>
namespace pg8 {
#define PG8_LAS __attribute__((address_space(3)))
typedef unsigned short bf16_t;
typedef short bf16x8 __attribute__((ext_vector_type(8)));
typedef float f32x4 __attribute__((ext_vector_type(4)));
typedef unsigned u32x4 __attribute__((ext_vector_type(4)));
constexpr int BM = 256, BK = 64, HALF = 128, HTB = HALF * BK * 2  , STAGE_BYTES = 8 * HTB, NXCD = 8, WGM = 8;

__host__ __device__ __forceinline__ int lds_byte(int r, int c) { const int st = (r >> 4) * 2 + (c >> 5), rr = r & 15, cc = c & 31, ob = rr * 64 + cc * 2; return st * 1024 + (ob ^ (((ob >> 9) & 1) << 5)); }
__host__ __device__ __forceinline__ void stage_rc(int b, int& R, int& C) { const int st = b / 1024, sb = b % 1024, swz = sb ^ (((sb >> 9) & 1) << 5); R = (st >> 1) * 16 + swz / 64; C = (st & 1) * 32 + (swz % 64) / 2; }
__host__ __device__ __forceinline__ int perm32(int rho) { const int n = rho >> 4, i = rho & 15; return 8 * (i >> 2) + 4 * n + (i & 3); }

struct Unit { int pm, pn; };
struct Gemm { const bf16_t* A; const bf16_t* Bt; int M, N, K; };

struct StaticOrder {
    int nM, nN, nwg, G, c;
    __host__ __device__ void init(int M, int N, int G_, int c_) { nM = M / BM; nN = N / BM; nwg = nM * nN; G = G_; c = c_; }
    __host__ __device__ bool next(int i, Unit& u) const {
        const long L = (long)i * G + c; if (L >= nwg) return false;
        int wgid = (int)L; { const int q = nwg / NXCD, r = nwg % NXCD, xcd = wgid % NXCD, off = wgid / NXCD; wgid = (xcd < r ? xcd * (q + 1) : r * (q + 1) + (xcd - r) * q) + off; }
        const int nig = WGM * nN, gid = wgid / nig, fm = gid * WGM, gsz = (nM - fm) < WGM ? (nM - fm) : WGM;
        u.pm = fm + ((wgid % nig) % gsz); u.pn = (wgid % nig) / gsz; return true;
    }
    __device__ __forceinline__ void a_ready(const Unit&) const {}
    __device__ __forceinline__ void done(const Unit&) const {}
};

typedef float f32x2 __attribute__((ext_vector_type(2)));
typedef __bf16 bf16x2_t __attribute__((ext_vector_type(2)));
__device__ __forceinline__ unsigned cvt_pk_bf16(float lo, float hi) { f32x2 v = {lo, hi}; bf16x2_t b = __builtin_convertvector(v, bf16x2_t); return __builtin_bit_cast(unsigned, b); }
__device__ __forceinline__ u32x4 pack8(const f32x4& v0, const f32x4& v1) { u32x4 w; w.x = cvt_pk_bf16(v0[0], v0[1]); w.y = cvt_pk_bf16(v0[2], v0[3]); w.z = cvt_pk_bf16(v1[0], v1[1]); w.w = cvt_pk_bf16(v1[2], v1[3]); return w; }

template <int ACT> struct EpiBf16S {
    static constexpr bool PERM = true, AFTER_DRAIN = false;
    bf16_t* O; int ldc; float scale;
    __device__ __forceinline__ void operator()(const f32x4 (&acc)[2][2][4][2], const Unit& u, int wr, int wc, int fr, int fq) const {
        const int row0 = u.pm * BM + wr * 64 + fr, col0 = u.pn * BM + wc * 32 + 8 * fq;
#pragma unroll
        for (int ai = 0; ai < 2; ++ai)
#pragma unroll
            for (int m = 0; m < 4; ++m) { bf16_t* rowp = O + (size_t)(row0 + ai * HALF + m * 16) * ldc + col0;
#pragma unroll
                for (int bj = 0; bj < 2; ++bj) { f32x4 v0 = acc[ai][bj][m][0], v1 = acc[ai][bj][m][1];
                    if (ACT == 1) {
#pragma unroll
                        for (int e = 0; e < 4; ++e) { const float a = fmaxf(v0[e], 0.f), b = fmaxf(v1[e], 0.f); v0[e] = a * a; v1[e] = b * b; } }
                    else { v0 = v0 * scale; v1 = v1 * scale; }
                    *(u32x4*)(rowp + bj * HALF) = pack8(v0, v1); } }
    }
};
struct EpiRes {
    static constexpr bool PERM = false, AFTER_DRAIN = false;
    const float* base; float* out; int ldc;
    __device__ __forceinline__ void operator()(const f32x4 (&acc)[2][2][4][2], const Unit& u, int wr, int wc, int fr, int fq) const {
        const int row0 = u.pm * BM + wr * 64 + fr, col0 = u.pn * BM + wc * 32 + 4 * fq;
#pragma unroll
        for (int ai = 0; ai < 2; ++ai)
#pragma unroll
            for (int m = 0; m < 4; ++m) { const size_t off = (size_t)(row0 + ai * HALF + m * 16) * ldc + col0;
                f32x4 bs[2][2];
#pragma unroll
                for (int bj = 0; bj < 2; ++bj)
#pragma unroll
                    for (int n = 0; n < 2; ++n) bs[bj][n] = *(const f32x4*)(base + off + bj * HALF + n * 16);
#pragma unroll
                for (int bj = 0; bj < 2; ++bj)
#pragma unroll
                    for (int n = 0; n < 2; ++n) *(f32x4*)(out + off + bj * HALF + n * 16) = bs[bj][n] + acc[ai][bj][m][n]; }
    }
};
struct EpiProj {
    static constexpr bool PERM = true, AFTER_DRAIN = false;
    bf16_t* O; int ldc; const float* cs; const float* sn; int posmask;
    __device__ __forceinline__ void operator()(const f32x4 (&acc)[2][2][4][2], const Unit& u, int wr, int wc, int fr, int fq) const {
        const int row0 = u.pm * BM + wr * 64 + fr, col0 = u.pn * BM + wc * 32 + 8 * fq;
        const int sec = u.pn >> 3;
        const int i0 = 16 * wc + 4 * fq;
#pragma unroll
        for (int ai = 0; ai < 2; ++ai)
#pragma unroll
            for (int m = 0; m < 4; ++m) { const int row = row0 + ai * HALF + m * 16; bf16_t* rowp = O + (size_t)row * ldc + col0;
                f32x4 c4 = (f32x4){1.f, 1.f, 1.f, 1.f}, s4 = (f32x4){0.f, 0.f, 0.f, 0.f};
                if (sec < 2) { const int pos = row & posmask; c4 = *(const f32x4*)(cs + (size_t)pos * 64 + i0); s4 = *(const f32x4*)(sn + (size_t)pos * 64 + i0);
                    if (sec == 1) { c4 = c4 * 0.08838834764831845f; s4 = s4 * 0.08838834764831845f; } }
#pragma unroll
                for (int bj = 0; bj < 2; ++bj) { f32x4 v0 = acc[ai][bj][m][0], v1 = acc[ai][bj][m][1];
                    if (sec < 2) {
                        f32x4 o0, o1;
                        o0[0] = v0[0] * c4[0] - v0[1] * s4[0]; o0[1] = v0[0] * s4[0] + v0[1] * c4[0];
                        o0[2] = v0[2] * c4[1] - v0[3] * s4[1]; o0[3] = v0[2] * s4[1] + v0[3] * c4[1];
                        o1[0] = v1[0] * c4[2] - v1[1] * s4[2]; o1[1] = v1[0] * s4[2] + v1[1] * c4[2];
                        o1[2] = v1[2] * c4[3] - v1[3] * s4[3]; o1[3] = v1[2] * s4[3] + v1[3] * c4[3];
                        v0 = o0; v1 = o1;
                    } else if (sec == 3) {
#pragma unroll
                        for (int e = 0; e < 4; ++e) { v0[e] = v0[e] * __builtin_amdgcn_rcpf(1.f + __builtin_amdgcn_exp2f(-1.4426950408889634f * v0[e]));
                                                      v1[e] = v1[e] * __builtin_amdgcn_rcpf(1.f + __builtin_amdgcn_exp2f(-1.4426950408889634f * v1[e])); }
                    } else if (sec == 4) { v0 = v0 * 0.12751743074602224f; v1 = v1 * 0.12751743074602224f; }
                    *(u32x4*)(rowp + bj * HALF) = pack8(v0, v1); } }
    }
};
template <class Epi, class Sched, bool ALIGN_EPI = false, bool SP2 = false>
__device__ __forceinline__ void gemm_phase(PG8_LAS unsigned char* lds, const Gemm g, const Sched& S, const Epi& E) {
    int tid_ = threadIdx.x; asm volatile("" : "+v"(tid_));
    const int tid = tid_, wid = __builtin_amdgcn_readfirstlane(tid >> 6), lane = tid & 63, wr = wid >> 2, wc = wid & 3, fr = lane & 15, fq = lane >> 4;
    const int K = g.K, nt = K / BK;
    unsigned voffA[2], voffB[2];
#pragma unroll
    for (int i = 0; i < 2; ++i) { int R, C; stage_rc(tid * 16 + i * 8192, R, C); const int Rb = Epi::PERM ? ((R & ~31) + perm32(R & 31)) : R;
        voffA[i] = (unsigned)(R * K + C) * 2u; voffB[i] = (unsigned)(Rb * K + C) * 2u; }
    const size_t kstep = (size_t)(BK * 2);
    const size_t hstep = (size_t)HALF * K * 2;
    const size_t tstep = 2 * hstep;
    const unsigned ldsw = (unsigned)wid * 1024u;
    const int aoff = lds_byte(wr * 64 + fr, fq * 8), boff = lds_byte(wc * 32 + fr, fq * 8);
#define PG8_SA(b, h) (((b) * 2 + (h)) * HTB)
#define PG8_SB(b, h) ((4 + (b) * 2 + (h)) * HTB)
#define PG8_STAGE(bufoff, gbase, voff) do { _Pragma("unroll") for (int _i = 0; _i < 2; ++_i) \
        __builtin_amdgcn_global_load_lds((const unsigned*)((const char*)(gbase) + (voff)[_i]), (PG8_LAS unsigned*)(lds + (bufoff) + ldsw + _i * 8192), 16, 0, 0); } while (0)
#define PG8_LDA(dst, b, h) do { _Pragma("unroll") for (int m = 0; m < 4; ++m) _Pragma("unroll") for (int k = 0; k < 2; ++k) dst[m][k] = *(const PG8_LAS bf16x8*)(lds + PG8_SA(b, h) + aoff + m * 2048 + k * 1024); } while (0)
#define PG8_LDB(dst, b, h) do { _Pragma("unroll") for (int n = 0; n < 2; ++n) _Pragma("unroll") for (int k = 0; k < 2; ++k) dst[n][k] = *(const PG8_LAS bf16x8*)(lds + PG8_SB(b, h) + boff + n * 2048 + k * 1024); } while (0)
#define PG8_MMA(ai, bj, At, Bt) do { __builtin_amdgcn_s_setprio(1); _Pragma("unroll") for (int m = 0; m < 4; ++m) _Pragma("unroll") for (int n = 0; n < 2; ++n) _Pragma("unroll") for (int k = 0; k < 2; ++k) \
        acc[ai][bj][m][n] = __builtin_amdgcn_mfma_f32_16x16x32_bf16(Bt[n][k], At[m][k], acc[ai][bj][m][n], 0, 0, 0); __builtin_amdgcn_s_setprio(0); } while (0)
#define PG8_WAIT_V(n) asm volatile("s_waitcnt vmcnt(" #n ")" ::: "memory")
#define PG8_WAIT_L(n) asm volatile("s_waitcnt lgkmcnt(" #n ")" ::: "memory")
#define PG8_BAR __builtin_amdgcn_s_barrier()
#define PG8_SCHED __builtin_amdgcn_sched_barrier(0)
    Unit cur, nxt; int ui = 0;
    if (!S.next(0, cur)) return;
    f32x4 acc[2][2][4][2];
#pragma unroll
    for (int a = 0; a < 2; ++a)
#pragma unroll
        for (int b = 0; b < 2; ++b)
#pragma unroll
            for (int m = 0; m < 4; ++m)
#pragma unroll
                for (int n = 0; n < 2; ++n) acc[a][b][m][n] = (f32x4){0.f, 0.f, 0.f, 0.f};
    bf16x8 At[4][2], B0[2][2], B1[2][2];
    const char* cA = (const char*)g.A + (size_t)cur.pm * tstep; const char* cB = (const char*)g.Bt + (size_t)cur.pn * tstep;
    S.a_ready(cur);
    if constexpr (SP2) {
        PG8_STAGE(PG8_SB(0, 0), cB, voffB); PG8_STAGE(PG8_SB(0, 1), cB + hstep, voffB); PG8_STAGE(PG8_SA(0, 0), cA, voffA); PG8_STAGE(PG8_SA(0, 1), cA + hstep, voffA);
        if (wr == 1) PG8_BAR;
        PG8_WAIT_V(2); PG8_BAR;
        PG8_STAGE(PG8_SB(1, 0), cB + kstep, voffB); PG8_STAGE(PG8_SA(1, 0), cA + kstep, voffA); PG8_STAGE(PG8_SB(1, 1), cB + hstep + kstep, voffB);
        PG8_WAIT_V(6); PG8_BAR;
    } else {
        PG8_STAGE(PG8_SB(0, 0), cB, voffB); PG8_STAGE(PG8_SA(0, 0), cA, voffA); PG8_STAGE(PG8_SB(0, 1), cB + hstep, voffB); PG8_STAGE(PG8_SA(0, 1), cA + hstep, voffA);
        if (wr == 1) PG8_BAR;
        PG8_WAIT_V(4); PG8_BAR;
        PG8_STAGE(PG8_SB(1, 0), cB + kstep, voffB); PG8_STAGE(PG8_SA(1, 0), cA + kstep, voffA); PG8_STAGE(PG8_SB(1, 1), cB + hstep + kstep, voffB);
        PG8_WAIT_V(6); PG8_BAR;
    }
    for (;;) {
        const bool has_next = S.next(ui + 1, nxt);
        const char* nA = has_next ? (const char*)g.A + (size_t)nxt.pm * tstep : cA; const char* nB = has_next ? (const char*)g.Bt + (size_t)nxt.pn * tstep : cB;
        for (int t = 0; t < nt; t += 2) {
            const bool last = (t == nt - 2);
            const char* a1 = cA + (size_t)(t + 1) * kstep;
            const char* a2 = last ? nA : cA + (size_t)(t + 2) * kstep; const char* b2 = last ? nB : cB + (size_t)(t + 2) * kstep;
            const char* a3 = a2 + kstep; const char* b3 = b2 + kstep;
            if (last && has_next) S.a_ready(nxt);
            if constexpr (SP2) {
            PG8_LDB(B0, 0, 0); PG8_LDB(B1, 0, 1); PG8_SCHED; PG8_LDA(At, 0, 0); PG8_STAGE(PG8_SA(1, 1), a1 + hstep, voffA);
            PG8_WAIT_V(8); PG8_WAIT_L(0); PG8_BAR; PG8_MMA(0, 0, At, B0); PG8_MMA(0, 1, At, B1); PG8_BAR; PG8_SCHED;
            PG8_LDA(At, 0, 1); PG8_STAGE(PG8_SB(0, 0), b2, voffB); PG8_STAGE(PG8_SB(0, 1), b2 + hstep, voffB); PG8_STAGE(PG8_SA(0, 0), a2, voffA);
            PG8_WAIT_V(8); PG8_WAIT_L(0); PG8_BAR; PG8_MMA(1, 0, At, B0); PG8_MMA(1, 1, At, B1); PG8_BAR; PG8_SCHED;
            PG8_LDB(B0, 1, 0); PG8_LDB(B1, 1, 1); PG8_SCHED; PG8_LDA(At, 1, 0); PG8_STAGE(PG8_SA(0, 1), a2 + hstep, voffA);
            PG8_WAIT_V(8); PG8_WAIT_L(0); PG8_BAR; PG8_MMA(0, 0, At, B0); PG8_MMA(0, 1, At, B1); PG8_BAR; PG8_SCHED;
            PG8_LDA(At, 1, 1); PG8_STAGE(PG8_SB(1, 0), b3, voffB); PG8_STAGE(PG8_SB(1, 1), b3 + hstep, voffB); PG8_STAGE(PG8_SA(1, 0), a3, voffA);
            PG8_WAIT_V(8); PG8_WAIT_L(0); PG8_BAR; PG8_MMA(1, 0, At, B0); PG8_MMA(1, 1, At, B1); PG8_BAR; PG8_SCHED;
            } else {
            PG8_LDB(B0, 0, 0); PG8_SCHED; PG8_LDA(At, 0, 0); PG8_STAGE(PG8_SA(1, 1), a1 + hstep, voffA);
            PG8_WAIT_L(8); PG8_BAR; PG8_WAIT_L(0); PG8_MMA(0, 0, At, B0); PG8_BAR; PG8_SCHED;
            PG8_LDB(B1, 0, 1); PG8_STAGE(PG8_SB(0, 0), b2, voffB);
            PG8_BAR; PG8_WAIT_L(0); PG8_MMA(0, 1, At, B1); PG8_BAR;
            PG8_LDA(At, 0, 1); PG8_STAGE(PG8_SA(0, 0), a2, voffA);
            PG8_BAR; PG8_WAIT_L(0); PG8_MMA(1, 0, At, B0); PG8_BAR; PG8_SCHED;
            PG8_STAGE(PG8_SB(0, 1), b2 + hstep, voffB);
            PG8_WAIT_V(6); PG8_BAR; PG8_MMA(1, 1, At, B1); PG8_BAR;
            PG8_LDB(B0, 1, 0); PG8_SCHED; PG8_LDA(At, 1, 0); PG8_STAGE(PG8_SA(0, 1), a2 + hstep, voffA);
            PG8_WAIT_L(8); PG8_BAR; PG8_WAIT_L(0); PG8_MMA(0, 0, At, B0); PG8_BAR; PG8_SCHED;
            PG8_LDB(B1, 1, 1); PG8_STAGE(PG8_SB(1, 0), b3, voffB);
            PG8_BAR; PG8_WAIT_L(0); PG8_MMA(0, 1, At, B1); PG8_BAR;
            PG8_LDA(At, 1, 1); PG8_STAGE(PG8_SA(1, 0), a3, voffA);
            PG8_BAR; PG8_WAIT_L(0); PG8_MMA(1, 0, At, B0); PG8_BAR; PG8_SCHED;
            PG8_STAGE(PG8_SB(1, 1), b3 + hstep, voffB);
            PG8_WAIT_V(6); PG8_BAR; PG8_MMA(1, 1, At, B1); PG8_BAR;
            }
        }
        if constexpr (ALIGN_EPI) { if (wr == 0) PG8_BAR; }
        if constexpr (!Epi::AFTER_DRAIN) { E(acc, cur, wr, wc, fr, fq); S.done(cur); }
        if (!has_next) break;
#pragma unroll
        for (int a = 0; a < 2; ++a)
#pragma unroll
            for (int b = 0; b < 2; ++b)
#pragma unroll
                for (int m = 0; m < 4; ++m)
#pragma unroll
                    for (int n = 0; n < 2; ++n) acc[a][b][m][n] = (f32x4){0.f, 0.f, 0.f, 0.f};
        cur = nxt; cA = nA; cB = nB; ++ui;
        if constexpr (ALIGN_EPI) { if (wr == 1) PG8_BAR; }
    }
    PG8_WAIT_V(0);
    if constexpr (!ALIGN_EPI) { if (wr == 0) PG8_BAR; }
    PG8_BAR;
    if constexpr (Epi::AFTER_DRAIN) { E.fused(acc, cur, wr, wc, fr, fq, lds, wid, lane); S.done(cur); }
#undef PG8_SA
#undef PG8_SB
#undef PG8_STAGE
#undef PG8_LDA
#undef PG8_LDB
#undef PG8_MMA
#undef PG8_WAIT_V
#undef PG8_WAIT_L
#undef PG8_BAR
#undef PG8_SCHED
}
}
#ifndef PG8_SP2
#define PG8_SP2 true
#endif
#ifndef PG8_ALIGN
#define PG8_ALIGN true
#endif

constexpr int NWAVES = 8, NTHREADS = 512;
constexpr int NPHASE = 21;
#ifndef MK_N_LAUNCHES
#define MK_N_LAUNCHES 1
#endif
constexpr int N_LAUNCHES = MK_N_LAUNCHES;

constexpr int DM = 4096, NTOK = 32768, HTOK = 16384, INW = 11264, DFF = 16384, MEMW = 512, NMEM = 1536, HD = 128;
constexpr int RETW = 2048, QA_OFF = 8192, KA_OFF = 10240, VA_OFF = 10752;
constexpr float RMS_EPS = 1e-6f, LOG2E = 1.4426950408889634f;
constexpr int TBW = 264;

constexpr size_t MiB = 1u << 20;
constexpr size_t WS_CTL = 0, CTL_ZERO_BYTES = 1 * MiB;
constexpr size_t WS_COS = 1 * MiB, WS_SIN = 3 * MiB, WS_TB = 5 * MiB;
constexpr size_t WS_MEMN = 6 * MiB, WS_KVM = 18 * MiB;
constexpr size_t WS_WIN = 24 * MiB, WS_WOUT = 112 * MiB, WS_WCQ = 144 * MiB, WS_WCKV = 148 * MiB, WS_WCO = 156 * MiB, WS_W1 = 160 * MiB, WS_W2 = 288 * MiB;
constexpr size_t WS_XN = 416 * MiB;
constexpr size_t WS_R = 672 * MiB;
constexpr size_t WS_PROJ = WS_R, WS_Y = WS_R + 352 * MiB, WS_ST = WS_Y + 128 * MiB, WS_END = WS_ST + 128 * MiB;
constexpr size_t WS_QC = WS_R, WS_OC = WS_R + 32 * MiB;
constexpr size_t WS_HID = WS_R;
static_assert(WS_HID + (size_t)HTOK * DFF * 2 <= WS_END && WS_END == 1280 * MiB, "d_ws map");
constexpr int CW_TMO = 0, CW_BAR = 4096;

constexpr int RING_OFF = 0, RING_BYTES = 131072;
constexpr int LDSCTL_OFF = RING_BYTES, MISC_OFF = LDSCTL_OFF + 320;
constexpr int TAB_OFF = LDSCTL_OFF + 1024;
constexpr int LDS_BYTES = 147456;
static_assert(TAB_OFF + 8192 <= LDS_BYTES, "LDS map");

#define GAS __attribute__((address_space(1)))
#define LAS __attribute__((address_space(3)))
#define DI __device__ __forceinline__
typedef unsigned short bf16;
typedef unsigned v4u __attribute__((ext_vector_type(4)));
typedef unsigned v2u __attribute__((ext_vector_type(2)));
typedef float f32x4 __attribute__((ext_vector_type(4)));
typedef float f32x16 __attribute__((ext_vector_type(16)));
typedef short bf16x8 __attribute__((ext_vector_type(8)));
typedef short v4i16_t __attribute__((ext_vector_type(4)));
typedef GAS unsigned gu32;
#define RLX_AGENT __ATOMIC_RELAXED, __HIP_MEMORY_SCOPE_AGENT
#define LDS_WAIT() asm volatile("s_waitcnt lgkmcnt(0)" ::: "memory")
#define VM_WAIT() asm volatile("s_waitcnt vmcnt(0)" ::: "memory")
DI unsigned f2bf(float f) { unsigned u = __builtin_bit_cast(unsigned, f); return (u + 0x7fffu + ((u >> 16) & 1u)) >> 16; }
DI unsigned pk2(float lo, float hi) { return pg8::cvt_pk_bf16(lo, hi); }
DI float bflo(unsigned w) { return __uint_as_float(w << 16); }
DI float bfhi(unsigned w) { return __uint_as_float(w & 0xffff0000u); }
DI float ex2(float x) { return __builtin_amdgcn_exp2f(x); }
#define XB_TMO      128
#define XB_XCNT(j)  (256  + 64 * (j))
#define XB_XSUB(j)  (1280 + 64 * (j))
#define XB_XGEN(j)  (2304 + 64 * (j))
#define XB_TOP      3328
#define XB_TOPGEN   3392
#define XCD_BAR_WORDS 3456
#define XB_SPIN_CAP (1u << 18)

__device__ __forceinline__ unsigned xb_ld(unsigned* p)              { return __hip_atomic_load(p, __ATOMIC_RELAXED, __HIP_MEMORY_SCOPE_AGENT); }
__device__ __forceinline__ unsigned xb_add(unsigned* p, unsigned v) { return __hip_atomic_fetch_add(p, v, __ATOMIC_RELAXED, __HIP_MEMORY_SCOPE_AGENT); }
__device__ __forceinline__ unsigned xb_xcc_id() { return (unsigned)__builtin_amdgcn_s_getreg((3 << 11) | 20) & 0xFu; }
#define XB_SPIN(cond, bar) do { unsigned _sp = 0; while (cond) { __builtin_amdgcn_s_sleep(1); \
    if ((++_sp & 255u) == 0u) { if (xb_ld(&(bar)[XB_TMO])) break; if (_sp > XB_SPIN_CAP) { atomicAdd(&(bar)[XB_TMO], 1u); break; } } } } while (0)

struct XcdBarrier {
    unsigned* bar; unsigned x;
    volatile LAS unsigned* st;
};

__device__ __forceinline__ XcdBarrier xcd_barrier_post(unsigned* bar, volatile LAS unsigned* st) {
    XcdBarrier b; b.bar = bar; b.x = xb_xcc_id(); b.st = st;
    if (threadIdx.x == 0) (void)xb_add(&bar[XB_XCNT(b.x)], 1u);
    return b;
}
__device__ __forceinline__ void xcd_barrier_complete(unsigned* bar, unsigned x, unsigned& nloc, unsigned& nx) {
    const unsigned G = gridDim.x * gridDim.y * gridDim.z;
    unsigned sum, cnt, mine, sp = 0u;
    for (;;) {
        sum = 0u; cnt = 0u; mine = 0u;
#pragma unroll
        for (unsigned j = 0; j < 16; ++j) { const unsigned c = xb_ld(&bar[XB_XCNT(j)]); sum += c; cnt += (c > 0u) ? 1u : 0u; mine = (j == x) ? c : mine; }
        if (sum == G) break;
        __builtin_amdgcn_s_sleep(1);
        if ((++sp & 255u) == 0u) { if (xb_ld(&bar[XB_TMO])) break; if (sp > XB_SPIN_CAP) { atomicAdd(&bar[XB_TMO], 1u); break; } }
    }
    nloc = mine > 0u ? mine : 1u; nx = cnt > 0u ? cnt : 1u;
}

__device__ __forceinline__ void xcd_barrier(const XcdBarrier& b) {
    asm volatile("s_waitcnt vmcnt(0)" ::: "memory");
    __syncthreads();
    if (threadIdx.x == 0) {
        unsigned* bar = b.bar;
        __builtin_amdgcn_s_waitcnt(0);
        unsigned nloc = b.st[0], nx = b.st[1];
        if (nloc == 0u) { xcd_barrier_complete(bar, b.x, nloc, nx); b.st[0] = nloc; b.st[1] = nx; }
        const unsigned old = xb_add(&bar[XB_XSUB(b.x)], 1u);
        const unsigned gen = old / nloc;
        if (old + 1u == (gen + 1u) * nloc) {
            __builtin_amdgcn_fence(__ATOMIC_RELEASE, "agent");
            asm volatile("s_waitcnt vmcnt(0)" ::: "memory");
            const unsigned og = xb_add(&bar[XB_TOP], 1u);
            const unsigned tg = og / nx;
            if (og + 1u == (tg + 1u) * nx) xb_add(&bar[XB_TOPGEN], 1u);
            else XB_SPIN(xb_ld(&bar[XB_TOPGEN]) == tg, bar);
            __builtin_amdgcn_fence(__ATOMIC_ACQUIRE, "agent");
            xb_add(&bar[XB_XGEN(b.x)], 1u);
            asm volatile("s_waitcnt vmcnt(0)" ::: "memory");
        } else {
            XB_SPIN(xb_ld(&bar[XB_XGEN(b.x)]) == gen, bar);
            __builtin_amdgcn_fence(__ATOMIC_ACQUIRE, "agent");
            asm volatile("s_waitcnt vmcnt(0)" ::: "memory");
        }
    }
    __syncthreads();
}
struct Frame {
    LAS unsigned char* lds;
    volatile LAS unsigned* MISC;
    gu32* ctl;
    int tid, lane, wave;
    int vcu, G;
    unsigned char* ws;
};

DI float wave_sum(float v) {
#pragma unroll
    for (int o = 1; o < 64; o <<= 1) v += __shfl_xor(v, o);
    return v;
}
template <bool ROPEPERM>
DI void p0_transpose_item(const float* W, int K, int N, bf16* WT, LAS float* scr, int item, int lane) {
    const int nblk = N / 32, kb = item / nblk, nb = item % nblk, k0 = 64 * kb, n0 = 32 * nb;
    int ncol = n0 + (lane & 31);
    if (ROPEPERM && ncol < 4096) { const int o = ncol & 127; ncol = (ncol & ~127) + (o >> 1) + 64 * (o & 1); }
#pragma unroll 8
    for (int i = 0; i < 32; ++i) { const int kk = 2 * i + (lane >> 5); scr[kk * 33 + (lane & 31)] = W[(size_t)(k0 + kk) * N + ncol]; }
    LDS_WAIT(); asm volatile("" ::: "memory");
    const int c = lane & 7;
#pragma unroll
    for (int j = 0; j < 4; ++j) { const int n = (lane >> 3) + 8 * j; const LAS float* s = scr + (8 * c) * 33 + n;
        v4u o; o.x = pk2(s[0 * 33], s[1 * 33]); o.y = pk2(s[2 * 33], s[3 * 33]); o.z = pk2(s[4 * 33], s[5 * 33]); o.w = pk2(s[6 * 33], s[7 * 33]);
        *(GAS v4u*)(WT + (size_t)(n0 + n) * K + k0 + 8 * c) = o; }
    LDS_WAIT(); asm volatile("" ::: "memory");
}
DI void rms_row_to_bf16(const float* xrow, const float* gain, bf16* orow, int lane) {
    const GAS f32x4* xr = (const GAS f32x4*)xrow + lane;
    f32x4 v[16]; float s = 0.f;
#pragma unroll
    for (int j = 0; j < 16; ++j) { v[j] = xr[64 * j]; s += (v[j].x * v[j].x + v[j].y * v[j].y) + (v[j].z * v[j].z + v[j].w * v[j].w); }
    const float rstd = 1.0f / sqrtf(wave_sum(s) * (1.f / DM) + RMS_EPS);
    const GAS f32x4* gr = (const GAS f32x4*)gain + lane;
    GAS v2u* o8 = (GAS v2u*)orow + lane;
#pragma unroll
    for (int j = 0; j < 16; ++j) { const f32x4 g = gr[64 * j]; v2u w; w.x = pk2(v[j].x * rstd * g.x, v[j].y * rstd * g.y); w.y = pk2(v[j].z * rstd * g.z, v[j].w * rstd * g.w); o8[64 * j] = w; }
}
DI void rms_row_to_f32(const float* xrow, const float* gain, float* orow, int lane, bool poison) {
    const GAS f32x4* xr = (const GAS f32x4*)xrow + lane;
    f32x4 v[16]; float s = 0.f;
#pragma unroll
    for (int j = 0; j < 16; ++j) { v[j] = xr[64 * j]; s += (v[j].x * v[j].x + v[j].y * v[j].y) + (v[j].z * v[j].z + v[j].w * v[j].w); }
    float rstd = 1.0f / sqrtf(wave_sum(s) * (1.f / DM) + RMS_EPS);
    if (poison) rstd = __builtin_nanf("");
    const GAS f32x4* gr = (const GAS f32x4*)gain + lane;
    GAS f32x4* o = (GAS f32x4*)orow + lane;
#pragma unroll
    for (int j = 0; j < 16; ++j) { const f32x4 g = gr[64 * j]; o[64 * j] = v[j] * rstd * g; }
}

#define MFMA32(a, b, c) __builtin_amdgcn_mfma_f32_32x32x16_bf16((a), (b), (c), 0, 0, 0)
DI int crow(int reg, int h) { return (reg & 3) + 8 * (reg >> 2) + 4 * h; }
DI unsigned off_b(unsigned row, unsigned ch) { return 256u * row + 16u * (ch ^ (((row & 3u) << 2) | ((row >> 2) & 3u))); }
DI bf16x8 row_frag(const LAS unsigned char* img, int rowbase, int lane, int ks) { return *(const LAS bf16x8*)(img + off_b(rowbase + (lane & 31), 2 * ks + (lane >> 5))); }
DI v4i16_t tr4(const LAS unsigned char* p) { return __builtin_amdgcn_ds_read_tr16_b64_v4i16((LAS v4i16_t*)p); }
DI bf16x8 tr_frag_nat(const LAS unsigned char* img, int rowbase, int lane, int c, int ks) {
    const unsigned h = lane >> 5, blk = (lane >> 4) & 1, q = (lane & 15) >> 2, p = lane & 3;
    const unsigned r0 = rowbase + 16 * ks + 8 * h + q, ch = 4 * c + 2 * blk + (p >> 1);
    const v4i16_t lo = tr4(img + off_b(r0, ch) + 8 * (p & 1)), hi = tr4(img + off_b(r0 + 4, ch) + 8 * (p & 1));
    return __builtin_shufflevector(lo, hi, 0, 1, 2, 3, 4, 5, 6, 7);
}
DI bf16x8 tr_frag_perm(const LAS unsigned char* img, int rowbase, int lane, int c, int s) {
    const unsigned h = lane >> 5, blk = (lane >> 4) & 1, q = (lane & 15) >> 2, p = lane & 3;
    const unsigned r0 = rowbase + 16 * s + 4 * h + q, ch = 4 * c + 2 * blk + (p >> 1);
    const v4i16_t lo = tr4(img + off_b(r0, ch) + 8 * (p & 1)), hi = tr4(img + off_b(r0 + 8, ch) + 8 * (p & 1));
    return __builtin_shufflevector(lo, hi, 0, 1, 2, 3, 4, 5, 6, 7);
}
template <int S> DI bf16x8 pack_step(const f32x16& x) {
    v4u p; p.x = pk2(x[8 * S], x[8 * S + 1]); p.y = pk2(x[8 * S + 2], x[8 * S + 3]); p.z = pk2(x[8 * S + 4], x[8 * S + 5]); p.w = pk2(x[8 * S + 6], x[8 * S + 7]);
    return __builtin_bit_cast(bf16x8, p);
}
DI void stage_tile(LAS unsigned char* img, const bf16* g, size_t pitch, int tid) {
#pragma unroll
    for (int i = 0; i < 4; ++i) { const int n = tid + 512 * i, row = n >> 4, ch = n & 15;
        const v4u v = *(const GAS v4u*)(g + (size_t)row * pitch + ch * 8);
        *(LAS v4u*)(img + off_b(row, ch)) = v; }
}
DI void stage_tile_scaled(LAS unsigned char* img, const bf16* g, size_t pitch, int tid, float a, float b) {
#pragma unroll
    for (int i = 0; i < 4; ++i) { const int n = tid + 512 * i, row = n >> 4, ch = n & 15;
        const v4u v = *(const GAS v4u*)(g + (size_t)row * pitch + ch * 8); const float sc = ex2(a + b * (float)row);
        v4u o; o.x = pk2(bflo(v.x) * sc, bfhi(v.x) * sc); o.y = pk2(bflo(v.y) * sc, bfhi(v.y) * sc); o.z = pk2(bflo(v.z) * sc, bfhi(v.z) * sc); o.w = pk2(bflo(v.w) * sc, bfhi(v.w) * sc);
        *(LAS v4u*)(img + off_b(row, ch)) = o; }
}

template <bool WIN>
DI void attn_unit(LAS unsigned char* lds, const LAS float* tbh, const bf16* qptr, size_t qpitch, const bf16* kptr, const bf16* vptr, size_t kvpitch, int lo, int hi,
                  bf16* optr, size_t opitch, float m0, float l0, int iq, int tid) {
    const int lane = tid & 63, r = lane & 31, h = lane >> 5;
    bf16x8 qf[8];
#pragma unroll
    for (int ks = 0; ks < 8; ++ks) qf[ks] = *(const GAS bf16x8*)(qptr + (size_t)r * qpitch + 16 * ks + 8 * h);
    f32x16 o[4];
#pragma unroll
    for (int c = 0; c < 4; ++c)
#pragma unroll
        for (int i = 0; i < 16; ++i) o[c][i] = 0.f;
    float m = m0, l = l0;
    LAS unsigned char* imgK = lds; LAS unsigned char* imgV = lds + 32768;
    for (int dk = lo; dk < hi; ++dk) {
        __syncthreads();
        stage_tile(imgK, kptr + (ptrdiff_t)dk * 128 * (ptrdiff_t)kvpitch, kvpitch, tid);
        stage_tile(imgV, vptr + (ptrdiff_t)dk * 128 * (ptrdiff_t)kvpitch, kvpitch, tid);
        __syncthreads();
#pragma unroll
        for (int kh = 0; kh < 2; ++kh) {
        f32x16 st[2];
#pragma unroll
        for (int kt = 0; kt < 2; ++kt) {
#pragma unroll
            for (int i = 0; i < 16; ++i) st[kt][i] = 0.f;
#pragma unroll
            for (int ks = 0; ks < 8; ++ks) st[kt] = MFMA32(row_frag(imgK, 64 * kh + 32 * kt, lane, ks), qf[ks], st[kt]);
        }
        if (WIN) {
            const int relb = 128 * dk - iq + 128 + 64 * kh;
#pragma unroll
            for (int kt = 0; kt < 2; ++kt)
#pragma unroll
                for (int i = 0; i < 16; ++i) { const int idx = relb + 32 * kt + crow(i, h); const bool ok = (unsigned)idx <= 256u;
                    const float bias = tbh[ok ? idx : 0]; st[kt][i] = ok ? st[kt][i] + bias : -1e30f; }
        }
        float mx = st[0][0];
#pragma unroll
        for (int kt = 0; kt < 2; ++kt)
#pragma unroll
            for (int i = 0; i < 16; ++i) mx = fmaxf(mx, st[kt][i]);
        mx = fmaxf(mx, __shfl_xor(mx, 32));
        const float mnew = fmaxf(m, mx), alpha = ex2(m - mnew); m = mnew;
        float rs = 0.f;
#pragma unroll
        for (int kt = 0; kt < 2; ++kt)
#pragma unroll
            for (int i = 0; i < 16; ++i) { const float p = ex2(st[kt][i] - mnew); st[kt][i] = p; rs += p; }
        rs += __shfl_xor(rs, 32);
        l = l * alpha + rs;
#pragma unroll
        for (int c = 0; c < 4; ++c)
#pragma unroll
            for (int i = 0; i < 16; ++i) o[c][i] *= alpha;
#pragma unroll
        for (int kt = 0; kt < 2; ++kt) {
            const bf16x8 p0 = pack_step<0>(st[kt]), p1 = pack_step<1>(st[kt]);
#pragma unroll
            for (int c = 0; c < 4; ++c) { o[c] = MFMA32(tr_frag_perm(imgV, 64 * kh + 32 * kt, lane, c, 0), p0, o[c]); o[c] = MFMA32(tr_frag_perm(imgV, 64 * kh + 32 * kt, lane, c, 1), p1, o[c]); }
        }
        }
    }
    const float inv = 1.0f / l;
#pragma unroll
    for (int c = 0; c < 4; ++c)
#pragma unroll
        for (int g4 = 0; g4 < 4; ++g4) { v2u w; w.x = pk2(o[c][4 * g4] * inv, o[c][4 * g4 + 1] * inv); w.y = pk2(o[c][4 * g4 + 2] * inv, o[c][4 * g4 + 3] * inv);
            *(GAS v2u*)(optr + (size_t)r * opitch + 32 * c + 8 * g4 + 4 * h) = w; }
}

DI void ret_kv_unit(LAS unsigned char* lds, const bf16* kg, const bf16* vg, size_t pitch, bf16* STf, bf16* STb, float lf2, float lb2, int tid) {
    const int lane = tid & 63, w = __builtin_amdgcn_readfirstlane(tid >> 6), r = lane & 31, h = lane >> 5;
    __syncthreads();
    stage_tile(lds, vg, pitch, tid);
    stage_tile_scaled(lds + 32768, kg, pitch, tid, 127.f * lf2, -lf2);
    stage_tile_scaled(lds + 65536, kg, pitch, tid, 0.f, lb2);
    __syncthreads();
    const int dir = w & 1, ce = w >> 1;
    const LAS unsigned char* imgK = lds + 32768 + dir * 32768;
    f32x16 acc[4];
#pragma unroll
    for (int c = 0; c < 4; ++c)
#pragma unroll
        for (int i = 0; i < 16; ++i) acc[c][i] = 0.f;
#pragma unroll
    for (int ks = 0; ks < 8; ++ks) { const bf16x8 bfr = tr_frag_nat(lds, 0, lane, ce, ks);
#pragma unroll
        for (int cd = 0; cd < 4; ++cd) acc[cd] = MFMA32(tr_frag_nat(imgK, 0, lane, cd, ks), bfr, acc[cd]); }
    bf16* dst = (dir ? STb : STf) + (size_t)(32 * ce + r) * 128 + 4 * h;
#pragma unroll
    for (int cd = 0; cd < 4; ++cd)
#pragma unroll
        for (int g4 = 0; g4 < 4; ++g4) { v2u x; x.x = pk2(acc[cd][4 * g4], acc[cd][4 * g4 + 1]); x.y = pk2(acc[cd][4 * g4 + 2], acc[cd][4 * g4 + 3]); *(GAS v2u*)(dst + 32 * cd + 8 * g4) = x; }
}
DI void ret_scan(bf16* ST, int nseq, int nchunk, const float* dec_f, const float* dec_b, int gtid, int nthreads) {
    const int ntask = nseq * 32 * 2048;
    for (int task = gtid; task < ntask; task += nthreads) {
        const int chain = task >> 11, eo = (task & 2047) * 8, seq = chain >> 5, hh = (chain >> 1) & 15, dir = chain & 1;
        const float lg = -expf(dir ? dec_b[hh] : dec_f[hh]), cd = ex2(128.f * lg * LOG2E);
        float s[8];
#pragma unroll
        for (int e = 0; e < 8; ++e) s[e] = 0.f;
        const ptrdiff_t cstride = (ptrdiff_t)16 * 2 * 16384 * (dir ? -1 : 1);
        bf16* p = ST + ((size_t)((seq * nchunk + (dir ? nchunk - 1 : 0)) * 16 + hh) * 2 + dir) * 16384 + eo;
        for (int cc = 0; cc < nchunk; cc += 4) {
            v4u v[4];
#pragma unroll
            for (int u = 0; u < 4; ++u) v[u] = *(const GAS v4u*)(p + u * cstride);
#pragma unroll
            for (int u = 0; u < 4; ++u) {
                v4u o; o.x = pk2(s[0], s[1]); o.y = pk2(s[2], s[3]); o.z = pk2(s[4], s[5]); o.w = pk2(s[6], s[7]);
                *(GAS v4u*)(p + u * cstride) = o;
                s[0] = s[0] * cd + bflo(v[u].x); s[1] = s[1] * cd + bfhi(v[u].x); s[2] = s[2] * cd + bflo(v[u].y); s[3] = s[3] * cd + bfhi(v[u].y);
                s[4] = s[4] * cd + bflo(v[u].z); s[5] = s[5] * cd + bfhi(v[u].z); s[6] = s[6] * cd + bflo(v[u].w); s[7] = s[7] * cd + bfhi(v[u].w);
            }
            p += 4 * cstride;
        }
    }
}
DI void ret_out_unit(LAS unsigned char* lds, LAS float* part, const bf16* qg, const bf16* kg, const bf16* vg, const bf16* gg, size_t pitch, const bf16* RfT, const bf16* RbT,
                     bf16* yg, size_t ypitch, float lf2, float lb2, int tid) {
    const int lane = tid & 63, w = __builtin_amdgcn_readfirstlane(tid >> 6), r = lane & 31, h = lane >> 5;
    __syncthreads();
    stage_tile(lds, kg, pitch, tid);
    stage_tile(lds + 32768, vg, pitch, tid);
    stage_tile(lds + 65536, RfT, 128, tid);
    stage_tile(lds + 98304, RbT, 128, tid);
    const int i = 32 * (w & 3) + r, eh = w >> 2;
    bf16x8 qf[8];
#pragma unroll
    for (int ks = 0; ks < 8; ++ks) qf[ks] = *(const GAS bf16x8*)(qg + (size_t)i * pitch + 16 * ks + 8 * h);
    __syncthreads();
    f32x16 y[2];
    {
        f32x16 cf[2], cb[2];
#pragma unroll
        for (int c2 = 0; c2 < 2; ++c2)
#pragma unroll
            for (int q = 0; q < 16; ++q) { cf[c2][q] = 0.f; cb[c2][q] = 0.f; }
#pragma unroll
        for (int ks = 0; ks < 8; ++ks)
#pragma unroll
            for (int c2 = 0; c2 < 2; ++c2) { cf[c2] = MFMA32(row_frag(lds + 65536, 32 * (2 * eh + c2), lane, ks), qf[ks], cf[c2]); cb[c2] = MFMA32(row_frag(lds + 98304, 32 * (2 * eh + c2), lane, ks), qf[ks], cb[c2]); }
        const float xf = ex2((float)(i + 1) * lf2), xb = ex2((float)(128 - i) * lb2);
#pragma unroll
        for (int c2 = 0; c2 < 2; ++c2)
#pragma unroll
            for (int q = 0; q < 16; ++q) y[c2][q] = xf * cf[c2][q] + xb * cb[c2][q];
    }
#pragma unroll
    for (int jt = 0; jt < 4; ++jt) {
        f32x16 st;
#pragma unroll
        for (int q = 0; q < 16; ++q) st[q] = 0.f;
#pragma unroll
        for (int ks = 0; ks < 8; ++ks) st = MFMA32(row_frag(lds, 32 * jt, lane, ks), qf[ks], st);
#pragma unroll
        for (int q = 0; q < 16; ++q) { const int d = i - (32 * jt + crow(q, h)); const float f = ex2((float)d * (d >= 0 ? lf2 : -lb2)); st[q] *= f; }
        const bf16x8 p0 = pack_step<0>(st), p1 = pack_step<1>(st);
#pragma unroll
        for (int c2 = 0; c2 < 2; ++c2) { y[c2] = MFMA32(tr_frag_perm(lds + 32768, 32 * jt, lane, 2 * eh + c2, 0), p0, y[c2]); y[c2] = MFMA32(tr_frag_perm(lds + 32768, 32 * jt, lane, 2 * eh + c2, 1), p1, y[c2]); }
    }
    float ss = 0.f;
#pragma unroll
    for (int c2 = 0; c2 < 2; ++c2)
#pragma unroll
        for (int q = 0; q < 16; ++q) ss += y[c2][q] * y[c2][q];
    ss += __shfl_xor(ss, 32);
    if (h == 0) part[w * 32 + r] = ss;
    __syncthreads();
    const float tot = part[w * 32 + r] + part[(w ^ 4) * 32 + r];
    const float rstd = 1.0f / sqrtf(tot * (1.f / 128.f) + RMS_EPS);
#pragma unroll
    for (int c2 = 0; c2 < 2; ++c2)
#pragma unroll
        for (int g4 = 0; g4 < 4; ++g4) { const int e0 = 32 * (2 * eh + c2) + 8 * g4 + 4 * h;
            const v2u gv = *(const GAS v2u*)(gg + (size_t)i * pitch + e0);
            v2u x; x.x = pk2(y[c2][4 * g4] * rstd * bflo(gv.x), y[c2][4 * g4 + 1] * rstd * bfhi(gv.x)); x.y = pk2(y[c2][4 * g4 + 2] * rstd * bflo(gv.y), y[c2][4 * g4 + 3] * rstd * bfhi(gv.y));
            *(GAS v2u*)(yg + (size_t)i * ypitch + e0) = x; }
}
struct Args { const float* in[20]; float* out; unsigned char* ws; int ph_lo, ph_hi, li, pad; };
DI int t5_bucket(int rel) {
    const int n = rel < 0 ? -rel : rel;
    const int b = n < 8 ? n : n < 12 ? 8 : n < 16 ? 9 : n < 23 ? 10 : n < 32 ? 11 : n < 46 ? 12 : n < 64 ? 13 : n < 91 ? 14 : 15;
    return b + (rel > 0 ? 16 : 0);
}

__global__ void __launch_bounds__(NTHREADS, 2) hymba_fwd(Args args) {
    extern __shared__ __attribute__((aligned(16))) unsigned char lds[];
    Frame F;
    F.lds = (LAS unsigned char*)lds;
    F.MISC = (volatile LAS unsigned*)(F.lds + MISC_OFF);
    F.tid = threadIdx.x; F.lane = F.tid & 63; F.wave = __builtin_amdgcn_readfirstlane(F.tid >> 6);
    F.G = gridDim.x; { const int bx = blockIdx.x; F.vcu = (F.G % 8 == 0) ? (bx % 8) * (F.G / 8) + bx / 8 : bx; }
    F.ws = args.ws;
    F.ctl = (gu32*)(F.ws + WS_CTL);
    unsigned char* const ws = args.ws;
    for (int u = F.tid; u < (LDS_BYTES - LDSCTL_OFF) / 4; u += NTHREADS) ((LAS unsigned*)(F.lds + LDSCTL_OFF))[u] = 0u;
    __syncthreads();
    XcdBarrier bar; bar.bar = (unsigned*)(F.ctl + CW_BAR); bar.x = 0; bar.st = nullptr;
    if (N_LAUNCHES == 1) bar = xcd_barrier_post((unsigned*)(F.ctl + CW_BAR), F.MISC + 8);
#define GRID_BAR() do { if (N_LAUNCHES == 1) { xcd_barrier(bar); } } while (0)
    const int lo = args.ph_lo, hi = args.ph_hi;
#ifndef PHMASK
#define PHMASK 0x1fffff
#endif
#define IN(k) ((((PHMASK) >> (k)) & 1) && lo <= (k) && (k) < hi)
#define BOTH(k) (IN(k) && IN((k) + 1))
    const int gw = F.vcu * NWAVES + F.wave, NGW = F.G * NWAVES;
    const int gtid = blockIdx.x * NTHREADS + F.tid, NT = F.G * NTHREADS;
    float* const out = args.out;
    bf16* const XN = (bf16*)(ws + WS_XN);
    float* const COS = (float*)(ws + WS_COS); float* const SIN = (float*)(ws + WS_SIN); float* const TB = (float*)(ws + WS_TB);
    LAS float* const ltab = (LAS float*)(F.lds + TAB_OFF);

    if (IN(0)) {
        LAS float* scr = (LAS float*)(F.lds + RING_OFF + F.wave * 16384);
        constexpr int I_IN = (DM / 64) * (INW / 32), I_OUT = (DM / 64) * (DM / 32), I_CQ = (DM / 64) * (MEMW / 32), I_CKV = (DM / 64) * (2 * MEMW / 32), I_CO = (MEMW / 64) * (DM / 32),
                      I_1 = (DM / 64) * (DFF / 32), I_2 = (DFF / 64) * (DM / 32);
        constexpr int NITEMS = I_IN + I_OUT + I_CQ + I_CKV + I_CO + I_1 + I_2;
        for (int it = gw; it < NITEMS; it += NGW) {
            int r = it;
            if (r < I_IN) { p0_transpose_item<true>(args.in[5], DM, INW, (bf16*)(ws + WS_WIN), scr, r, F.lane); continue; } r -= I_IN;
            if (r < I_OUT) { p0_transpose_item<false>(args.in[10], DM, DM, (bf16*)(ws + WS_WOUT), scr, r, F.lane); continue; } r -= I_OUT;
            if (r < I_CQ) { p0_transpose_item<false>(args.in[13], DM, MEMW, (bf16*)(ws + WS_WCQ), scr, r, F.lane); continue; } r -= I_CQ;
            if (r < I_CKV) { p0_transpose_item<false>(args.in[14], DM, 2 * MEMW, (bf16*)(ws + WS_WCKV), scr, r, F.lane); continue; } r -= I_CKV;
            if (r < I_CO) { p0_transpose_item<false>(args.in[15], MEMW, DM, (bf16*)(ws + WS_WCO), scr, r, F.lane); continue; } r -= I_CO;
            if (r < I_1) { p0_transpose_item<false>(args.in[17], DM, DFF, (bf16*)(ws + WS_W1), scr, r, F.lane); continue; } r -= I_1;
            p0_transpose_item<false>(args.in[18], DFF, DM, (bf16*)(ws + WS_W2), scr, r, F.lane);
        }
        for (int e = gtid; e < 8192 * 64; e += NT) { const int pos = e >> 6, i = e & 63;
            const float inv = exp2f(-(float)i * (13.287712379549449f / 64.0f));
            const float ang = (float)pos * inv;
            double rev = (double)ang * 0.15915494309189535; rev -= floor(rev);
            const float rf = (float)rev;
            COS[e] = __builtin_amdgcn_cosf(rf); SIN[e] = __builtin_amdgcn_sinf(rf); }
        for (int e = gtid; e < 16 * TBW; e += NT) { const int hh = e / TBW, idx = e % TBW; const int rel = idx - 128;
            TB[e] = (idx <= 256) ? args.in[9][t5_bucket(rel) * 16 + hh] * LOG2E : 0.f; }
        for (int m = gw; m < NTOK; m += NGW) { const float* src = (m < HTOK) ? args.in[0] + (size_t)m * DM : args.in[1] + (size_t)(m - HTOK) * DM; rms_row_to_bf16(src, args.in[4], XN + (size_t)m * DM, F.lane); }
        for (int m = gw; m < NMEM; m += NGW) { const float* src = (m < 1024) ? args.in[2] + (size_t)m * DM : args.in[3] + (size_t)(m - 1024) * DM; rms_row_to_bf16(src, args.in[12], (bf16*)(ws + WS_MEMN) + (size_t)m * DM, F.lane); }
        if (BOTH(0)) GRID_BAR();
    }

#pragma unroll
    for (int g = 0; g < 2; ++g) {
        const int pb = 1 + 5 * g;
        const int nbs = g ? 64 : 32, nseq = g ? 2 : 4;
        bf16* const PROJ = (bf16*)(ws + WS_PROJ); bf16* const Y = (bf16*)(ws + WS_Y); bf16* const ST = (bf16*)(ws + WS_ST);
        if (IN(pb)) {
            pg8::Gemm gm{XN + (size_t)g * HTOK * DM, (const bf16*)(ws + WS_WIN), HTOK, INW, DM}; pg8::StaticOrder S; S.init(HTOK, INW, F.G, (int)blockIdx.x);
            pg8::EpiProj E{PROJ, INW, COS, SIN, g ? 8191 : 4095};
            pg8::gemm_phase<pg8::EpiProj, pg8::StaticOrder, PG8_ALIGN, PG8_SP2>(F.lds + RING_OFF, gm, S, E);
            if (BOTH(pb)) GRID_BAR();
        }
        if (IN(pb + 1)) {
            int tid = threadIdx.x; asm volatile("" : "+v"(tid)); const int wave = __builtin_amdgcn_readfirstlane(tid >> 6), lane = tid & 63;
            for (int u = blockIdx.x; u < 2048; u += F.G) { const int hh = u & 15, c = u >> 4;
                const float lf2 = -expf(args.in[6][hh]) * LOG2E, lb2 = -expf(args.in[7][hh]) * LOG2E;
                const bf16* rowp = PROJ + (size_t)c * 128 * INW;
                bf16* stp = ST + (size_t)(c * 16 + hh) * 2 * 16384;
                ret_kv_unit(F.lds, rowp + RETW + hh * HD, rowp + 2 * RETW + hh * HD, INW, stp, stp + 16384, lf2, lb2, tid);
            }
            for (int u = blockIdx.x; u < 1024; u += F.G) { const int hp = u & 7, R = u >> 3, nb = R % nbs;
                const int hq = 2 * hp + (wave >> 2), kvh = hp >> 1;
                __syncthreads();
                for (int e = tid; e < 2 * TBW; e += NTHREADS) ltab[e] = TB[(2 * hp) * TBW + e];
                const bf16* rowp = PROJ + (size_t)R * 128 * INW;
                const int qr = 32 * (wave & 3);
                attn_unit<true>(F.lds, ltab + (wave >> 2) * TBW, rowp + (size_t)qr * INW + QA_OFF + hq * HD, INW, rowp + KA_OFF + kvh * HD, rowp + VA_OFF + kvh * HD, INW,
                                nb == 0 ? 0 : -1, nb == nbs - 1 ? 1 : 2, Y + (size_t)(R * 128 + qr) * DM + RETW + hq * HD, DM, args.in[8][hq] * LOG2E, 1.0f, qr + (lane & 31), tid);
            }
            if (BOTH(pb + 1)) GRID_BAR();
        }
        if (IN(pb + 2)) { ret_scan(ST, nseq, nbs, args.in[6], args.in[7], gtid, NT); if (BOTH(pb + 2)) GRID_BAR(); }
        if (IN(pb + 3)) {
            int tid = threadIdx.x; asm volatile("" : "+v"(tid));
            for (int u = blockIdx.x; u < 2048; u += F.G) { const int hh = u & 15, c = u >> 4;
                const float lf2 = -expf(args.in[6][hh]) * LOG2E, lb2 = -expf(args.in[7][hh]) * LOG2E;
                const bf16* rowp = PROJ + (size_t)c * 128 * INW;
                const bf16* stp = ST + (size_t)(c * 16 + hh) * 2 * 16384;
                ret_out_unit(F.lds, ltab, rowp + hh * HD, rowp + RETW + hh * HD, rowp + 2 * RETW + hh * HD, rowp + 3 * RETW + hh * HD, INW, stp, stp + 16384,
                             Y + (size_t)c * 128 * DM + hh * HD, DM, lf2, lb2, tid);
            }
            if (BOTH(pb + 3)) GRID_BAR();
        }
        if (IN(pb + 4)) {
            pg8::Gemm gm{Y, (const bf16*)(ws + WS_WOUT), HTOK, DM, DM}; pg8::StaticOrder S; S.init(HTOK, DM, F.G, (int)blockIdx.x);
            pg8::EpiRes E{args.in[g], out + (size_t)g * HTOK * DM, DM};
            pg8::gemm_phase<pg8::EpiRes, pg8::StaticOrder, PG8_ALIGN, PG8_SP2>(F.lds + RING_OFF, gm, S, E);
            if (BOTH(pb + 4)) GRID_BAR();
        }
    }

    if (IN(11)) {
        { pg8::Gemm gm{(const bf16*)(ws + WS_MEMN), (const bf16*)(ws + WS_WCKV), NMEM, 2 * MEMW, DM}; pg8::StaticOrder S; S.init(NMEM, 2 * MEMW, F.G, (int)blockIdx.x);
          pg8::EpiBf16S<0> E{(bf16*)(ws + WS_KVM), 2 * MEMW, 1.0f};
          pg8::gemm_phase<pg8::EpiBf16S<0>, pg8::StaticOrder, PG8_ALIGN, PG8_SP2>(F.lds + RING_OFF, gm, S, E); }
        for (int m = gw; m < NTOK; m += NGW) rms_row_to_bf16(out + (size_t)m * DM, args.in[11], XN + (size_t)m * DM, F.lane);
        if (BOTH(11)) GRID_BAR();
    }
    if (IN(12)) {
        pg8::Gemm gm{XN, (const bf16*)(ws + WS_WCQ), NTOK, MEMW, DM}; pg8::StaticOrder S; S.init(NTOK, MEMW, F.G, (int)blockIdx.x);
        pg8::EpiBf16S<0> E{(bf16*)(ws + WS_QC), MEMW, 0.12751743074602224f};
        pg8::gemm_phase<pg8::EpiBf16S<0>, pg8::StaticOrder, PG8_ALIGN, PG8_SP2>(F.lds + RING_OFF, gm, S, E);
        if (BOTH(12)) GRID_BAR();
    }
    if (IN(13)) {
        int tid = threadIdx.x; asm volatile("" : "+v"(tid)); const int wave = __builtin_amdgcn_readfirstlane(tid >> 6);
        const bf16* QC = (const bf16*)(ws + WS_QC); const bf16* KVM = (const bf16*)(ws + WS_KVM); bf16* OC = (bf16*)(ws + WS_OC);
        for (int u = blockIdx.x; u < 512; u += F.G) { const int hd = u & 3, tile = u >> 2, row0 = tile * 256;
            const int mrow = row0 < HTOK ? (row0 >> 12) * 256 : 1024 + ((row0 - HTOK) >> 13) * 256;
            const int qr = row0 + 32 * wave;
            attn_unit<false>(F.lds, ltab, QC + (size_t)qr * MEMW + hd * HD, MEMW, KVM + (size_t)mrow * (2 * MEMW) + hd * HD, KVM + (size_t)mrow * (2 * MEMW) + MEMW + hd * HD, 2 * MEMW,
                             0, 2, OC + (size_t)qr * MEMW + hd * HD, MEMW, -1e30f, 0.0f, 0, tid);
        }
        if (BOTH(13)) GRID_BAR();
    }
    if (IN(14)) {
        pg8::Gemm gm{(const bf16*)(ws + WS_OC), (const bf16*)(ws + WS_WCO), NTOK, DM, MEMW}; pg8::StaticOrder S; S.init(NTOK, DM, F.G, (int)blockIdx.x);
        pg8::EpiRes E{out, out, DM};
        pg8::gemm_phase<pg8::EpiRes, pg8::StaticOrder, PG8_ALIGN, PG8_SP2>(F.lds + RING_OFF, gm, S, E);
        if (BOTH(14)) GRID_BAR();
    }
    if (IN(15)) {
        for (int m = gw; m < NTOK; m += NGW) rms_row_to_bf16(out + (size_t)m * DM, args.in[16], XN + (size_t)m * DM, F.lane);
        if (BOTH(15)) GRID_BAR();
    }
#pragma unroll
    for (int g = 0; g < 2; ++g) {
        bf16* const HID = (bf16*)(ws + WS_HID);
        if (IN(16 + 2 * g)) {
            pg8::Gemm gm{XN + (size_t)g * HTOK * DM, (const bf16*)(ws + WS_W1), HTOK, DFF, DM}; pg8::StaticOrder S; S.init(HTOK, DFF, F.G, (int)blockIdx.x);
            pg8::EpiBf16S<1> E{HID, DFF, 1.0f};
            pg8::gemm_phase<pg8::EpiBf16S<1>, pg8::StaticOrder, PG8_ALIGN, PG8_SP2>(F.lds + RING_OFF, gm, S, E);
            if (BOTH(16 + 2 * g)) GRID_BAR();
        }
        if (IN(17 + 2 * g)) {
            pg8::Gemm gm{HID, (const bf16*)(ws + WS_W2), HTOK, DM, DFF}; pg8::StaticOrder S; S.init(HTOK, DM, F.G, (int)blockIdx.x);
            pg8::EpiRes E{out + (size_t)g * HTOK * DM, out + (size_t)g * HTOK * DM, DM};
            pg8::gemm_phase<pg8::EpiRes, pg8::StaticOrder, PG8_ALIGN, PG8_SP2>(F.lds + RING_OFF, gm, S, E);
            if (BOTH(17 + 2 * g)) GRID_BAR();
        }
    }
    if (IN(20)) {
        const bool poison = (N_LAUNCHES == 1) && (__hip_atomic_load((gu32*)((unsigned*)(F.ctl + CW_BAR) + XB_TMO), RLX_AGENT) != 0u);
        for (int m = gw; m < NTOK; m += NGW) rms_row_to_f32(out + (size_t)m * DM, args.in[19], out + (size_t)m * DM, F.lane, poison);
    }
#undef IN
#undef BOTH
}

extern "C" void kernel_launch(void* const* d_in, const int* in_sizes, int n_in, void* d_out, int out_size, void* d_ws, size_t ws_size, hipStream_t stream) {
    static int grid = 0;
    if (grid == 0) {
        if (n_in != 20 || out_size != NTOK * DM || ws_size < WS_END) { fprintf(stderr, "kernel_launch: shape/workspace mismatch (n_in %d, out %d, ws %zu, need %zu); nothing launched\n", n_in, out_size, ws_size, (size_t)WS_END); grid = -1; return; }
        int dev = 0, cus = 0, per_cu = 0;
        if (hipGetDevice(&dev) != hipSuccess || hipDeviceGetAttribute(&cus, hipDeviceAttributeMultiprocessorCount, dev) != hipSuccess) { grid = -1; return; }
        if (hipFuncSetAttribute((const void*)hymba_fwd, hipFuncAttributeMaxDynamicSharedMemorySize, LDS_BYTES) != hipSuccess) { fprintf(stderr, "kernel_launch: hipFuncSetAttribute failed\n"); grid = -1; return; }
        if (hipOccupancyMaxActiveBlocksPerMultiprocessor(&per_cu, (const void*)hymba_fwd, NTHREADS, LDS_BYTES) != hipSuccess || per_cu < 1)
            fprintf(stderr, "kernel_launch: note: occupancy query reports %d workgroups per CU\n", per_cu);
        (void)hipGetLastError();
        grid = cus;
    }
    if (grid < 0) return;
    if (hipMemsetAsync((char*)d_ws + WS_CTL, 0, CTL_ZERO_BYTES, stream) != hipSuccess) return;
    Args a{};
    for (int i = 0; i < 20; ++i) a.in[i] = (const float*)d_in[i];
    a.out = (float*)d_out; a.ws = (unsigned char*)d_ws; a.pad = 0;
    for (int li = 0; li < N_LAUNCHES; ++li) {
        a.ph_lo = (N_LAUNCHES == 1) ? 0 : li; a.ph_hi = (N_LAUNCHES == 1) ? NPHASE : li + 1; a.li = li;
        hipLaunchKernelGGL(hymba_fwd, dim3(grid), dim3(NTHREADS), LDS_BYTES, stream, a);
        const hipError_t le = hipPeekAtLastError();
        if (le != hipSuccess) { fprintf(stderr, "kernel_launch: launch %d failed: %s\n", li, hipGetErrorName(le)); break; }
    }
}
```

```cpp
#include <hip/hip_runtime.h>
#include <cstdio>
#include <cstdint>
namespace pg8 {
#define PG8_LAS __attribute__((address_space(3)))
typedef unsigned short bf16_t;
typedef short bf16x8 __attribute__((ext_vector_type(8)));
typedef float f32x4 __attribute__((ext_vector_type(4)));
typedef unsigned u32x4 __attribute__((ext_vector_type(4)));
constexpr int BM = 256, BK = 64, HALF = 128, HTB = HALF * BK * 2  , STAGE_BYTES = 8 * HTB, NXCD = 8, WGM = 8;

__host__ __device__ __forceinline__ int lds_byte(int r, int c) { const int st = (r >> 4) * 2 + (c >> 5), rr = r & 15, cc = c & 31, ob = rr * 64 + cc * 2; return st * 1024 + (ob ^ (((ob >> 9) & 1) << 5)); }
__host__ __device__ __forceinline__ void stage_rc(int b, int& R, int& C) { const int st = b / 1024, sb = b % 1024, swz = sb ^ (((sb >> 9) & 1) << 5); R = (st >> 1) * 16 + swz / 64; C = (st & 1) * 32 + (swz % 64) / 2; }
__host__ __device__ __forceinline__ int perm32(int rho) { const int n = rho >> 4, i = rho & 15; return 8 * (i >> 2) + 4 * n + (i & 3); }

struct Unit { int pm, pn; };
struct Gemm { const bf16_t* A; const bf16_t* Bt; int M, N, K; };

struct StaticOrder {
    int nM, nN, nwg, G, c;
    __host__ __device__ void init(int M, int N, int G_, int c_) { nM = M / BM; nN = N / BM; nwg = nM * nN; G = G_; c = c_; }
    __host__ __device__ bool next(int i, Unit& u) const {
        const long L = (long)i * G + c; if (L >= nwg) return false;
        int wgid = (int)L; { const int q = nwg / NXCD, r = nwg % NXCD, xcd = wgid % NXCD, off = wgid / NXCD; wgid = (xcd < r ? xcd * (q + 1) : r * (q + 1) + (xcd - r) * q) + off; }
        const int nig = WGM * nN, gid = wgid / nig, fm = gid * WGM, gsz = (nM - fm) < WGM ? (nM - fm) : WGM;
        u.pm = fm + ((wgid % nig) % gsz); u.pn = (wgid % nig) / gsz; return true;
    }
    __device__ __forceinline__ void a_ready(const Unit&) const {}
    __device__ __forceinline__ void done(const Unit&) const {}
};

typedef float f32x2 __attribute__((ext_vector_type(2)));
typedef __bf16 bf16x2_t __attribute__((ext_vector_type(2)));
__device__ __forceinline__ unsigned cvt_pk_bf16(float lo, float hi) { f32x2 v = {lo, hi}; bf16x2_t b = __builtin_convertvector(v, bf16x2_t); return __builtin_bit_cast(unsigned, b); }
__device__ __forceinline__ u32x4 pack8(const f32x4& v0, const f32x4& v1) { u32x4 w; w.x = cvt_pk_bf16(v0[0], v0[1]); w.y = cvt_pk_bf16(v0[2], v0[3]); w.z = cvt_pk_bf16(v1[0], v1[1]); w.w = cvt_pk_bf16(v1[2], v1[3]); return w; }

template <int ACT, bool RS> struct EpiBf16S {
    static constexpr bool PERM = true, AFTER_DRAIN = false;
    bf16_t* O; int ldc; float scale; const float* ss;
    __device__ __forceinline__ void operator()(const f32x4 (&acc)[2][2][4][2], const Unit& u, int wr, int wc, int fr, int fq) const {
        const int row0 = u.pm * BM + wr * 64 + fr, col0 = u.pn * BM + wc * 32 + 8 * fq;
#pragma unroll
        for (int ai = 0; ai < 2; ++ai)
#pragma unroll
            for (int m = 0; m < 4; ++m) { const int row = row0 + ai * HALF + m * 16; bf16_t* rowp = O + (size_t)row * ldc + col0;
                float rs = scale;
                if (RS) rs = scale * __builtin_amdgcn_rsqf(ss[row] * (1.0f / 4096.0f) + 1e-6f);
#pragma unroll
                for (int bj = 0; bj < 2; ++bj) { f32x4 v0 = acc[ai][bj][m][0] * rs, v1 = acc[ai][bj][m][1] * rs;
                    if (ACT == 1) {
#pragma unroll
                        for (int e = 0; e < 4; ++e) { const float a = fmaxf(v0[e], 0.f), b = fmaxf(v1[e], 0.f); v0[e] = a * a; v1[e] = b * b; } }
                    *(u32x4*)(rowp + bj * HALF) = pack8(v0, v1); } }
    }
};
template <bool BASE_F32> struct EpiResB {
    static constexpr bool PERM = true, AFTER_DRAIN = false;
    const float* basef; bf16_t* X; int ldc; float* ss;
    __device__ __forceinline__ void operator()(const f32x4 (&acc)[2][2][4][2], const Unit& u, int wr, int wc, int fr, int fq) const {
        const int row0 = u.pm * BM + wr * 64 + fr, col0 = u.pn * BM + wc * 32 + 8 * fq;
#pragma unroll
        for (int ai = 0; ai < 2; ++ai)
#pragma unroll
            for (int m = 0; m < 4; ++m) { const int row = row0 + ai * HALF + m * 16; const size_t off = (size_t)row * ldc + col0;
                f32x4 b[2][2];
                if (BASE_F32) {
#pragma unroll
                    for (int bj = 0; bj < 2; ++bj) { b[bj][0] = *(const f32x4*)(basef + off + bj * HALF); b[bj][1] = *(const f32x4*)(basef + off + bj * HALF + 4); }
                } else {
#pragma unroll
                    for (int bj = 0; bj < 2; ++bj) { const u32x4 w = *(const u32x4*)(X + off + bj * HALF);
                        b[bj][0] = (f32x4){__uint_as_float(w.x << 16), __uint_as_float(w.x & 0xffff0000u), __uint_as_float(w.y << 16), __uint_as_float(w.y & 0xffff0000u)};
                        b[bj][1] = (f32x4){__uint_as_float(w.z << 16), __uint_as_float(w.z & 0xffff0000u), __uint_as_float(w.w << 16), __uint_as_float(w.w & 0xffff0000u)}; }
                }
                float s = 0.f;
#pragma unroll
                for (int bj = 0; bj < 2; ++bj) { const f32x4 v0 = b[bj][0] + acc[ai][bj][m][0], v1 = b[bj][1] + acc[ai][bj][m][1];
                    s += (v0[0] * v0[0] + v0[1] * v0[1]) + (v0[2] * v0[2] + v0[3] * v0[3]) + (v1[0] * v1[0] + v1[1] * v1[1]) + (v1[2] * v1[2] + v1[3] * v1[3]);
                    *(u32x4*)(X + off + bj * HALF) = pack8(v0, v1); }
                s += __shfl_xor(s, 16); s += __shfl_xor(s, 32);
                if (fq == 0) (void)__hip_atomic_fetch_add(ss + row, s, __ATOMIC_RELAXED, __HIP_MEMORY_SCOPE_AGENT); }
    }
};
struct EpiProj {
    static constexpr bool PERM = true, AFTER_DRAIN = false;
    bf16_t* O; int ldc; const float* cs; const float* sn; int posmask;
    __device__ __forceinline__ void operator()(const f32x4 (&acc)[2][2][4][2], const Unit& u, int wr, int wc, int fr, int fq) const {
        const int row0 = u.pm * BM + wr * 64 + fr, col0 = u.pn * BM + wc * 32 + 8 * fq;
        const int sec = u.pn >> 3;
        const int i0 = 16 * wc + 4 * fq;
#pragma unroll
        for (int ai = 0; ai < 2; ++ai)
#pragma unroll
            for (int m = 0; m < 4; ++m) { const int row = row0 + ai * HALF + m * 16; bf16_t* rowp = O + (size_t)row * ldc + col0;
                f32x4 c4 = (f32x4){1.f, 1.f, 1.f, 1.f}, s4 = (f32x4){0.f, 0.f, 0.f, 0.f};
                if (sec < 2) { const int pos = row & posmask; c4 = *(const f32x4*)(cs + (size_t)pos * 64 + i0); s4 = *(const f32x4*)(sn + (size_t)pos * 64 + i0);
                    if (sec == 1) { c4 = c4 * 0.08838834764831845f; s4 = s4 * 0.08838834764831845f; } }
#pragma unroll
                for (int bj = 0; bj < 2; ++bj) { f32x4 v0 = acc[ai][bj][m][0], v1 = acc[ai][bj][m][1];
                    if (sec < 2) {
                        f32x4 o0, o1;
                        o0[0] = v0[0] * c4[0] - v0[1] * s4[0]; o0[1] = v0[0] * s4[0] + v0[1] * c4[0];
                        o0[2] = v0[2] * c4[1] - v0[3] * s4[1]; o0[3] = v0[2] * s4[1] + v0[3] * c4[1];
                        o1[0] = v1[0] * c4[2] - v1[1] * s4[2]; o1[1] = v1[0] * s4[2] + v1[1] * c4[2];
                        o1[2] = v1[2] * c4[3] - v1[3] * s4[3]; o1[3] = v1[2] * s4[3] + v1[3] * c4[3];
                        v0 = o0; v1 = o1;
                    } else if (sec == 3) {
#pragma unroll
                        for (int e = 0; e < 4; ++e) { v0[e] = v0[e] * __builtin_amdgcn_rcpf(1.f + __builtin_amdgcn_exp2f(-1.4426950408889634f * v0[e]));
                                                      v1[e] = v1[e] * __builtin_amdgcn_rcpf(1.f + __builtin_amdgcn_exp2f(-1.4426950408889634f * v1[e])); }
                    } else if (sec == 4) { v0 = v0 * 0.12751743074602224f; v1 = v1 * 0.12751743074602224f; }
                    *(u32x4*)(rowp + bj * HALF) = pack8(v0, v1); } }
    }
};
template <class Epi, class Sched, bool ALIGN_EPI = false, bool SP2 = false>
__device__ __forceinline__ void gemm_phase(PG8_LAS unsigned char* lds, const Gemm g, const Sched& S, const Epi& E) {
    int tid_ = threadIdx.x; asm volatile("" : "+v"(tid_));
    const int tid = tid_, wid = __builtin_amdgcn_readfirstlane(tid >> 6), lane = tid & 63, wr = wid >> 2, wc = wid & 3, fr = lane & 15, fq = lane >> 4;
    const int K = g.K, nt = K / BK;
    unsigned voffA[2], voffB[2];
#pragma unroll
    for (int i = 0; i < 2; ++i) { int R, C; stage_rc(tid * 16 + i * 8192, R, C); const int Rb = Epi::PERM ? ((R & ~31) + perm32(R & 31)) : R;
        voffA[i] = (unsigned)(R * K + C) * 2u; voffB[i] = (unsigned)(Rb * K + C) * 2u; }
    const size_t kstep = (size_t)(BK * 2);
    const size_t hstep = (size_t)HALF * K * 2;
    const size_t tstep = 2 * hstep;
    const unsigned ldsw = (unsigned)wid * 1024u;
    const int aoff = lds_byte(wr * 64 + fr, fq * 8), boff = lds_byte(wc * 32 + fr, fq * 8);
#define PG8_SA(b, h) (((b) * 2 + (h)) * HTB)
#define PG8_SB(b, h) ((4 + (b) * 2 + (h)) * HTB)
#define PG8_STAGE(bufoff, gbase, voff) do { _Pragma("unroll") for (int _i = 0; _i < 2; ++_i) \
        __builtin_amdgcn_global_load_lds((const unsigned*)((const char*)(gbase) + (voff)[_i]), (PG8_LAS unsigned*)(lds + (bufoff) + ldsw + _i * 8192), 16, 0, 0); } while (0)
#define PG8_LDA(dst, b, h) do { _Pragma("unroll") for (int m = 0; m < 4; ++m) _Pragma("unroll") for (int k = 0; k < 2; ++k) dst[m][k] = *(const PG8_LAS bf16x8*)(lds + PG8_SA(b, h) + aoff + m * 2048 + k * 1024); } while (0)
#define PG8_LDB(dst, b, h) do { _Pragma("unroll") for (int n = 0; n < 2; ++n) _Pragma("unroll") for (int k = 0; k < 2; ++k) dst[n][k] = *(const PG8_LAS bf16x8*)(lds + PG8_SB(b, h) + boff + n * 2048 + k * 1024); } while (0)
#define PG8_MMA(ai, bj, At, Bt) do { __builtin_amdgcn_s_setprio(1); _Pragma("unroll") for (int m = 0; m < 4; ++m) _Pragma("unroll") for (int n = 0; n < 2; ++n) _Pragma("unroll") for (int k = 0; k < 2; ++k) \
        acc[ai][bj][m][n] = __builtin_amdgcn_mfma_f32_16x16x32_bf16(Bt[n][k], At[m][k], acc[ai][bj][m][n], 0, 0, 0); __builtin_amdgcn_s_setprio(0); } while (0)
#define PG8_WAIT_V(n) asm volatile("s_waitcnt vmcnt(" #n ")" ::: "memory")
#define PG8_WAIT_L(n) asm volatile("s_waitcnt lgkmcnt(" #n ")" ::: "memory")
#define PG8_BAR __builtin_amdgcn_s_barrier()
#define PG8_SCHED __builtin_amdgcn_sched_barrier(0)
    Unit cur, nxt; int ui = 0;
    if (!S.next(0, cur)) return;
    f32x4 acc[2][2][4][2];
#pragma unroll
    for (int a = 0; a < 2; ++a)
#pragma unroll
        for (int b = 0; b < 2; ++b)
#pragma unroll
            for (int m = 0; m < 4; ++m)
#pragma unroll
                for (int n = 0; n < 2; ++n) acc[a][b][m][n] = (f32x4){0.f, 0.f, 0.f, 0.f};
    bf16x8 At[4][2], B0[2][2], B1[2][2];
    const char* cA = (const char*)g.A + (size_t)cur.pm * tstep; const char* cB = (const char*)g.Bt + (size_t)cur.pn * tstep;
    S.a_ready(cur);
    if constexpr (SP2) {
        PG8_STAGE(PG8_SB(0, 0), cB, voffB); PG8_STAGE(PG8_SB(0, 1), cB + hstep, voffB); PG8_STAGE(PG8_SA(0, 0), cA, voffA); PG8_STAGE(PG8_SA(0, 1), cA + hstep, voffA);
        if (wr == 1) PG8_BAR;
        PG8_WAIT_V(2); PG8_BAR;
        PG8_STAGE(PG8_SB(1, 0), cB + kstep, voffB); PG8_STAGE(PG8_SA(1, 0), cA + kstep, voffA); PG8_STAGE(PG8_SB(1, 1), cB + hstep + kstep, voffB);
        PG8_WAIT_V(6); PG8_BAR;
    } else {
        PG8_STAGE(PG8_SB(0, 0), cB, voffB); PG8_STAGE(PG8_SA(0, 0), cA, voffA); PG8_STAGE(PG8_SB(0, 1), cB + hstep, voffB); PG8_STAGE(PG8_SA(0, 1), cA + hstep, voffA);
        if (wr == 1) PG8_BAR;
        PG8_WAIT_V(4); PG8_BAR;
        PG8_STAGE(PG8_SB(1, 0), cB + kstep, voffB); PG8_STAGE(PG8_SA(1, 0), cA + kstep, voffA); PG8_STAGE(PG8_SB(1, 1), cB + hstep + kstep, voffB);
        PG8_WAIT_V(6); PG8_BAR;
    }
    for (;;) {
        const bool has_next = S.next(ui + 1, nxt);
        const char* nA = has_next ? (const char*)g.A + (size_t)nxt.pm * tstep : cA; const char* nB = has_next ? (const char*)g.Bt + (size_t)nxt.pn * tstep : cB;
        for (int t = 0; t < nt; t += 2) {
            const bool last = (t == nt - 2);
            const char* a1 = cA + (size_t)(t + 1) * kstep;
            const char* a2 = last ? nA : cA + (size_t)(t + 2) * kstep; const char* b2 = last ? nB : cB + (size_t)(t + 2) * kstep;
            const char* a3 = a2 + kstep; const char* b3 = b2 + kstep;
            if (last && has_next) S.a_ready(nxt);
            if constexpr (SP2) {
            PG8_LDB(B0, 0, 0); PG8_LDB(B1, 0, 1); PG8_SCHED; PG8_LDA(At, 0, 0); PG8_STAGE(PG8_SA(1, 1), a1 + hstep, voffA);
            PG8_WAIT_V(8); PG8_WAIT_L(0); PG8_BAR; PG8_MMA(0, 0, At, B0); PG8_MMA(0, 1, At, B1); PG8_BAR; PG8_SCHED;
            PG8_LDA(At, 0, 1); PG8_STAGE(PG8_SB(0, 0), b2, voffB); PG8_STAGE(PG8_SB(0, 1), b2 + hstep, voffB); PG8_STAGE(PG8_SA(0, 0), a2, voffA);
            PG8_WAIT_V(8); PG8_WAIT_L(0); PG8_BAR; PG8_MMA(1, 0, At, B0); PG8_MMA(1, 1, At, B1); PG8_BAR; PG8_SCHED;
            PG8_LDB(B0, 1, 0); PG8_LDB(B1, 1, 1); PG8_SCHED; PG8_LDA(At, 1, 0); PG8_STAGE(PG8_SA(0, 1), a2 + hstep, voffA);
            PG8_WAIT_V(8); PG8_WAIT_L(0); PG8_BAR; PG8_MMA(0, 0, At, B0); PG8_MMA(0, 1, At, B1); PG8_BAR; PG8_SCHED;
            PG8_LDA(At, 1, 1); PG8_STAGE(PG8_SB(1, 0), b3, voffB); PG8_STAGE(PG8_SB(1, 1), b3 + hstep, voffB); PG8_STAGE(PG8_SA(1, 0), a3, voffA);
            PG8_WAIT_V(8); PG8_WAIT_L(0); PG8_BAR; PG8_MMA(1, 0, At, B0); PG8_MMA(1, 1, At, B1); PG8_BAR; PG8_SCHED;
            } else {
            PG8_LDB(B0, 0, 0); PG8_SCHED; PG8_LDA(At, 0, 0); PG8_STAGE(PG8_SA(1, 1), a1 + hstep, voffA);
            PG8_WAIT_L(8); PG8_BAR; PG8_WAIT_L(0); PG8_MMA(0, 0, At, B0); PG8_BAR; PG8_SCHED;
            PG8_LDB(B1, 0, 1); PG8_STAGE(PG8_SB(0, 0), b2, voffB);
            PG8_BAR; PG8_WAIT_L(0); PG8_MMA(0, 1, At, B1); PG8_BAR;
            PG8_LDA(At, 0, 1); PG8_STAGE(PG8_SA(0, 0), a2, voffA);
            PG8_BAR; PG8_WAIT_L(0); PG8_MMA(1, 0, At, B0); PG8_BAR; PG8_SCHED;
            PG8_STAGE(PG8_SB(0, 1), b2 + hstep, voffB);
            PG8_WAIT_V(6); PG8_BAR; PG8_MMA(1, 1, At, B1); PG8_BAR;
            PG8_LDB(B0, 1, 0); PG8_SCHED; PG8_LDA(At, 1, 0); PG8_STAGE(PG8_SA(0, 1), a2 + hstep, voffA);
            PG8_WAIT_L(8); PG8_BAR; PG8_WAIT_L(0); PG8_MMA(0, 0, At, B0); PG8_BAR; PG8_SCHED;
            PG8_LDB(B1, 1, 1); PG8_STAGE(PG8_SB(1, 0), b3, voffB);
            PG8_BAR; PG8_WAIT_L(0); PG8_MMA(0, 1, At, B1); PG8_BAR;
            PG8_LDA(At, 1, 1); PG8_STAGE(PG8_SA(1, 0), a3, voffA);
            PG8_BAR; PG8_WAIT_L(0); PG8_MMA(1, 0, At, B0); PG8_BAR; PG8_SCHED;
            PG8_STAGE(PG8_SB(1, 1), b3 + hstep, voffB);
            PG8_WAIT_V(6); PG8_BAR; PG8_MMA(1, 1, At, B1); PG8_BAR;
            }
        }
        if constexpr (ALIGN_EPI) { if (wr == 0) PG8_BAR; }
        if constexpr (!Epi::AFTER_DRAIN) { E(acc, cur, wr, wc, fr, fq); S.done(cur); }
        if (!has_next) break;
#pragma unroll
        for (int a = 0; a < 2; ++a)
#pragma unroll
            for (int b = 0; b < 2; ++b)
#pragma unroll
                for (int m = 0; m < 4; ++m)
#pragma unroll
                    for (int n = 0; n < 2; ++n) acc[a][b][m][n] = (f32x4){0.f, 0.f, 0.f, 0.f};
        cur = nxt; cA = nA; cB = nB; ++ui;
        if constexpr (ALIGN_EPI) { if (wr == 1) PG8_BAR; }
    }
    PG8_WAIT_V(0);
    if constexpr (!ALIGN_EPI) { if (wr == 0) PG8_BAR; }
    PG8_BAR;
    if constexpr (Epi::AFTER_DRAIN) { E.fused(acc, cur, wr, wc, fr, fq, lds, wid, lane); S.done(cur); }
#undef PG8_SA
#undef PG8_SB
#undef PG8_STAGE
#undef PG8_LDA
#undef PG8_LDB
#undef PG8_MMA
#undef PG8_WAIT_V
#undef PG8_WAIT_L
#undef PG8_BAR
#undef PG8_SCHED
}
}
#ifndef PG8_SP2
#define PG8_SP2 true
#endif
#ifndef PG8_ALIGN
#define PG8_ALIGN true
#endif

constexpr int NWAVES = 8, NTHREADS = 512;
constexpr int NPHASE = 19;
#ifndef MK_N_LAUNCHES
#define MK_N_LAUNCHES 1
#endif
constexpr int N_LAUNCHES = MK_N_LAUNCHES;

constexpr int DM = 4096, NTOK = 32768, HTOK = 16384, INW = 11264, DFF = 16384, MEMW = 512, NMEM = 1536, HD = 128;
constexpr int RETW = 2048, QA_OFF = 8192, KA_OFF = 10240, VA_OFF = 10752;
constexpr float RMS_EPS = 1e-6f, LOG2E = 1.4426950408889634f;
constexpr int TBW = 264;

constexpr size_t MiB = 1u << 20;
constexpr size_t WS_CTL = 0, CTL_ZERO_BYTES = 1 * MiB;
constexpr size_t WS_COS = 1 * MiB, WS_SIN = 3 * MiB, WS_TB = 5 * MiB;
constexpr size_t WS_MEMN = 6 * MiB, WS_KVM = 18 * MiB;
constexpr size_t WS_WIN = 24 * MiB, WS_WOUT = 112 * MiB, WS_WCQ = 144 * MiB, WS_WCKV = 148 * MiB, WS_WCO = 156 * MiB, WS_W1 = 160 * MiB, WS_W2 = 288 * MiB;
constexpr size_t WS_XN = 416 * MiB;
constexpr size_t WS_R = 672 * MiB;
constexpr size_t WS_PROJ = WS_R, WS_Y = WS_R + 352 * MiB, WS_ST = WS_Y + 128 * MiB, WS_END = WS_ST + 128 * MiB;
constexpr size_t WS_QC = WS_R, WS_OC = WS_R + 32 * MiB;
constexpr size_t WS_HID = WS_R;
static_assert(WS_HID + (size_t)HTOK * DFF * 2 <= WS_END && WS_END == 1280 * MiB, "d_ws map");
constexpr int CW_TMO = 0, CW_BAR = 4096;
constexpr size_t WS_SS = 512 * 1024;

constexpr int RING_OFF = 0, RING_BYTES = 131072;
constexpr int LDSCTL_OFF = RING_BYTES, MISC_OFF = LDSCTL_OFF + 320;
constexpr int TAB_OFF = LDSCTL_OFF + 1024;
constexpr int LDS_BYTES = 147456;
static_assert(TAB_OFF + 8192 <= LDS_BYTES, "LDS map");

#define GAS __attribute__((address_space(1)))
#define LAS __attribute__((address_space(3)))
#define DI __device__ __forceinline__
typedef unsigned short bf16;
typedef unsigned v4u __attribute__((ext_vector_type(4)));
typedef unsigned v2u __attribute__((ext_vector_type(2)));
typedef float f32x4 __attribute__((ext_vector_type(4)));
typedef float f32x16 __attribute__((ext_vector_type(16)));
typedef short bf16x8 __attribute__((ext_vector_type(8)));
typedef short v4i16_t __attribute__((ext_vector_type(4)));
typedef GAS unsigned gu32;
#define RLX_AGENT __ATOMIC_RELAXED, __HIP_MEMORY_SCOPE_AGENT
#define LDS_WAIT() asm volatile("s_waitcnt lgkmcnt(0)" ::: "memory")
#define VM_WAIT() asm volatile("s_waitcnt vmcnt(0)" ::: "memory")
DI unsigned f2bf(float f) { unsigned u = __builtin_bit_cast(unsigned, f); return (u + 0x7fffu + ((u >> 16) & 1u)) >> 16; }
DI unsigned pk2(float lo, float hi) { return pg8::cvt_pk_bf16(lo, hi); }
DI float bflo(unsigned w) { return __uint_as_float(w << 16); }
DI float bfhi(unsigned w) { return __uint_as_float(w & 0xffff0000u); }
DI float ex2(float x) { return __builtin_amdgcn_exp2f(x); }
#define XB_TMO      128
#define XB_XCNT(j)  (256  + 64 * (j))
#define XB_XSUB(j)  (1280 + 64 * (j))
#define XB_XGEN(j)  (2304 + 64 * (j))
#define XB_TOP      3328
#define XB_TOPGEN   3392
#define XCD_BAR_WORDS 3456
#define XB_SPIN_CAP (1u << 18)

__device__ __forceinline__ unsigned xb_ld(unsigned* p)              { return __hip_atomic_load(p, __ATOMIC_RELAXED, __HIP_MEMORY_SCOPE_AGENT); }
__device__ __forceinline__ unsigned xb_add(unsigned* p, unsigned v) { return __hip_atomic_fetch_add(p, v, __ATOMIC_RELAXED, __HIP_MEMORY_SCOPE_AGENT); }
__device__ __forceinline__ unsigned xb_xcc_id() { return (unsigned)__builtin_amdgcn_s_getreg((3 << 11) | 20) & 0xFu; }
#define XB_SPIN(cond, bar) do { unsigned _sp = 0; while (cond) { __builtin_amdgcn_s_sleep(1); \
    if ((++_sp & 255u) == 0u) { if (xb_ld(&(bar)[XB_TMO])) break; if (_sp > XB_SPIN_CAP) { atomicAdd(&(bar)[XB_TMO], 1u); break; } } } } while (0)

struct XcdBarrier {
    unsigned* bar; unsigned x;
    volatile LAS unsigned* st;
};

__device__ __forceinline__ XcdBarrier xcd_barrier_post(unsigned* bar, volatile LAS unsigned* st) {
    XcdBarrier b; b.bar = bar; b.x = xb_xcc_id(); b.st = st;
    if (threadIdx.x == 0) (void)xb_add(&bar[XB_XCNT(b.x)], 1u);
    return b;
}
__device__ __forceinline__ void xcd_barrier_complete(unsigned* bar, unsigned x, unsigned& nloc, unsigned& nx) {
    const unsigned G = gridDim.x * gridDim.y * gridDim.z;
    unsigned sum, cnt, mine, sp = 0u;
    for (;;) {
        sum = 0u; cnt = 0u; mine = 0u;
#pragma unroll
        for (unsigned j = 0; j < 16; ++j) { const unsigned c = xb_ld(&bar[XB_XCNT(j)]); sum += c; cnt += (c > 0u) ? 1u : 0u; mine = (j == x) ? c : mine; }
        if (sum == G) break;
        __builtin_amdgcn_s_sleep(1);
        if ((++sp & 255u) == 0u) { if (xb_ld(&bar[XB_TMO])) break; if (sp > XB_SPIN_CAP) { atomicAdd(&bar[XB_TMO], 1u); break; } }
    }
    nloc = mine > 0u ? mine : 1u; nx = cnt > 0u ? cnt : 1u;
}

__device__ __forceinline__ void xcd_barrier(const XcdBarrier& b) {
    asm volatile("s_waitcnt vmcnt(0)" ::: "memory");
    __syncthreads();
    if (threadIdx.x == 0) {
        unsigned* bar = b.bar;
        __builtin_amdgcn_s_waitcnt(0);
        unsigned nloc = b.st[0], nx = b.st[1];
        if (nloc == 0u) { xcd_barrier_complete(bar, b.x, nloc, nx); b.st[0] = nloc; b.st[1] = nx; }
        const unsigned old = xb_add(&bar[XB_XSUB(b.x)], 1u);
        const unsigned gen = old / nloc;
        if (old + 1u == (gen + 1u) * nloc) {
            __builtin_amdgcn_fence(__ATOMIC_RELEASE, "agent");
            asm volatile("s_waitcnt vmcnt(0)" ::: "memory");
            const unsigned og = xb_add(&bar[XB_TOP], 1u);
            const unsigned tg = og / nx;
            if (og + 1u == (tg + 1u) * nx) xb_add(&bar[XB_TOPGEN], 1u);
            else XB_SPIN(xb_ld(&bar[XB_TOPGEN]) == tg, bar);
            __builtin_amdgcn_fence(__ATOMIC_ACQUIRE, "agent");
            xb_add(&bar[XB_XGEN(b.x)], 1u);
            asm volatile("s_waitcnt vmcnt(0)" ::: "memory");
        } else {
            XB_SPIN(xb_ld(&bar[XB_XGEN(b.x)]) == gen, bar);
            __builtin_amdgcn_fence(__ATOMIC_ACQUIRE, "agent");
            asm volatile("s_waitcnt vmcnt(0)" ::: "memory");
        }
    }
    __syncthreads();
}

DI float wave_sum(float v) {
#pragma unroll
    for (int o = 1; o < 64; o <<= 1) v += __shfl_xor(v, o);
    return v;
}
template <bool ROPEPERM>
DI void p0_transpose_item(const float* W, int K, int N, bf16* WT, LAS float* scr, int item, int lane, const float* gain = nullptr) {
    const int nblk = N / 32, kb = item / nblk, nb = item % nblk, k0 = 64 * kb, n0 = 32 * nb;
    int ncol = n0 + (lane & 31);
    if (ROPEPERM && ncol < 4096) { const int o = ncol & 127; ncol = (ncol & ~127) + (o >> 1) + 64 * (o & 1); }
#pragma unroll 8
    for (int i = 0; i < 32; ++i) { const int kk = 2 * i + (lane >> 5); float w = W[(size_t)(k0 + kk) * N + ncol]; if (gain) w *= gain[k0 + kk]; scr[kk * 33 + (lane & 31)] = w; }
    LDS_WAIT(); asm volatile("" ::: "memory");
    const int c = lane & 7;
#pragma unroll
    for (int j = 0; j < 4; ++j) { const int n = (lane >> 3) + 8 * j; const LAS float* s = scr + (8 * c) * 33 + n;
        v4u o; o.x = pk2(s[0 * 33], s[1 * 33]); o.y = pk2(s[2 * 33], s[3 * 33]); o.z = pk2(s[4 * 33], s[5 * 33]); o.w = pk2(s[6 * 33], s[7 * 33]);
        *(GAS v4u*)(WT + (size_t)(n0 + n) * K + k0 + 8 * c) = o; }
    LDS_WAIT(); asm volatile("" ::: "memory");
}
DI void rms_row_to_bf16(const float* xrow, const float* gain, bf16* orow, int lane) {
    const GAS f32x4* xr = (const GAS f32x4*)xrow + lane;
    f32x4 v[16]; float s = 0.f;
#pragma unroll
    for (int j = 0; j < 16; ++j) { v[j] = xr[64 * j]; s += (v[j].x * v[j].x + v[j].y * v[j].y) + (v[j].z * v[j].z + v[j].w * v[j].w); }
    const float rstd = 1.0f / sqrtf(wave_sum(s) * (1.f / DM) + RMS_EPS);
    const GAS f32x4* gr = (const GAS f32x4*)gain + lane;
    GAS v2u* o8 = (GAS v2u*)orow + lane;
#pragma unroll
    for (int j = 0; j < 16; ++j) { const f32x4 g = gr[64 * j]; v2u w; w.x = pk2(v[j].x * rstd * g.x, v[j].y * rstd * g.y); w.y = pk2(v[j].z * rstd * g.z, v[j].w * rstd * g.w); o8[64 * j] = w; }
}
DI void final_row(const bf16* xrow, float ssrow, const float* gain, float* orow, int lane, bool poison) {
    float rstd = __builtin_amdgcn_rsqf(ssrow * (1.f / DM) + RMS_EPS);
    if (poison) rstd = __builtin_nanf("");
    const GAS v4u* xr = (const GAS v4u*)xrow + lane; const GAS f32x4* gr = (const GAS f32x4*)gain + 2 * lane; GAS f32x4* o = (GAS f32x4*)orow + 2 * lane;
    v4u v[8];
#pragma unroll
    for (int j = 0; j < 8; ++j) v[j] = xr[64 * j];
#pragma unroll
    for (int j = 0; j < 8; ++j) { const f32x4 g0 = gr[128 * j], g1 = gr[128 * j + 1];
        o[128 * j] = (f32x4){bflo(v[j].x) * rstd * g0.x, bfhi(v[j].x) * rstd * g0.y, bflo(v[j].y) * rstd * g0.z, bfhi(v[j].y) * rstd * g0.w};
        o[128 * j + 1] = (f32x4){bflo(v[j].z) * rstd * g1.x, bfhi(v[j].z) * rstd * g1.y, bflo(v[j].w) * rstd * g1.z, bfhi(v[j].w) * rstd * g1.w}; }
}

#define MFMA32(a, b, c) __builtin_amdgcn_mfma_f32_32x32x16_bf16((a), (b), (c), 0, 0, 0)
DI int crow(int reg, int h) { return (reg & 3) + 8 * (reg >> 2) + 4 * h; }
DI unsigned off_b(unsigned row, unsigned ch) { return 256u * row + 16u * (ch ^ (((row & 3u) << 2) | ((row >> 2) & 3u))); }
DI bf16x8 row_frag(const LAS unsigned char* img, int rowbase, int lane, int ks) { return *(const LAS bf16x8*)(img + off_b(rowbase + (lane & 31), 2 * ks + (lane >> 5))); }
DI v4i16_t tr4(const LAS unsigned char* p) { return __builtin_amdgcn_ds_read_tr16_b64_v4i16((LAS v4i16_t*)p); }
DI bf16x8 tr_frag_nat(const LAS unsigned char* img, int rowbase, int lane, int c, int ks) {
    const unsigned h = lane >> 5, blk = (lane >> 4) & 1, q = (lane & 15) >> 2, p = lane & 3;
    const unsigned r0 = rowbase + 16 * ks + 8 * h + q, ch = 4 * c + 2 * blk + (p >> 1);
    const v4i16_t lo = tr4(img + off_b(r0, ch) + 8 * (p & 1)), hi = tr4(img + off_b(r0 + 4, ch) + 8 * (p & 1));
    return __builtin_shufflevector(lo, hi, 0, 1, 2, 3, 4, 5, 6, 7);
}
DI bf16x8 tr_frag_perm(const LAS unsigned char* img, int rowbase, int lane, int c, int s) {
    const unsigned h = lane >> 5, blk = (lane >> 4) & 1, q = (lane & 15) >> 2, p = lane & 3;
    const unsigned r0 = rowbase + 16 * s + 4 * h + q, ch = 4 * c + 2 * blk + (p >> 1);
    const v4i16_t lo = tr4(img + off_b(r0, ch) + 8 * (p & 1)), hi = tr4(img + off_b(r0 + 8, ch) + 8 * (p & 1));
    return __builtin_shufflevector(lo, hi, 0, 1, 2, 3, 4, 5, 6, 7);
}
template <int S> DI bf16x8 pack_step(const f32x16& x) {
    v4u p; p.x = pk2(x[8 * S], x[8 * S + 1]); p.y = pk2(x[8 * S + 2], x[8 * S + 3]); p.z = pk2(x[8 * S + 4], x[8 * S + 5]); p.w = pk2(x[8 * S + 6], x[8 * S + 7]);
    return __builtin_bit_cast(bf16x8, p);
}
DI void stage_tile(LAS unsigned char* img, const bf16* g, size_t pitch, int tid) {
#pragma unroll
    for (int i = 0; i < 4; ++i) { const int n = tid + 512 * i, row = n >> 4, ch = n & 15;
        const v4u v = *(const GAS v4u*)(g + (size_t)row * pitch + ch * 8);
        *(LAS v4u*)(img + off_b(row, ch)) = v; }
}
DI void stage_tile_scaled(LAS unsigned char* img, const bf16* g, size_t pitch, int tid, float a, float b) {
#pragma unroll
    for (int i = 0; i < 4; ++i) { const int n = tid + 512 * i, row = n >> 4, ch = n & 15;
        const v4u v = *(const GAS v4u*)(g + (size_t)row * pitch + ch * 8); const float sc = ex2(a + b * (float)row);
        v4u o; o.x = pk2(bflo(v.x) * sc, bfhi(v.x) * sc); o.y = pk2(bflo(v.y) * sc, bfhi(v.y) * sc); o.z = pk2(bflo(v.z) * sc, bfhi(v.z) * sc); o.w = pk2(bflo(v.w) * sc, bfhi(v.w) * sc);
        *(LAS v4u*)(img + off_b(row, ch)) = o; }
}

template <bool WIN>
DI void attn_unit(LAS unsigned char* lds, const LAS float* tbh, const bf16* qptr, size_t qpitch, const bf16* kptr, const bf16* vptr, size_t kvpitch, int lo, int hi,
                  bf16* optr, size_t opitch, float m0, float l0, int iq, int tid) {
    const int lane = tid & 63, r = lane & 31, h = lane >> 5;
    bf16x8 qf[8];
#pragma unroll
    for (int ks = 0; ks < 8; ++ks) qf[ks] = *(const GAS bf16x8*)(qptr + (size_t)r * qpitch + 16 * ks + 8 * h);
    f32x16 o[4];
#pragma unroll
    for (int c = 0; c < 4; ++c)
#pragma unroll
        for (int i = 0; i < 16; ++i) o[c][i] = 0.f;
    float m = m0, l = l0;
    LAS unsigned char* imgK = lds; LAS unsigned char* imgV = lds + 32768;
    for (int dk = lo; dk < hi; ++dk) {
        __syncthreads();
        stage_tile(imgK, kptr + (ptrdiff_t)dk * 128 * (ptrdiff_t)kvpitch, kvpitch, tid);
        stage_tile(imgV, vptr + (ptrdiff_t)dk * 128 * (ptrdiff_t)kvpitch, kvpitch, tid);
        __syncthreads();
#pragma unroll
        for (int kh = 0; kh < 2; ++kh) {
        f32x16 st[2];
#pragma unroll
        for (int kt = 0; kt < 2; ++kt) {
#pragma unroll
            for (int i = 0; i < 16; ++i) st[kt][i] = 0.f;
#pragma unroll
            for (int ks = 0; ks < 8; ++ks) st[kt] = MFMA32(row_frag(imgK, 64 * kh + 32 * kt, lane, ks), qf[ks], st[kt]);
        }
        if (WIN) {
            const int relb = 128 * dk - iq + 128 + 64 * kh;
#pragma unroll
            for (int kt = 0; kt < 2; ++kt)
#pragma unroll
                for (int i = 0; i < 16; ++i) { const int idx = relb + 32 * kt + crow(i, h); const bool ok = (unsigned)idx <= 256u;
                    const float bias = tbh[ok ? idx : 0]; st[kt][i] = ok ? st[kt][i] + bias : -1e30f; }
        }
        float mx = st[0][0];
#pragma unroll
        for (int kt = 0; kt < 2; ++kt)
#pragma unroll
            for (int i = 0; i < 16; ++i) mx = fmaxf(mx, st[kt][i]);
        mx = fmaxf(mx, __shfl_xor(mx, 32));
        const float mnew = fmaxf(m, mx), alpha = ex2(m - mnew); m = mnew;
        float rs = 0.f;
#pragma unroll
        for (int kt = 0; kt < 2; ++kt)
#pragma unroll
            for (int i = 0; i < 16; ++i) { const float p = ex2(st[kt][i] - mnew); st[kt][i] = p; rs += p; }
        rs += __shfl_xor(rs, 32);
        l = l * alpha + rs;
#pragma unroll
        for (int c = 0; c < 4; ++c)
#pragma unroll
            for (int i = 0; i < 16; ++i) o[c][i] *= alpha;
#pragma unroll
        for (int kt = 0; kt < 2; ++kt) {
            const bf16x8 p0 = pack_step<0>(st[kt]), p1 = pack_step<1>(st[kt]);
#pragma unroll
            for (int c = 0; c < 4; ++c) { o[c] = MFMA32(tr_frag_perm(imgV, 64 * kh + 32 * kt, lane, c, 0), p0, o[c]); o[c] = MFMA32(tr_frag_perm(imgV, 64 * kh + 32 * kt, lane, c, 1), p1, o[c]); }
        }
        }
    }
    const float inv = 1.0f / l;
#pragma unroll
    for (int c = 0; c < 4; ++c)
#pragma unroll
        for (int g4 = 0; g4 < 4; ++g4) { v2u w; w.x = pk2(o[c][4 * g4] * inv, o[c][4 * g4 + 1] * inv); w.y = pk2(o[c][4 * g4 + 2] * inv, o[c][4 * g4 + 3] * inv);
            *(GAS v2u*)(optr + (size_t)r * opitch + 32 * c + 8 * g4 + 4 * h) = w; }
}

DI void ret_kv_unit(LAS unsigned char* lds, const bf16* kg, const bf16* vg, size_t pitch, bf16* STf, bf16* STb, float lf2, float lb2, int tid) {
    const int lane = tid & 63, w = __builtin_amdgcn_readfirstlane(tid >> 6), r = lane & 31, h = lane >> 5;
    __syncthreads();
    stage_tile(lds, vg, pitch, tid);
    stage_tile_scaled(lds + 32768, kg, pitch, tid, 127.f * lf2, -lf2);
    stage_tile_scaled(lds + 65536, kg, pitch, tid, 0.f, lb2);
    __syncthreads();
    const int dir = w & 1, ce = w >> 1;
    const LAS unsigned char* imgK = lds + 32768 + dir * 32768;
    f32x16 acc[4];
#pragma unroll
    for (int c = 0; c < 4; ++c)
#pragma unroll
        for (int i = 0; i < 16; ++i) acc[c][i] = 0.f;
#pragma unroll
    for (int ks = 0; ks < 8; ++ks) { const bf16x8 bfr = tr_frag_nat(lds, 0, lane, ce, ks);
#pragma unroll
        for (int cd = 0; cd < 4; ++cd) acc[cd] = MFMA32(tr_frag_nat(imgK, 0, lane, cd, ks), bfr, acc[cd]); }
    bf16* dst = (dir ? STb : STf) + (size_t)(32 * ce + r) * 128 + 4 * h;
#pragma unroll
    for (int cd = 0; cd < 4; ++cd)
#pragma unroll
        for (int g4 = 0; g4 < 4; ++g4) { v2u x; x.x = pk2(acc[cd][4 * g4], acc[cd][4 * g4 + 1]); x.y = pk2(acc[cd][4 * g4 + 2], acc[cd][4 * g4 + 3]); *(GAS v2u*)(dst + 32 * cd + 8 * g4) = x; }
}
DI void ret_scan(bf16* ST, int nseq, int nchunk, const float* dec_f, const float* dec_b, int gtid, int nthreads) {
    const int ntask = nseq * 32 * 2048;
    for (int task = gtid; task < ntask; task += nthreads) {
        const int chain = task >> 11, eo = (task & 2047) * 8, seq = chain >> 5, hh = (chain >> 1) & 15, dir = chain & 1;
        const float lg = -expf(dir ? dec_b[hh] : dec_f[hh]), cd = ex2(128.f * lg * LOG2E);
        float s[8];
#pragma unroll
        for (int e = 0; e < 8; ++e) s[e] = 0.f;
        const ptrdiff_t cstride = (ptrdiff_t)16 * 2 * 16384 * (dir ? -1 : 1);
        bf16* p = ST + ((size_t)((seq * nchunk + (dir ? nchunk - 1 : 0)) * 16 + hh) * 2 + dir) * 16384 + eo;
        for (int cc = 0; cc < nchunk; cc += 4) {
            v4u v[4];
#pragma unroll
            for (int u = 0; u < 4; ++u) v[u] = *(const GAS v4u*)(p + u * cstride);
#pragma unroll
            for (int u = 0; u < 4; ++u) {
                v4u o; o.x = pk2(s[0], s[1]); o.y = pk2(s[2], s[3]); o.z = pk2(s[4], s[5]); o.w = pk2(s[6], s[7]);
                *(GAS v4u*)(p + u * cstride) = o;
                s[0] = s[0] * cd + bflo(v[u].x); s[1] = s[1] * cd + bfhi(v[u].x); s[2] = s[2] * cd + bflo(v[u].y); s[3] = s[3] * cd + bfhi(v[u].y);
                s[4] = s[4] * cd + bflo(v[u].z); s[5] = s[5] * cd + bfhi(v[u].z); s[6] = s[6] * cd + bflo(v[u].w); s[7] = s[7] * cd + bfhi(v[u].w);
            }
            p += 4 * cstride;
        }
    }
}
DI void ret_out_unit(LAS unsigned char* lds, LAS float* part, const bf16* qg, const bf16* kg, const bf16* vg, const bf16* gg, size_t pitch, const bf16* RfT, const bf16* RbT,
                     bf16* yg, size_t ypitch, float lf2, float lb2, int tid) {
    const int lane = tid & 63, w = __builtin_amdgcn_readfirstlane(tid >> 6), r = lane & 31, h = lane >> 5;
    __syncthreads();
    stage_tile(lds, kg, pitch, tid);
    stage_tile(lds + 32768, vg, pitch, tid);
    stage_tile(lds + 65536, RfT, 128, tid);
    stage_tile(lds + 98304, RbT, 128, tid);
    const int i = 32 * (w & 3) + r, eh = w >> 2;
    bf16x8 qf[8];
#pragma unroll
    for (int ks = 0; ks < 8; ++ks) qf[ks] = *(const GAS bf16x8*)(qg + (size_t)i * pitch + 16 * ks + 8 * h);
    __syncthreads();
    f32x16 y[2];
    {
        const float xf = ex2((float)(i + 1) * lf2), xb = ex2((float)(128 - i) * lb2);
        f32x16 cc[2];
#pragma unroll
        for (int c2 = 0; c2 < 2; ++c2)
#pragma unroll
            for (int q = 0; q < 16; ++q) cc[c2][q] = 0.f;
#pragma unroll
        for (int ks = 0; ks < 8; ++ks)
#pragma unroll
            for (int c2 = 0; c2 < 2; ++c2) cc[c2] = MFMA32(row_frag(lds + 65536, 32 * (2 * eh + c2), lane, ks), qf[ks], cc[c2]);
#pragma unroll
        for (int c2 = 0; c2 < 2; ++c2)
#pragma unroll
            for (int q = 0; q < 16; ++q) { y[c2][q] = xf * cc[c2][q]; cc[c2][q] = 0.f; }
        __builtin_amdgcn_sched_barrier(0);
#pragma unroll
        for (int ks = 0; ks < 8; ++ks)
#pragma unroll
            for (int c2 = 0; c2 < 2; ++c2) cc[c2] = MFMA32(row_frag(lds + 98304, 32 * (2 * eh + c2), lane, ks), qf[ks], cc[c2]);
#pragma unroll
        for (int c2 = 0; c2 < 2; ++c2)
#pragma unroll
            for (int q = 0; q < 16; ++q) y[c2][q] += xb * cc[c2][q];
        __builtin_amdgcn_sched_barrier(0);
    }
#pragma unroll
    for (int jt = 0; jt < 4; ++jt) {
        f32x16 st;
#pragma unroll
        for (int q = 0; q < 16; ++q) st[q] = 0.f;
#pragma unroll
        for (int ks = 0; ks < 8; ++ks) st = MFMA32(row_frag(lds, 32 * jt, lane, ks), qf[ks], st);
#pragma unroll
        for (int q = 0; q < 16; ++q) { const int d = i - (32 * jt + crow(q, h)); const float f = ex2((float)d * (d >= 0 ? lf2 : -lb2)); st[q] *= f; }
        const bf16x8 p0 = pack_step<0>(st), p1 = pack_step<1>(st);
#pragma unroll
        for (int c2 = 0; c2 < 2; ++c2) { y[c2] = MFMA32(tr_frag_perm(lds + 32768, 32 * jt, lane, 2 * eh + c2, 0), p0, y[c2]); y[c2] = MFMA32(tr_frag_perm(lds + 32768, 32 * jt, lane, 2 * eh + c2, 1), p1, y[c2]); }
    }
    float ss = 0.f;
#pragma unroll
    for (int c2 = 0; c2 < 2; ++c2)
#pragma unroll
        for (int q = 0; q < 16; ++q) ss += y[c2][q] * y[c2][q];
    ss += __shfl_xor(ss, 32);
    if (h == 0) part[w * 32 + r] = ss;
    __syncthreads();
    const float tot = part[w * 32 + r] + part[(w ^ 4) * 32 + r];
    const float rstd = 1.0f / sqrtf(tot * (1.f / 128.f) + RMS_EPS);
#pragma unroll
    for (int c2 = 0; c2 < 2; ++c2)
#pragma unroll
        for (int g4 = 0; g4 < 4; ++g4) { const int e0 = 32 * (2 * eh + c2) + 8 * g4 + 4 * h;
            const v2u gv = *(const GAS v2u*)(gg + (size_t)i * pitch + e0);
            v2u x; x.x = pk2(y[c2][4 * g4] * rstd * bflo(gv.x), y[c2][4 * g4 + 1] * rstd * bfhi(gv.x)); x.y = pk2(y[c2][4 * g4 + 2] * rstd * bflo(gv.y), y[c2][4 * g4 + 3] * rstd * bfhi(gv.y));
            *(GAS v2u*)(yg + (size_t)i * ypitch + e0) = x; }
}
struct Args { const float* in[20]; float* out; unsigned char* ws; int ph_lo, ph_hi, li, pad; };
DI int t5_bucket(int rel) {
    const int n = rel < 0 ? -rel : rel;
    const int b = n < 8 ? n : n < 12 ? 8 : n < 16 ? 9 : n < 23 ? 10 : n < 32 ? 11 : n < 46 ? 12 : n < 64 ? 13 : n < 91 ? 14 : 15;
    return b + (rel > 0 ? 16 : 0);
}

#define PH_BEGIN() int tid = threadIdx.x; asm volatile("" : "+v"(tid)); unsigned char* ws = args.ws; asm volatile("" : "+s"(ws)); \
    LAS unsigned char* const L = (LAS unsigned char*)lds; const int lane = tid & 63, wave = __builtin_amdgcn_readfirstlane(tid >> 6), G = gridDim.x; \
    const int vcu = (G % 8 == 0) ? ((int)blockIdx.x % 8) * (G / 8) + (int)blockIdx.x / 8 : (int)blockIdx.x; (void)lane; (void)wave; (void)vcu; (void)L
#define GRID_BAR() do { if (N_LAUNCHES == 1) { unsigned* bp_ = (unsigned*)(args.ws + WS_CTL) + CW_BAR; asm volatile("" : "+s"(bp_)); XcdBarrier b_; b_.bar = bp_; b_.x = xb_xcc_id(); \
    b_.st = (volatile LAS unsigned*)((LAS unsigned char*)lds + MISC_OFF) + 8; xcd_barrier(b_); } } while (0)
#ifndef REPMASK
#define REPMASK 0
#endif
#define NREP(k) ((((REPMASK) >> (k)) & 1) ? 2 : 1)
#ifndef PHMASK
#define PHMASK 0x7ffff
#endif
#define IN(k) ((((PHMASK) >> (k)) & 1) && lo <= (k) && (k) < hi)
#define BOTH(k) (IN(k) && IN((k) + 1))
template <int g> DI void mixer_half(const Args& args, unsigned char* lds, const int lo, const int hi) {
        const int pb = 1 + 5 * g;
        const int nbs = g ? 64 : 32, nseq = g ? 2 : 4;
        if (IN(pb)) {
            PH_BEGIN();
            pg8::Gemm gm{(const bf16*)(ws + WS_XN) + (size_t)g * HTOK * DM, (const bf16*)(ws + WS_WIN), HTOK, INW, DM}; pg8::StaticOrder S; S.init(HTOK, INW, G, (int)blockIdx.x);
            pg8::EpiProj E{(bf16*)(ws + WS_PROJ), INW, (const float*)(ws + WS_COS), (const float*)(ws + WS_SIN), g ? 8191 : 4095};
            _Pragma("unroll 1") for (int rep = 0; rep < NREP(1); ++rep) pg8::gemm_phase<pg8::EpiProj, pg8::StaticOrder, PG8_ALIGN, PG8_SP2>(L + RING_OFF, gm, S, E);
            if (BOTH(pb)) GRID_BAR();
        }
        if (IN(pb + 1)) {
          _Pragma("unroll 1") for (int rep = 0; rep < NREP(2); ++rep) {
            PH_BEGIN();
            bf16* const PROJ = (bf16*)(ws + WS_PROJ); bf16* const Y = (bf16*)(ws + WS_Y); bf16* const ST = (bf16*)(ws + WS_ST); const float* const TB = (const float*)(ws + WS_TB);
            LAS float* const ltab = (LAS float*)(L + TAB_OFF);
            for (int u = blockIdx.x; u < 2048; u += G) { const int hh = u & 15, c = u >> 4;
                const float lf2 = -expf(args.in[6][hh]) * LOG2E, lb2 = -expf(args.in[7][hh]) * LOG2E;
                const bf16* rowp = PROJ + (size_t)c * 128 * INW;
                bf16* stp = ST + (size_t)(c * 16 + hh) * 2 * 16384;
                ret_kv_unit(L, rowp + RETW + hh * HD, rowp + 2 * RETW + hh * HD, INW, stp, stp + 16384, lf2, lb2, tid);
            }
            for (int u = blockIdx.x; u < 1024; u += G) { const int hp = u & 7, R = u >> 3, nb = R % nbs;
                const int hq = 2 * hp + (wave >> 2), kvh = hp >> 1;
                __syncthreads();
                for (int e = tid; e < 2 * TBW; e += NTHREADS) ltab[e] = TB[(2 * hp) * TBW + e];
                const bf16* rowp = PROJ + (size_t)R * 128 * INW;
                const int qr = 32 * (wave & 3);
                attn_unit<true>(L, ltab + (wave >> 2) * TBW, rowp + (size_t)qr * INW + QA_OFF + hq * HD, INW, rowp + KA_OFF + kvh * HD, rowp + VA_OFF + kvh * HD, INW,
                                nb == 0 ? 0 : -1, nb == nbs - 1 ? 1 : 2, Y + (size_t)(R * 128 + qr) * DM + RETW + hq * HD, DM, args.in[8][hq] * LOG2E, 1.0f, qr + (lane & 31), tid);
            }
          }
            if (BOTH(pb + 1)) GRID_BAR();
        }
        if (IN(pb + 2)) {
            PH_BEGIN();
            if (g == 0) {
                if ((int)blockIdx.x >= G - 24) {
                    pg8::Gemm gm{(const bf16*)(ws + WS_MEMN), (const bf16*)(ws + WS_WCKV), NMEM, 2 * MEMW, DM}; pg8::StaticOrder S; S.init(NMEM, 2 * MEMW, 24, (int)blockIdx.x - (G - 24));
                    pg8::EpiBf16S<0, false> E{(bf16*)(ws + WS_KVM), 2 * MEMW, 1.0f, nullptr};
                    pg8::gemm_phase<pg8::EpiBf16S<0, false>, pg8::StaticOrder, PG8_ALIGN, PG8_SP2>(L + RING_OFF, gm, S, E);
                } else ret_scan((bf16*)(ws + WS_ST), nseq, nbs, args.in[6], args.in[7], blockIdx.x * NTHREADS + tid, (G - 24) * NTHREADS);
            } else ret_scan((bf16*)(ws + WS_ST), nseq, nbs, args.in[6], args.in[7], blockIdx.x * NTHREADS + tid, G * NTHREADS);
            if (BOTH(pb + 2)) GRID_BAR();
        }
        if (IN(pb + 3)) {
          _Pragma("unroll 1") for (int rep = 0; rep < NREP(4); ++rep) {
            PH_BEGIN();
            bf16* const PROJ = (bf16*)(ws + WS_PROJ); bf16* const Y = (bf16*)(ws + WS_Y); bf16* const ST = (bf16*)(ws + WS_ST);
            for (int u = blockIdx.x; u < 2048; u += G) { const int hh = u & 15, c = u >> 4;
                const float lf2 = -expf(args.in[6][hh]) * LOG2E, lb2 = -expf(args.in[7][hh]) * LOG2E;
                const bf16* rowp = PROJ + (size_t)c * 128 * INW;
                const bf16* stp = ST + (size_t)(c * 16 + hh) * 2 * 16384;
                ret_out_unit(L, (LAS float*)(L + TAB_OFF), rowp + hh * HD, rowp + RETW + hh * HD, rowp + 2 * RETW + hh * HD, rowp + 3 * RETW + hh * HD, INW, stp, stp + 16384,
                             Y + (size_t)c * 128 * DM + hh * HD, DM, lf2, lb2, tid);
            }
          }
            if (BOTH(pb + 3)) GRID_BAR();
        }
        if (IN(pb + 4)) {
            PH_BEGIN();
            pg8::Gemm gm{(const bf16*)(ws + WS_Y), (const bf16*)(ws + WS_WOUT), HTOK, DM, DM}; pg8::StaticOrder S; S.init(HTOK, DM, G, (int)blockIdx.x);
            pg8::EpiResB<true> E{args.in[g], (bf16*)(ws + WS_XN) + (size_t)g * HTOK * DM, DM, (float*)(ws + WS_SS) + g * HTOK};
            pg8::gemm_phase<pg8::EpiResB<true>, pg8::StaticOrder, PG8_ALIGN, PG8_SP2>(L + RING_OFF, gm, S, E);
            if (BOTH(pb + 4)) GRID_BAR();
        }
}

__global__ void __launch_bounds__(NTHREADS, 2) hymba_fwd(Args args) {
    extern __shared__ __attribute__((aligned(16))) unsigned char lds[];
    {
        const int t0 = threadIdx.x;
        for (int u = t0; u < (LDS_BYTES - LDSCTL_OFF) / 4; u += NTHREADS) ((LAS unsigned*)((LAS unsigned char*)lds + LDSCTL_OFF))[u] = 0u;
        __syncthreads();
        if (N_LAUNCHES == 1) (void)xcd_barrier_post((unsigned*)(args.ws + WS_CTL) + CW_BAR, (volatile LAS unsigned*)((LAS unsigned char*)lds + MISC_OFF) + 8);
    }
    const int lo = args.ph_lo, hi = args.ph_hi;

    if (IN(0)) {
      _Pragma("unroll 1") for (int rep = 0; rep < NREP(0); ++rep) {
        PH_BEGIN();
        const int gw = vcu * NWAVES + wave, NGW = G * NWAVES, gtid = blockIdx.x * NTHREADS + tid, NT = G * NTHREADS;
        LAS float* scr = (LAS float*)(L + RING_OFF + wave * 16384);
        constexpr int I_IN = (DM / 64) * (INW / 32), I_OUT = (DM / 64) * (DM / 32), I_CQ = (DM / 64) * (MEMW / 32), I_CKV = (DM / 64) * (2 * MEMW / 32), I_CO = (MEMW / 64) * (DM / 32),
                      I_1 = (DM / 64) * (DFF / 32), I_2 = (DFF / 64) * (DM / 32);
        constexpr int NITEMS = I_IN + I_OUT + I_CQ + I_CKV + I_CO + I_1 + I_2;
        for (int it = gw; it < NITEMS; it += NGW) {
            int r = it;
            if (r < I_IN) { p0_transpose_item<true>(args.in[5], DM, INW, (bf16*)(ws + WS_WIN), scr, r, lane); continue; } r -= I_IN;
            if (r < I_OUT) { p0_transpose_item<false>(args.in[10], DM, DM, (bf16*)(ws + WS_WOUT), scr, r, lane); continue; } r -= I_OUT;
            if (r < I_CQ) { p0_transpose_item<false>(args.in[13], DM, MEMW, (bf16*)(ws + WS_WCQ), scr, r, lane, args.in[11]); continue; } r -= I_CQ;
            if (r < I_CKV) { p0_transpose_item<false>(args.in[14], DM, 2 * MEMW, (bf16*)(ws + WS_WCKV), scr, r, lane); continue; } r -= I_CKV;
            if (r < I_CO) { p0_transpose_item<false>(args.in[15], MEMW, DM, (bf16*)(ws + WS_WCO), scr, r, lane); continue; } r -= I_CO;
            if (r < I_1) { p0_transpose_item<false>(args.in[17], DM, DFF, (bf16*)(ws + WS_W1), scr, r, lane, args.in[16]); continue; } r -= I_1;
            p0_transpose_item<false>(args.in[18], DFF, DM, (bf16*)(ws + WS_W2), scr, r, lane);
        }
        float* const COS = (float*)(ws + WS_COS); float* const SIN = (float*)(ws + WS_SIN); float* const TB = (float*)(ws + WS_TB);
        for (int e = gtid; e < 8192 * 64; e += NT) { const int pos = e >> 6, i = e & 63;
            const float inv = exp2f(-(float)i * (13.287712379549449f / 64.0f));
            const float ang = (float)pos * inv;
            double rev = (double)ang * 0.15915494309189535; rev -= floor(rev);
            const float rf = (float)rev;
            COS[e] = __builtin_amdgcn_cosf(rf); SIN[e] = __builtin_amdgcn_sinf(rf); }
        for (int e = gtid; e < 16 * TBW; e += NT) { const int hh = e / TBW, idx = e % TBW; const int rel = idx - 128;
            TB[e] = (idx <= 256) ? args.in[9][t5_bucket(rel) * 16 + hh] * LOG2E : 0.f; }
        bf16* const XN = (bf16*)(ws + WS_XN);
        for (int m = gw; m < NTOK; m += NGW) { const float* src = (m < HTOK) ? args.in[0] + (size_t)m * DM : args.in[1] + (size_t)(m - HTOK) * DM; rms_row_to_bf16(src, args.in[4], XN + (size_t)m * DM, lane); }
        for (int m = gw; m < NMEM; m += NGW) { const float* src = (m < 1024) ? args.in[2] + (size_t)m * DM : args.in[3] + (size_t)(m - 1024) * DM; rms_row_to_bf16(src, args.in[12], (bf16*)(ws + WS_MEMN) + (size_t)m * DM, lane); }
      }
        if (BOTH(0)) GRID_BAR();
    }

    mixer_half<0>(args, lds, lo, hi);
    mixer_half<1>(args, lds, lo, hi);

    if (IN(11)) {
        PH_BEGIN();
        pg8::Gemm gm{(const bf16*)(ws + WS_XN), (const bf16*)(ws + WS_WCQ), NTOK, MEMW, DM}; pg8::StaticOrder S; S.init(NTOK, MEMW, G, (int)blockIdx.x);
        pg8::EpiBf16S<0, true> E{(bf16*)(ws + WS_QC), MEMW, 0.12751743074602224f, (const float*)(ws + WS_SS)};
        pg8::gemm_phase<pg8::EpiBf16S<0, true>, pg8::StaticOrder, PG8_ALIGN, PG8_SP2>(L + RING_OFF, gm, S, E);
        if (BOTH(11)) GRID_BAR();
    }
    if (IN(12)) {
      _Pragma("unroll 1") for (int rep = 0; rep < NREP(12); ++rep) {
        PH_BEGIN();
        const bf16* QC = (const bf16*)(ws + WS_QC); const bf16* KVM = (const bf16*)(ws + WS_KVM); bf16* OC = (bf16*)(ws + WS_OC);
        for (int u = blockIdx.x; u < 512; u += G) { const int hd = u & 3, tile = u >> 2, row0 = tile * 256;
            const int mrow = row0 < HTOK ? (row0 >> 12) * 256 : 1024 + ((row0 - HTOK) >> 13) * 256;
            const int qr = row0 + 32 * wave;
            attn_unit<false>(L, (LAS float*)(L + TAB_OFF), QC + (size_t)qr * MEMW + hd * HD, MEMW, KVM + (size_t)mrow * (2 * MEMW) + hd * HD, KVM + (size_t)mrow * (2 * MEMW) + MEMW + hd * HD, 2 * MEMW,
                             0, 2, OC + (size_t)qr * MEMW + hd * HD, MEMW, -1e30f, 0.0f, 0, tid);
        }
      }
        if (BOTH(12)) GRID_BAR();
    }
    if (IN(13)) {
        PH_BEGIN();
        pg8::Gemm gm{(const bf16*)(ws + WS_OC), (const bf16*)(ws + WS_WCO), NTOK, DM, MEMW}; pg8::StaticOrder S; S.init(NTOK, DM, G, (int)blockIdx.x);
        pg8::EpiResB<false> E{nullptr, (bf16*)(ws + WS_XN), DM, (float*)(ws + WS_SS) + NTOK};
        pg8::gemm_phase<pg8::EpiResB<false>, pg8::StaticOrder, PG8_ALIGN, PG8_SP2>(L + RING_OFF, gm, S, E);
        if (BOTH(13)) GRID_BAR();
    }
#pragma unroll
    for (int g = 0; g < 2; ++g) {
        if (IN(14 + 2 * g)) {
            PH_BEGIN();
            pg8::Gemm gm{(const bf16*)(ws + WS_XN) + (size_t)g * HTOK * DM, (const bf16*)(ws + WS_W1), HTOK, DFF, DM}; pg8::StaticOrder S; S.init(HTOK, DFF, G, (int)blockIdx.x);
            pg8::EpiBf16S<1, true> E{(bf16*)(ws + WS_HID), DFF, 1.0f, (const float*)(ws + WS_SS) + NTOK + g * HTOK};
            _Pragma("unroll 1") for (int rep = 0; rep < NREP(14); ++rep) pg8::gemm_phase<pg8::EpiBf16S<1, true>, pg8::StaticOrder, PG8_ALIGN, PG8_SP2>(L + RING_OFF, gm, S, E);
            if (BOTH(14 + 2 * g)) GRID_BAR();
        }
        if (IN(15 + 2 * g)) {
            PH_BEGIN();
            pg8::Gemm gm{(const bf16*)(ws + WS_HID), (const bf16*)(ws + WS_W2), HTOK, DM, DFF}; pg8::StaticOrder S; S.init(HTOK, DM, G, (int)blockIdx.x);
            pg8::EpiResB<false> E{nullptr, (bf16*)(ws + WS_XN) + (size_t)g * HTOK * DM, DM, (float*)(ws + WS_SS) + 2 * NTOK + g * HTOK};
            pg8::gemm_phase<pg8::EpiResB<false>, pg8::StaticOrder, PG8_ALIGN, PG8_SP2>(L + RING_OFF, gm, S, E);
            if (BOTH(15 + 2 * g)) GRID_BAR();
        }
    }
    if (IN(18)) {
        PH_BEGIN();
        const bool poison = (N_LAUNCHES == 1) && (__hip_atomic_load((gu32*)((unsigned*)(ws + WS_CTL) + CW_BAR + XB_TMO), RLX_AGENT) != 0u);
        const int gw = vcu * NWAVES + wave, NGW = G * NWAVES; float* const o = args.out; const bf16* const X = (const bf16*)(ws + WS_XN); const float* const ss3 = (const float*)(ws + WS_SS) + 2 * NTOK;
        for (int m = gw; m < NTOK; m += NGW) final_row(X + (size_t)m * DM, ss3[m], args.in[19], o + (size_t)m * DM, lane, poison);
    }
#undef IN
#undef BOTH
}

extern "C" void kernel_launch(void* const* d_in, const int* in_sizes, int n_in, void* d_out, int out_size, void* d_ws, size_t ws_size, hipStream_t stream) {
    static int grid = 0;
    if (grid == 0) {
        if (n_in != 20 || out_size != NTOK * DM || ws_size < WS_END) { fprintf(stderr, "kernel_launch: shape/workspace mismatch (n_in %d, out %d, ws %zu, need %zu); nothing launched\n", n_in, out_size, ws_size, (size_t)WS_END); grid = -1; return; }
        int dev = 0, cus = 0, per_cu = 0;
        if (hipGetDevice(&dev) != hipSuccess || hipDeviceGetAttribute(&cus, hipDeviceAttributeMultiprocessorCount, dev) != hipSuccess) { grid = -1; return; }
        if (hipFuncSetAttribute((const void*)hymba_fwd, hipFuncAttributeMaxDynamicSharedMemorySize, LDS_BYTES) != hipSuccess) { fprintf(stderr, "kernel_launch: hipFuncSetAttribute failed\n"); grid = -1; return; }
        if (hipOccupancyMaxActiveBlocksPerMultiprocessor(&per_cu, (const void*)hymba_fwd, NTHREADS, LDS_BYTES) != hipSuccess || per_cu < 1)
            fprintf(stderr, "kernel_launch: note: occupancy query reports %d workgroups per CU\n", per_cu);
        (void)hipGetLastError();
        grid = cus;
    }
    if (grid < 0) return;
    if (hipMemsetAsync((char*)d_ws + WS_CTL, 0, CTL_ZERO_BYTES, stream) != hipSuccess) return;
    Args a{};
    for (int i = 0; i < 20; ++i) a.in[i] = (const float*)d_in[i];
    a.out = (float*)d_out; a.ws = (unsigned char*)d_ws; a.pad = 0;
    for (int li = 0; li < N_LAUNCHES; ++li) {
        a.ph_lo = (N_LAUNCHES == 1) ? 0 : li; a.ph_hi = (N_LAUNCHES == 1) ? NPHASE : li + 1; a.li = li;
        hipLaunchKernelGGL(hymba_fwd, dim3(grid), dim3(NTHREADS), LDS_BYTES, stream, a);
        const hipError_t le = hipPeekAtLastError();
        if (le != hipSuccess) { fprintf(stderr, "kernel_launch: launch %d failed: %s\n", li, hipGetErrorName(le)); break; }
    }
}
```

```cpp
#include <hip/hip_runtime.h>
#include <cstdio>
#include <cstdint>
namespace pg8 {
#define PG8_LAS __attribute__((address_space(3)))
typedef unsigned short bf16_t;
typedef short bf16x8 __attribute__((ext_vector_type(8)));
typedef float f32x4 __attribute__((ext_vector_type(4)));
typedef unsigned u32x4 __attribute__((ext_vector_type(4)));
constexpr int BM = 256, BK = 64, HALF = 128, HTB = HALF * BK * 2  , STAGE_BYTES = 8 * HTB, NXCD = 8, WGM = 8;

__host__ __device__ __forceinline__ int lds_byte(int r, int c) { const int st = (r >> 4) * 2 + (c >> 5), rr = r & 15, cc = c & 31, ob = rr * 64 + cc * 2; return st * 1024 + (ob ^ (((ob >> 9) & 1) << 5)); }
__host__ __device__ __forceinline__ void stage_rc(int b, int& R, int& C) { const int st = b / 1024, sb = b % 1024, swz = sb ^ (((sb >> 9) & 1) << 5); R = (st >> 1) * 16 + swz / 64; C = (st & 1) * 32 + (swz % 64) / 2; }
__host__ __device__ __forceinline__ int perm32(int rho) { const int n = rho >> 4, i = rho & 15; return 8 * (i >> 2) + 4 * n + (i & 3); }

struct Unit { int pm, pn; };
struct Gemm { const bf16_t* A; const bf16_t* Bt; int M, N, K; };

struct StaticOrder {
    int nM, nN, nwg, G, c;
    __host__ __device__ void init(int M, int N, int G_, int c_) { nM = M / BM; nN = N / BM; nwg = nM * nN; G = G_; c = c_; }
    __host__ __device__ bool next(int i, Unit& u) const {
        const long L = (long)i * G + c; if (L >= nwg) return false;
        int wgid = (int)L; { const int q = nwg / NXCD, r = nwg % NXCD, xcd = wgid % NXCD, off = wgid / NXCD; wgid = (xcd < r ? xcd * (q + 1) : r * (q + 1) + (xcd - r) * q) + off; }
        const int nig = WGM * nN, gid = wgid / nig, fm = gid * WGM, gsz = (nM - fm) < WGM ? (nM - fm) : WGM;
        u.pm = fm + ((wgid % nig) % gsz); u.pn = (wgid % nig) / gsz; return true;
    }
    __device__ __forceinline__ void a_ready(const Unit&) const {}
    __device__ __forceinline__ void done(const Unit&) const {}
};

typedef float f32x2 __attribute__((ext_vector_type(2)));
typedef __bf16 bf16x2_t __attribute__((ext_vector_type(2)));
__device__ __forceinline__ unsigned cvt_pk_bf16(float lo, float hi) { f32x2 v = {lo, hi}; bf16x2_t b = __builtin_convertvector(v, bf16x2_t); return __builtin_bit_cast(unsigned, b); }
__device__ __forceinline__ u32x4 pack8(const f32x4& v0, const f32x4& v1) { u32x4 w; w.x = cvt_pk_bf16(v0[0], v0[1]); w.y = cvt_pk_bf16(v0[2], v0[3]); w.z = cvt_pk_bf16(v1[0], v1[1]); w.w = cvt_pk_bf16(v1[2], v1[3]); return w; }

template <int ACT, bool RS> struct EpiBf16S {
    static constexpr bool PERM = true, AFTER_DRAIN = false;
    bf16_t* O; int ldc; float scale; const float* ss;
    __device__ __forceinline__ void operator()(const f32x4 (&acc)[2][2][4][2], const Unit& u, int wr, int wc, int fr, int fq) const {
        const int row0 = u.pm * BM + wr * 64 + fr, col0 = u.pn * BM + wc * 32 + 8 * fq;
#pragma unroll
        for (int ai = 0; ai < 2; ++ai)
#pragma unroll
            for (int m = 0; m < 4; ++m) { const int row = row0 + ai * HALF + m * 16; bf16_t* rowp = O + (size_t)row * ldc + col0;
                float rs = scale;
                if (RS) rs = scale * __builtin_amdgcn_rsqf(ss[row] * (1.0f / 4096.0f) + 1e-6f);
#pragma unroll
                for (int bj = 0; bj < 2; ++bj) { f32x4 v0 = acc[ai][bj][m][0] * rs, v1 = acc[ai][bj][m][1] * rs;
                    if (ACT == 1) {
#pragma unroll
                        for (int e = 0; e < 4; ++e) { const float a = fmaxf(v0[e], 0.f), b = fmaxf(v1[e], 0.f); v0[e] = a * a; v1[e] = b * b; } }
                    *(u32x4*)(rowp + bj * HALF) = pack8(v0, v1); } }
    }
};
template <bool BASE_F32> struct EpiResB {
    static constexpr bool PERM = true, AFTER_DRAIN = false;
    const float* basef; const bf16_t* Xin; bf16_t* X; int ldc; float* ss;
    __device__ __forceinline__ void operator()(const f32x4 (&acc)[2][2][4][2], const Unit& u, int wr, int wc, int fr, int fq) const {
        const int row0 = u.pm * BM + wr * 64 + fr, col0 = u.pn * BM + wc * 32 + 8 * fq;
#pragma unroll
        for (int ai = 0; ai < 2; ++ai)
#pragma unroll
            for (int m = 0; m < 4; ++m) { const int row = row0 + ai * HALF + m * 16; const size_t off = (size_t)row * ldc + col0;
                f32x4 b[2][2];
                if (BASE_F32) {
#pragma unroll
                    for (int bj = 0; bj < 2; ++bj) { b[bj][0] = *(const f32x4*)(basef + off + bj * HALF); b[bj][1] = *(const f32x4*)(basef + off + bj * HALF + 4); }
                } else {
#pragma unroll
                    for (int bj = 0; bj < 2; ++bj) { const u32x4 w = *(const u32x4*)(Xin + off + bj * HALF);
                        b[bj][0] = (f32x4){__uint_as_float(w.x << 16), __uint_as_float(w.x & 0xffff0000u), __uint_as_float(w.y << 16), __uint_as_float(w.y & 0xffff0000u)};
                        b[bj][1] = (f32x4){__uint_as_float(w.z << 16), __uint_as_float(w.z & 0xffff0000u), __uint_as_float(w.w << 16), __uint_as_float(w.w & 0xffff0000u)}; }
                }
                float s = 0.f;
#pragma unroll
                for (int bj = 0; bj < 2; ++bj) { const f32x4 v0 = b[bj][0] + acc[ai][bj][m][0], v1 = b[bj][1] + acc[ai][bj][m][1];
                    s += (v0[0] * v0[0] + v0[1] * v0[1]) + (v0[2] * v0[2] + v0[3] * v0[3]) + (v1[0] * v1[0] + v1[1] * v1[1]) + (v1[2] * v1[2] + v1[3] * v1[3]);
                    *(u32x4*)(X + off + bj * HALF) = pack8(v0, v1); }
                s += __shfl_xor(s, 16); s += __shfl_xor(s, 32);
                if (fq == 0) (void)__hip_atomic_fetch_add(ss + row, s, __ATOMIC_RELAXED, __HIP_MEMORY_SCOPE_AGENT); }
    }
};
struct EpiProj {
    static constexpr bool PERM = true, AFTER_DRAIN = false;
    bf16_t* O; int ldc; const float* cs; const float* sn; int posmask;
    __device__ __forceinline__ void operator()(const f32x4 (&acc)[2][2][4][2], const Unit& u, int wr, int wc, int fr, int fq) const {
        const int row0 = u.pm * BM + wr * 64 + fr, col0 = u.pn * BM + wc * 32 + 8 * fq;
        const int sec = u.pn >> 3;
        const int i0 = 16 * wc + 4 * fq;
#pragma unroll
        for (int ai = 0; ai < 2; ++ai)
#pragma unroll
            for (int m = 0; m < 4; ++m) { const int row = row0 + ai * HALF + m * 16; bf16_t* rowp = O + (size_t)row * ldc + col0;
                f32x4 c4 = (f32x4){1.f, 1.f, 1.f, 1.f}, s4 = (f32x4){0.f, 0.f, 0.f, 0.f};
                if (sec < 2) { const int pos = row & posmask; c4 = *(const f32x4*)(cs + (size_t)pos * 64 + i0); s4 = *(const f32x4*)(sn + (size_t)pos * 64 + i0);
                    if (sec == 1) { c4 = c4 * 0.08838834764831845f; s4 = s4 * 0.08838834764831845f; } }
#pragma unroll
                for (int bj = 0; bj < 2; ++bj) { f32x4 v0 = acc[ai][bj][m][0], v1 = acc[ai][bj][m][1];
                    if (sec < 2) {
                        f32x4 o0, o1;
                        o0[0] = v0[0] * c4[0] - v0[1] * s4[0]; o0[1] = v0[0] * s4[0] + v0[1] * c4[0];
                        o0[2] = v0[2] * c4[1] - v0[3] * s4[1]; o0[3] = v0[2] * s4[1] + v0[3] * c4[1];
                        o1[0] = v1[0] * c4[2] - v1[1] * s4[2]; o1[1] = v1[0] * s4[2] + v1[1] * c4[2];
                        o1[2] = v1[2] * c4[3] - v1[3] * s4[3]; o1[3] = v1[2] * s4[3] + v1[3] * c4[3];
                        v0 = o0; v1 = o1;
                    } else if (sec == 3) {
#pragma unroll
                        for (int e = 0; e < 4; ++e) { v0[e] = v0[e] * __builtin_amdgcn_rcpf(1.f + __builtin_amdgcn_exp2f(-1.4426950408889634f * v0[e]));
                                                      v1[e] = v1[e] * __builtin_amdgcn_rcpf(1.f + __builtin_amdgcn_exp2f(-1.4426950408889634f * v1[e])); }
                    } else if (sec == 4) { v0 = v0 * 0.12751743074602224f; v1 = v1 * 0.12751743074602224f; }
                    *(u32x4*)(rowp + bj * HALF) = pack8(v0, v1); } }
    }
};
template <class Epi, class Sched, bool ALIGN_EPI = false, bool SP2 = false>
__device__ __forceinline__ void gemm_phase(PG8_LAS unsigned char* lds, const Gemm g, const Sched& S, const Epi& E) {
    int tid_ = threadIdx.x; asm volatile("" : "+v"(tid_));
    const int tid = tid_, wid = __builtin_amdgcn_readfirstlane(tid >> 6), lane = tid & 63, wr = wid >> 2, wc = wid & 3, fr = lane & 15, fq = lane >> 4;
    const int K = g.K, nt = K / BK;
    unsigned voffA[2], voffB[2];
#pragma unroll
    for (int i = 0; i < 2; ++i) { int R, C; stage_rc(tid * 16 + i * 8192, R, C); const int Rb = Epi::PERM ? ((R & ~31) + perm32(R & 31)) : R;
        voffA[i] = (unsigned)(R * K + C) * 2u; voffB[i] = (unsigned)(Rb * K + C) * 2u; }
    const size_t kstep = (size_t)(BK * 2);
    const size_t hstep = (size_t)HALF * K * 2;
    const size_t tstep = 2 * hstep;
    const unsigned ldsw = (unsigned)wid * 1024u;
    const int aoff = lds_byte(wr * 64 + fr, fq * 8), boff = lds_byte(wc * 32 + fr, fq * 8);
#define PG8_SA(b, h) (((b) * 2 + (h)) * HTB)
#define PG8_SB(b, h) ((4 + (b) * 2 + (h)) * HTB)
#define PG8_STAGE(bufoff, gbase, voff) do { _Pragma("unroll") for (int _i = 0; _i < 2; ++_i) \
        __builtin_amdgcn_global_load_lds((const unsigned*)((const char*)(gbase) + (voff)[_i]), (PG8_LAS unsigned*)(lds + (bufoff) + ldsw + _i * 8192), 16, 0, 0); } while (0)
#define PG8_LDA(dst, b, h) do { _Pragma("unroll") for (int m = 0; m < 4; ++m) _Pragma("unroll") for (int k = 0; k < 2; ++k) dst[m][k] = *(const PG8_LAS bf16x8*)(lds + PG8_SA(b, h) + aoff + m * 2048 + k * 1024); } while (0)
#define PG8_LDB(dst, b, h) do { _Pragma("unroll") for (int n = 0; n < 2; ++n) _Pragma("unroll") for (int k = 0; k < 2; ++k) dst[n][k] = *(const PG8_LAS bf16x8*)(lds + PG8_SB(b, h) + boff + n * 2048 + k * 1024); } while (0)
#define PG8_MMA(ai, bj, At, Bt) do { __builtin_amdgcn_s_setprio(1); _Pragma("unroll") for (int m = 0; m < 4; ++m) _Pragma("unroll") for (int n = 0; n < 2; ++n) _Pragma("unroll") for (int k = 0; k < 2; ++k) \
        acc[ai][bj][m][n] = __builtin_amdgcn_mfma_f32_16x16x32_bf16(Bt[n][k], At[m][k], acc[ai][bj][m][n], 0, 0, 0); __builtin_amdgcn_s_setprio(0); } while (0)
#define PG8_WAIT_V(n) asm volatile("s_waitcnt vmcnt(" #n ")" ::: "memory")
#define PG8_WAIT_L(n) asm volatile("s_waitcnt lgkmcnt(" #n ")" ::: "memory")
#define PG8_BAR __builtin_amdgcn_s_barrier()
#define PG8_SCHED __builtin_amdgcn_sched_barrier(0)
    Unit cur, nxt; int ui = 0;
    if (!S.next(0, cur)) return;
    f32x4 acc[2][2][4][2];
#pragma unroll
    for (int a = 0; a < 2; ++a)
#pragma unroll
        for (int b = 0; b < 2; ++b)
#pragma unroll
            for (int m = 0; m < 4; ++m)
#pragma unroll
                for (int n = 0; n < 2; ++n) acc[a][b][m][n] = (f32x4){0.f, 0.f, 0.f, 0.f};
    bf16x8 At[4][2], B0[2][2], B1[2][2];
    const char* cA = (const char*)g.A + (size_t)cur.pm * tstep; const char* cB = (const char*)g.Bt + (size_t)cur.pn * tstep;
    S.a_ready(cur);
    if constexpr (SP2) {
        PG8_STAGE(PG8_SB(0, 0), cB, voffB); PG8_STAGE(PG8_SB(0, 1), cB + hstep, voffB); PG8_STAGE(PG8_SA(0, 0), cA, voffA); PG8_STAGE(PG8_SA(0, 1), cA + hstep, voffA);
        if (wr == 1) PG8_BAR;
        PG8_WAIT_V(2); PG8_BAR;
        PG8_STAGE(PG8_SB(1, 0), cB + kstep, voffB); PG8_STAGE(PG8_SA(1, 0), cA + kstep, voffA); PG8_STAGE(PG8_SB(1, 1), cB + hstep + kstep, voffB);
        PG8_WAIT_V(6); PG8_BAR;
    } else {
        PG8_STAGE(PG8_SB(0, 0), cB, voffB); PG8_STAGE(PG8_SA(0, 0), cA, voffA); PG8_STAGE(PG8_SB(0, 1), cB + hstep, voffB); PG8_STAGE(PG8_SA(0, 1), cA + hstep, voffA);
        if (wr == 1) PG8_BAR;
        PG8_WAIT_V(4); PG8_BAR;
        PG8_STAGE(PG8_SB(1, 0), cB + kstep, voffB); PG8_STAGE(PG8_SA(1, 0), cA + kstep, voffA); PG8_STAGE(PG8_SB(1, 1), cB + hstep + kstep, voffB);
        PG8_WAIT_V(6); PG8_BAR;
    }
    for (;;) {
        const bool has_next = S.next(ui + 1, nxt);
        const char* nA = has_next ? (const char*)g.A + (size_t)nxt.pm * tstep : cA; const char* nB = has_next ? (const char*)g.Bt + (size_t)nxt.pn * tstep : cB;
        for (int t = 0; t < nt; t += 2) {
            const bool last = (t == nt - 2);
            const char* a1 = cA + (size_t)(t + 1) * kstep;
            const char* a2 = last ? nA : cA + (size_t)(t + 2) * kstep; const char* b2 = last ? nB : cB + (size_t)(t + 2) * kstep;
            const char* a3 = a2 + kstep; const char* b3 = b2 + kstep;
            if (last && has_next) S.a_ready(nxt);
            if constexpr (SP2) {
            PG8_LDB(B0, 0, 0); PG8_LDB(B1, 0, 1); PG8_SCHED; PG8_LDA(At, 0, 0); PG8_STAGE(PG8_SA(1, 1), a1 + hstep, voffA);
            PG8_WAIT_V(8); PG8_WAIT_L(0); PG8_BAR; PG8_MMA(0, 0, At, B0); PG8_MMA(0, 1, At, B1); PG8_BAR; PG8_SCHED;
            PG8_LDA(At, 0, 1); PG8_STAGE(PG8_SB(0, 0), b2, voffB); PG8_STAGE(PG8_SB(0, 1), b2 + hstep, voffB); PG8_STAGE(PG8_SA(0, 0), a2, voffA);
            PG8_WAIT_V(8); PG8_WAIT_L(0); PG8_BAR; PG8_MMA(1, 0, At, B0); PG8_MMA(1, 1, At, B1); PG8_BAR; PG8_SCHED;
            PG8_LDB(B0, 1, 0); PG8_LDB(B1, 1, 1); PG8_SCHED; PG8_LDA(At, 1, 0); PG8_STAGE(PG8_SA(0, 1), a2 + hstep, voffA);
            PG8_WAIT_V(8); PG8_WAIT_L(0); PG8_BAR; PG8_MMA(0, 0, At, B0); PG8_MMA(0, 1, At, B1); PG8_BAR; PG8_SCHED;
            PG8_LDA(At, 1, 1); PG8_STAGE(PG8_SB(1, 0), b3, voffB); PG8_STAGE(PG8_SB(1, 1), b3 + hstep, voffB); PG8_STAGE(PG8_SA(1, 0), a3, voffA);
            PG8_WAIT_V(8); PG8_WAIT_L(0); PG8_BAR; PG8_MMA(1, 0, At, B0); PG8_MMA(1, 1, At, B1); PG8_BAR; PG8_SCHED;
            } else {
            PG8_LDB(B0, 0, 0); PG8_SCHED; PG8_LDA(At, 0, 0); PG8_STAGE(PG8_SA(1, 1), a1 + hstep, voffA);
            PG8_WAIT_L(8); PG8_BAR; PG8_WAIT_L(0); PG8_MMA(0, 0, At, B0); PG8_BAR; PG8_SCHED;
            PG8_LDB(B1, 0, 1); PG8_STAGE(PG8_SB(0, 0), b2, voffB);
            PG8_BAR; PG8_WAIT_L(0); PG8_MMA(0, 1, At, B1); PG8_BAR;
            PG8_LDA(At, 0, 1); PG8_STAGE(PG8_SA(0, 0), a2, voffA);
            PG8_BAR; PG8_WAIT_L(0); PG8_MMA(1, 0, At, B0); PG8_BAR; PG8_SCHED;
            PG8_STAGE(PG8_SB(0, 1), b2 + hstep, voffB);
            PG8_WAIT_V(6); PG8_BAR; PG8_MMA(1, 1, At, B1); PG8_BAR;
            PG8_LDB(B0, 1, 0); PG8_SCHED; PG8_LDA(At, 1, 0); PG8_STAGE(PG8_SA(0, 1), a2 + hstep, voffA);
            PG8_WAIT_L(8); PG8_BAR; PG8_WAIT_L(0); PG8_MMA(0, 0, At, B0); PG8_BAR; PG8_SCHED;
            PG8_LDB(B1, 1, 1); PG8_STAGE(PG8_SB(1, 0), b3, voffB);
            PG8_BAR; PG8_WAIT_L(0); PG8_MMA(0, 1, At, B1); PG8_BAR;
            PG8_LDA(At, 1, 1); PG8_STAGE(PG8_SA(1, 0), a3, voffA);
            PG8_BAR; PG8_WAIT_L(0); PG8_MMA(1, 0, At, B0); PG8_BAR; PG8_SCHED;
            PG8_STAGE(PG8_SB(1, 1), b3 + hstep, voffB);
            PG8_WAIT_V(6); PG8_BAR; PG8_MMA(1, 1, At, B1); PG8_BAR;
            }
        }
        if constexpr (ALIGN_EPI) { if (wr == 0) PG8_BAR; }
        if constexpr (!Epi::AFTER_DRAIN) { E(acc, cur, wr, wc, fr, fq); S.done(cur); }
        if (!has_next) break;
#pragma unroll
        for (int a = 0; a < 2; ++a)
#pragma unroll
            for (int b = 0; b < 2; ++b)
#pragma unroll
                for (int m = 0; m < 4; ++m)
#pragma unroll
                    for (int n = 0; n < 2; ++n) acc[a][b][m][n] = (f32x4){0.f, 0.f, 0.f, 0.f};
        cur = nxt; cA = nA; cB = nB; ++ui;
        if constexpr (ALIGN_EPI) { if (wr == 1) PG8_BAR; }
    }
    PG8_WAIT_V(0);
    if constexpr (!ALIGN_EPI) { if (wr == 0) PG8_BAR; }
    PG8_BAR;
    if constexpr (Epi::AFTER_DRAIN) { E.fused(acc, cur, wr, wc, fr, fq, lds, wid, lane); S.done(cur); }
#undef PG8_SA
#undef PG8_SB
#undef PG8_STAGE
#undef PG8_LDA
#undef PG8_LDB
#undef PG8_MMA
#undef PG8_WAIT_V
#undef PG8_WAIT_L
#undef PG8_BAR
#undef PG8_SCHED
}
}
#ifndef PG8_SP2
#define PG8_SP2 true
#endif
#ifndef PG8_ALIGN
#define PG8_ALIGN true
#endif

constexpr int NWAVES = 8, NTHREADS = 512;
constexpr int NPHASE = 19;
#ifndef MK_N_LAUNCHES
#define MK_N_LAUNCHES 1
#endif
constexpr int N_LAUNCHES = MK_N_LAUNCHES;

constexpr int DM = 4096, NTOK = 32768, HTOK = 16384, INW = 11264, DFF = 16384, MEMW = 512, NMEM = 1536, HD = 128;
constexpr int RETW = 2048, QA_OFF = 8192, KA_OFF = 10240, VA_OFF = 10752;
constexpr float RMS_EPS = 1e-6f, LOG2E = 1.4426950408889634f;
constexpr int TBW = 264;

constexpr size_t MiB = 1u << 20;
constexpr size_t WS_CTL = 0, CTL_ZERO_BYTES = 1 * MiB;
constexpr size_t WS_COS = 1 * MiB, WS_SIN = 3 * MiB, WS_TB = 5 * MiB;
constexpr size_t WS_MEMN = 6 * MiB, WS_KVM = 18 * MiB;
constexpr size_t WS_WIN = 24 * MiB, WS_WOUT = 112 * MiB, WS_WCQ = 144 * MiB, WS_WCKV = 148 * MiB, WS_WCO = 156 * MiB, WS_W1 = 160 * MiB, WS_W2 = 288 * MiB;
constexpr size_t WS_XN = 416 * MiB;
constexpr size_t WS_R = 672 * MiB;
constexpr size_t WS_PROJ = WS_R, WS_Y = WS_R + 352 * MiB, WS_ST = WS_Y + 128 * MiB, WS_END = WS_ST + 128 * MiB;
constexpr size_t WS_QC = WS_R, WS_OC = WS_R + 32 * MiB;
constexpr size_t WS_HID = WS_R;
constexpr size_t WS_PROBE5 = WS_PROJ, WS_PROBE13 = WS_R + 64 * MiB, WS_PROBE15 = WS_WIN, WS_PROBE_SS = 896 * 1024;
static_assert(WS_HID + (size_t)HTOK * DFF * 2 <= WS_END && WS_END == 1280 * MiB, "d_ws map");
constexpr int CW_TMO = 0, CW_BAR = 4096;
constexpr size_t WS_SS = 512 * 1024;

constexpr int RING_OFF = 0, RING_BYTES = 131072;
constexpr int LDSCTL_OFF = RING_BYTES, MISC_OFF = LDSCTL_OFF + 320;
constexpr int TAB_OFF = LDSCTL_OFF + 1024;
constexpr int LDS_BYTES = 163840;
static_assert(TAB_OFF + 16 * TBW * 4 <= LDS_BYTES, "LDS map");

#define GAS __attribute__((address_space(1)))
#define LAS __attribute__((address_space(3)))
#define DI __device__ __forceinline__
typedef unsigned short bf16;
typedef unsigned v4u __attribute__((ext_vector_type(4)));
typedef unsigned v2u __attribute__((ext_vector_type(2)));
typedef float f32x4 __attribute__((ext_vector_type(4)));
typedef float f32x16 __attribute__((ext_vector_type(16)));
typedef short bf16x8 __attribute__((ext_vector_type(8)));
typedef short v4i16_t __attribute__((ext_vector_type(4)));
typedef GAS unsigned gu32;
#define RLX_AGENT __ATOMIC_RELAXED, __HIP_MEMORY_SCOPE_AGENT
#define LDS_WAIT() asm volatile("s_waitcnt lgkmcnt(0)" ::: "memory")
#define VM_WAIT() asm volatile("s_waitcnt vmcnt(0)" ::: "memory")
DI unsigned f2bf(float f) { unsigned u = __builtin_bit_cast(unsigned, f); return (u + 0x7fffu + ((u >> 16) & 1u)) >> 16; }
DI unsigned pk2(float lo, float hi) { return pg8::cvt_pk_bf16(lo, hi); }
DI float bflo(unsigned w) { return __uint_as_float(w << 16); }
DI float bfhi(unsigned w) { return __uint_as_float(w & 0xffff0000u); }
DI float ex2(float x) { return __builtin_amdgcn_exp2f(x); }
#define XB_TMO      128
#define XB_XCNT(j)  (256  + 64 * (j))
#define XB_XSUB(j)  (1280 + 64 * (j))
#define XB_XGEN(j)  (2304 + 64 * (j))
#define XB_TOP      3328
#define XB_TOPGEN   3392
#define XCD_BAR_WORDS 3456
#define XB_SPIN_CAP (1u << 18)

__device__ __forceinline__ unsigned xb_ld(unsigned* p)              { return __hip_atomic_load(p, __ATOMIC_RELAXED, __HIP_MEMORY_SCOPE_AGENT); }
__device__ __forceinline__ unsigned xb_add(unsigned* p, unsigned v) { return __hip_atomic_fetch_add(p, v, __ATOMIC_RELAXED, __HIP_MEMORY_SCOPE_AGENT); }
__device__ __forceinline__ unsigned xb_xcc_id() { return (unsigned)__builtin_amdgcn_s_getreg((3 << 11) | 20) & 0xFu; }
#define XB_SPIN(cond, bar) do { unsigned _sp = 0; while (cond) { __builtin_amdgcn_s_sleep(1); \
    if ((++_sp & 255u) == 0u) { if (xb_ld(&(bar)[XB_TMO])) break; if (_sp > XB_SPIN_CAP) { atomicAdd(&(bar)[XB_TMO], 1u); break; } } } } while (0)

struct XcdBarrier {
    unsigned* bar; unsigned x;
    volatile LAS unsigned* st;
};

__device__ __forceinline__ XcdBarrier xcd_barrier_post(unsigned* bar, volatile LAS unsigned* st) {
    XcdBarrier b; b.bar = bar; b.x = xb_xcc_id(); b.st = st;
    if (threadIdx.x == 0) (void)xb_add(&bar[XB_XCNT(b.x)], 1u);
    return b;
}
__device__ __forceinline__ void xcd_barrier_complete(unsigned* bar, unsigned x, unsigned& nloc, unsigned& nx) {
    const unsigned G = gridDim.x * gridDim.y * gridDim.z;
    unsigned sum, cnt, mine, sp = 0u;
    for (;;) {
        sum = 0u; cnt = 0u; mine = 0u;
#pragma unroll
        for (unsigned j = 0; j < 16; ++j) { const unsigned c = xb_ld(&bar[XB_XCNT(j)]); sum += c; cnt += (c > 0u) ? 1u : 0u; mine = (j == x) ? c : mine; }
        if (sum == G) break;
        __builtin_amdgcn_s_sleep(1);
        if ((++sp & 255u) == 0u) { if (xb_ld(&bar[XB_TMO])) break; if (sp > XB_SPIN_CAP) { atomicAdd(&bar[XB_TMO], 1u); break; } }
    }
    nloc = mine > 0u ? mine : 1u; nx = cnt > 0u ? cnt : 1u;
}

__device__ __forceinline__ void xcd_barrier(const XcdBarrier& b) {
    asm volatile("s_waitcnt vmcnt(0)" ::: "memory");
    __syncthreads();
    if (threadIdx.x == 0) {
        unsigned* bar = b.bar;
        __builtin_amdgcn_s_waitcnt(0);
        unsigned nloc = b.st[0], nx = b.st[1];
        if (nloc == 0u) { xcd_barrier_complete(bar, b.x, nloc, nx); b.st[0] = nloc; b.st[1] = nx; }
        const unsigned old = xb_add(&bar[XB_XSUB(b.x)], 1u);
        const unsigned gen = old / nloc;
        if (old + 1u == (gen + 1u) * nloc) {
            __builtin_amdgcn_fence(__ATOMIC_RELEASE, "agent");
            asm volatile("s_waitcnt vmcnt(0)" ::: "memory");
            const unsigned og = xb_add(&bar[XB_TOP], 1u);
            const unsigned tg = og / nx;
            if (og + 1u == (tg + 1u) * nx) xb_add(&bar[XB_TOPGEN], 1u);
            else XB_SPIN(xb_ld(&bar[XB_TOPGEN]) == tg, bar);
            __builtin_amdgcn_fence(__ATOMIC_ACQUIRE, "agent");
            xb_add(&bar[XB_XGEN(b.x)], 1u);
            asm volatile("s_waitcnt vmcnt(0)" ::: "memory");
        } else {
            XB_SPIN(xb_ld(&bar[XB_XGEN(b.x)]) == gen, bar);
            __builtin_amdgcn_fence(__ATOMIC_ACQUIRE, "agent");
            asm volatile("s_waitcnt vmcnt(0)" ::: "memory");
        }
    }
    __syncthreads();
}

DI float wave_sum(float v) {
#pragma unroll
    for (int o = 1; o < 64; o <<= 1) v += __shfl_xor(v, o);
    return v;
}
template <bool ROPEPERM>
DI void p0_transpose_item(const float* W, int K, int N, bf16* WT, LAS float* scr, int item, int lane, const float* gain = nullptr) {
    const int nblk = N / 32, kb = item / nblk, nb = item % nblk, k0 = 64 * kb, n0 = 32 * nb;
    int ncol = n0 + (lane & 31);
    if (ROPEPERM && ncol < 4096) { const int o = ncol & 127; ncol = (ncol & ~127) + (o >> 1) + 64 * (o & 1); }
    float wv[32];
#pragma unroll
    for (int i = 0; i < 32; ++i) { const int kk = 2 * i + (lane >> 5); wv[i] = W[(size_t)(k0 + kk) * N + ncol]; }
    if (gain) {
#pragma unroll
        for (int i = 0; i < 32; ++i) wv[i] *= gain[k0 + 2 * i + (lane >> 5)]; }
#pragma unroll
    for (int i = 0; i < 32; ++i) { const int kk = 2 * i + (lane >> 5); scr[kk * 33 + (lane & 31)] = wv[i]; }
    LDS_WAIT(); asm volatile("" ::: "memory");
    const int c = lane & 7;
#pragma unroll
    for (int j = 0; j < 4; ++j) { const int n = (lane >> 3) + 8 * j; const LAS float* s = scr + (8 * c) * 33 + n;
        v4u o; o.x = pk2(s[0 * 33], s[1 * 33]); o.y = pk2(s[2 * 33], s[3 * 33]); o.z = pk2(s[4 * 33], s[5 * 33]); o.w = pk2(s[6 * 33], s[7 * 33]);
        *(GAS v4u*)(WT + (size_t)(n0 + n) * K + k0 + 8 * c) = o; }
    LDS_WAIT(); asm volatile("" ::: "memory");
}
DI void rms_row_to_bf16(const float* xrow, const float* gain, bf16* orow, int lane) {
    const GAS f32x4* xr = (const GAS f32x4*)xrow + lane;
    f32x4 v[16]; float s = 0.f;
#pragma unroll
    for (int j = 0; j < 16; ++j) { v[j] = xr[64 * j]; s += (v[j].x * v[j].x + v[j].y * v[j].y) + (v[j].z * v[j].z + v[j].w * v[j].w); }
    const float rstd = 1.0f / sqrtf(wave_sum(s) * (1.f / DM) + RMS_EPS);
    const GAS f32x4* gr = (const GAS f32x4*)gain + lane;
    GAS v2u* o8 = (GAS v2u*)orow + lane;
#pragma unroll
    for (int j = 0; j < 16; ++j) { const f32x4 g = gr[64 * j]; v2u w; w.x = pk2(v[j].x * rstd * g.x, v[j].y * rstd * g.y); w.y = pk2(v[j].z * rstd * g.z, v[j].w * rstd * g.w); o8[64 * j] = w; }
}
DI void final_row(const bf16* xrow, float ssrow, const float* gain, float* orow, int lane, bool poison) {
    float rstd = __builtin_amdgcn_rsqf(ssrow * (1.f / DM) + RMS_EPS);
    if (poison) rstd = __builtin_nanf("");
    const GAS v4u* xr = (const GAS v4u*)xrow + lane; const GAS f32x4* gr = (const GAS f32x4*)gain + 2 * lane; GAS f32x4* o = (GAS f32x4*)orow + 2 * lane;
    v4u v[8];
#pragma unroll
    for (int j = 0; j < 8; ++j) v[j] = xr[64 * j];
#pragma unroll
    for (int j = 0; j < 8; ++j) { const f32x4 g0 = gr[128 * j], g1 = gr[128 * j + 1];
        o[128 * j] = (f32x4){bflo(v[j].x) * rstd * g0.x, bfhi(v[j].x) * rstd * g0.y, bflo(v[j].y) * rstd * g0.z, bfhi(v[j].y) * rstd * g0.w};
        o[128 * j + 1] = (f32x4){bflo(v[j].z) * rstd * g1.x, bfhi(v[j].z) * rstd * g1.y, bflo(v[j].w) * rstd * g1.z, bfhi(v[j].w) * rstd * g1.w}; }
}

#define MFMA32(a, b, c) __builtin_amdgcn_mfma_f32_32x32x16_bf16((a), (b), (c), 0, 0, 0)
DI int crow(int reg, int h) { return (reg & 3) + 8 * (reg >> 2) + 4 * h; }
DI unsigned off_b(unsigned row, unsigned ch) { return 256u * row + 16u * (ch ^ (((row & 3u) << 2) | ((row >> 2) & 3u))); }
DI bf16x8 row_frag(const LAS unsigned char* img, int rowbase, int lane, int ks) { return *(const LAS bf16x8*)(img + off_b(rowbase + (lane & 31), 2 * ks + (lane >> 5))); }
DI v4i16_t tr4(const LAS unsigned char* p) { return __builtin_amdgcn_ds_read_tr16_b64_v4i16((LAS v4i16_t*)p); }
DI bf16x8 tr_frag_nat(const LAS unsigned char* img, int rowbase, int lane, int c, int ks) {
    const unsigned h = lane >> 5, blk = (lane >> 4) & 1, q = (lane & 15) >> 2, p = lane & 3;
    const unsigned r0 = rowbase + 16 * ks + 8 * h + q, ch = 4 * c + 2 * blk + (p >> 1);
    const v4i16_t lo = tr4(img + off_b(r0, ch) + 8 * (p & 1)), hi = tr4(img + off_b(r0 + 4, ch) + 8 * (p & 1));
    return __builtin_shufflevector(lo, hi, 0, 1, 2, 3, 4, 5, 6, 7);
}
DI bf16x8 tr_frag_perm(const LAS unsigned char* img, int rowbase, int lane, int c, int s) {
    const unsigned h = lane >> 5, blk = (lane >> 4) & 1, q = (lane & 15) >> 2, p = lane & 3;
    const unsigned r0 = rowbase + 16 * s + 4 * h + q, ch = 4 * c + 2 * blk + (p >> 1);
    const v4i16_t lo = tr4(img + off_b(r0, ch) + 8 * (p & 1)), hi = tr4(img + off_b(r0 + 8, ch) + 8 * (p & 1));
    return __builtin_shufflevector(lo, hi, 0, 1, 2, 3, 4, 5, 6, 7);
}
template <int S> DI bf16x8 pack_step(const f32x16& x) {
    v4u p; p.x = pk2(x[8 * S], x[8 * S + 1]); p.y = pk2(x[8 * S + 2], x[8 * S + 3]); p.z = pk2(x[8 * S + 4], x[8 * S + 5]); p.w = pk2(x[8 * S + 6], x[8 * S + 7]);
    return __builtin_bit_cast(bf16x8, p);
}
DI void stage_tile(LAS unsigned char* img, const bf16* g, size_t pitch, int tid) {
#pragma unroll
    for (int i = 0; i < 4; ++i) { const int n = tid + 512 * i, row = n >> 4, ch = n & 15;
        const v4u v = *(const GAS v4u*)(g + (size_t)row * pitch + ch * 8);
        *(LAS v4u*)(img + off_b(row, ch)) = v; }
}
DI void stage_tile_scaled(LAS unsigned char* img, const bf16* g, size_t pitch, int tid, float a, float b) {
#pragma unroll
    for (int i = 0; i < 4; ++i) { const int n = tid + 512 * i, row = n >> 4, ch = n & 15;
        const v4u v = *(const GAS v4u*)(g + (size_t)row * pitch + ch * 8); const float sc = ex2(a + b * (float)row);
        v4u o; o.x = pk2(bflo(v.x) * sc, bfhi(v.x) * sc); o.y = pk2(bflo(v.y) * sc, bfhi(v.y) * sc); o.z = pk2(bflo(v.z) * sc, bfhi(v.z) * sc); o.w = pk2(bflo(v.w) * sc, bfhi(v.w) * sc);
        *(LAS v4u*)(img + off_b(row, ch)) = o; }
}

template <bool WIN>
DI void attn_unit(LAS unsigned char* lds, const LAS float* tbh, const bf16* qptr, size_t qpitch, const bf16* kptr, const bf16* vptr, size_t kvpitch, int lo, int hi,
                  bf16* optr, size_t opitch, float m0, float l0, int iq, int tid) {
    const int lane = tid & 63, r = lane & 31, h = lane >> 5;
    bf16x8 qf[8];
#pragma unroll
    for (int ks = 0; ks < 8; ++ks) qf[ks] = *(const GAS bf16x8*)(qptr + (size_t)r * qpitch + 16 * ks + 8 * h);
    f32x16 o[4];
#pragma unroll
    for (int c = 0; c < 4; ++c)
#pragma unroll
        for (int i = 0; i < 16; ++i) o[c][i] = 0.f;
    float m = m0, l = l0;
    LAS unsigned char* imgK = lds; LAS unsigned char* imgV = lds + 32768;
    for (int dk = lo; dk < hi; ++dk) {
        __syncthreads();
        stage_tile(imgK, kptr + (ptrdiff_t)dk * 128 * (ptrdiff_t)kvpitch, kvpitch, tid);
        stage_tile(imgV, vptr + (ptrdiff_t)dk * 128 * (ptrdiff_t)kvpitch, kvpitch, tid);
        __syncthreads();
#pragma unroll
        for (int kh = 0; kh < 2; ++kh) {
        f32x16 st[2];
#pragma unroll
        for (int kt = 0; kt < 2; ++kt) {
#pragma unroll
            for (int i = 0; i < 16; ++i) st[kt][i] = 0.f;
#pragma unroll
            for (int ks = 0; ks < 8; ++ks) st[kt] = MFMA32(row_frag(imgK, 64 * kh + 32 * kt, lane, ks), qf[ks], st[kt]);
        }
        if (WIN) {
            const int relb = 128 * dk - iq + 128 + 64 * kh;
#pragma unroll
            for (int kt = 0; kt < 2; ++kt)
#pragma unroll
                for (int i = 0; i < 16; ++i) { const int idx = relb + 32 * kt + crow(i, h); const bool ok = (unsigned)idx <= 256u;
                    const float bias = tbh[ok ? idx : 0]; st[kt][i] = ok ? st[kt][i] + bias : -1e30f; }
        }
        float mx = st[0][0];
#pragma unroll
        for (int kt = 0; kt < 2; ++kt)
#pragma unroll
            for (int i = 0; i < 16; ++i) mx = fmaxf(mx, st[kt][i]);
        mx = fmaxf(mx, __shfl_xor(mx, 32));
        const float mnew = fmaxf(m, mx), alpha = ex2(m - mnew); m = mnew;
        float rs = 0.f;
#pragma unroll
        for (int kt = 0; kt < 2; ++kt)
#pragma unroll
            for (int i = 0; i < 16; ++i) { const float p = ex2(st[kt][i] - mnew); st[kt][i] = p; rs += p; }
        rs += __shfl_xor(rs, 32);
        l = l * alpha + rs;
#pragma unroll
        for (int c = 0; c < 4; ++c)
#pragma unroll
            for (int i = 0; i < 16; ++i) o[c][i] *= alpha;
#pragma unroll
        for (int kt = 0; kt < 2; ++kt) {
            const bf16x8 p0 = pack_step<0>(st[kt]), p1 = pack_step<1>(st[kt]);
#pragma unroll
            for (int c = 0; c < 4; ++c) { o[c] = MFMA32(tr_frag_perm(imgV, 64 * kh + 32 * kt, lane, c, 0), p0, o[c]); o[c] = MFMA32(tr_frag_perm(imgV, 64 * kh + 32 * kt, lane, c, 1), p1, o[c]); }
        }
        }
    }
    const float inv = 1.0f / l;
#pragma unroll
    for (int c = 0; c < 4; ++c)
#pragma unroll
        for (int g4 = 0; g4 < 4; ++g4) { v2u w; w.x = pk2(o[c][4 * g4] * inv, o[c][4 * g4 + 1] * inv); w.y = pk2(o[c][4 * g4 + 2] * inv, o[c][4 * g4 + 3] * inv);
            *(GAS v2u*)(optr + (size_t)r * opitch + 32 * c + 8 * g4 + 4 * h) = w; }
}

DI void ret_kv_unit(LAS unsigned char* lds, const bf16* kg, const bf16* vg, size_t pitch, bf16* STf, bf16* STb, float lf2, float lb2, int tid) {
    const int lane = tid & 63, w = __builtin_amdgcn_readfirstlane(tid >> 6), r = lane & 31, h = lane >> 5;
    __syncthreads();
    stage_tile(lds, vg, pitch, tid);
    stage_tile_scaled(lds + 32768, kg, pitch, tid, 127.f * lf2, -lf2);
    stage_tile_scaled(lds + 65536, kg, pitch, tid, 0.f, lb2);
    __syncthreads();
    const int dir = w & 1, ce = w >> 1;
    const LAS unsigned char* imgK = lds + 32768 + dir * 32768;
    f32x16 acc[4];
#pragma unroll
    for (int c = 0; c < 4; ++c)
#pragma unroll
        for (int i = 0; i < 16; ++i) acc[c][i] = 0.f;
#pragma unroll
    for (int ks = 0; ks < 8; ++ks) { const bf16x8 bfr = tr_frag_nat(lds, 0, lane, ce, ks);
#pragma unroll
        for (int cd = 0; cd < 4; ++cd) acc[cd] = MFMA32(tr_frag_nat(imgK, 0, lane, cd, ks), bfr, acc[cd]); }
    bf16* dst = (dir ? STb : STf) + (size_t)(32 * ce + r) * 128 + 4 * h;
#pragma unroll
    for (int cd = 0; cd < 4; ++cd)
#pragma unroll
        for (int g4 = 0; g4 < 4; ++g4) { v2u x; x.x = pk2(acc[cd][4 * g4], acc[cd][4 * g4 + 1]); x.y = pk2(acc[cd][4 * g4 + 2], acc[cd][4 * g4 + 3]); *(GAS v2u*)(dst + 32 * cd + 8 * g4) = x; }
}
DI void ret_scan(bf16* ST, int nseq, int nchunk, const float* dec_f, const float* dec_b, int gtid, int nthreads) {
    const int ntask = nseq * 32 * 2048;
    for (int task = gtid; task < ntask; task += nthreads) {
        const int chain = task >> 11, eo = (task & 2047) * 8, seq = chain >> 5, hh = (chain >> 1) & 15, dir = chain & 1;
        const float lg = -expf(dir ? dec_b[hh] : dec_f[hh]), cd = ex2(128.f * lg * LOG2E);
        float s[8];
#pragma unroll
        for (int e = 0; e < 8; ++e) s[e] = 0.f;
        const ptrdiff_t cstride = (ptrdiff_t)16 * 2 * 16384 * (dir ? -1 : 1);
        bf16* p = ST + ((size_t)((seq * nchunk + (dir ? nchunk - 1 : 0)) * 16 + hh) * 2 + dir) * 16384 + eo;
        for (int cc = 0; cc < nchunk; cc += 8) {
            v4u v[8];
#pragma unroll
            for (int u = 0; u < 8; ++u) v[u] = *(const GAS v4u*)(p + u * cstride);
#pragma unroll
            for (int u = 0; u < 8; ++u) {
                v4u o; o.x = pk2(s[0], s[1]); o.y = pk2(s[2], s[3]); o.z = pk2(s[4], s[5]); o.w = pk2(s[6], s[7]);
                *(GAS v4u*)(p + u * cstride) = o;
                s[0] = s[0] * cd + bflo(v[u].x); s[1] = s[1] * cd + bfhi(v[u].x); s[2] = s[2] * cd + bflo(v[u].y); s[3] = s[3] * cd + bfhi(v[u].y);
                s[4] = s[4] * cd + bflo(v[u].z); s[5] = s[5] * cd + bfhi(v[u].z); s[6] = s[6] * cd + bflo(v[u].w); s[7] = s[7] * cd + bfhi(v[u].w);
            }
            p += 8 * cstride;
        }
    }
}
DI void ret_out_unit(LAS unsigned char* lds, LAS float* part, const bf16* qg, const bf16* kg, const bf16* vg, const bf16* gg, size_t pitch, const bf16* RfT, const bf16* RbT,
                     bf16* yg, size_t ypitch, float lf2, float lb2, int tid) {
    const int lane = tid & 63, w = __builtin_amdgcn_readfirstlane(tid >> 6), r = lane & 31, h = lane >> 5;
    __syncthreads();
    stage_tile(lds, kg, pitch, tid);
    stage_tile(lds + 32768, vg, pitch, tid);
    stage_tile(lds + 65536, RfT, 128, tid);
    stage_tile(lds + 98304, RbT, 128, tid);
    const int i = 32 * (w & 3) + r, eh = w >> 2;
    bf16x8 qf[8];
#pragma unroll
    for (int ks = 0; ks < 8; ++ks) qf[ks] = *(const GAS bf16x8*)(qg + (size_t)i * pitch + 16 * ks + 8 * h);
    __syncthreads();
    f32x16 y[2];
    {
        const float xf = ex2((float)(i + 1) * lf2), xb = ex2((float)(128 - i) * lb2);
        f32x16 cc[2];
#pragma unroll
        for (int c2 = 0; c2 < 2; ++c2)
#pragma unroll
            for (int q = 0; q < 16; ++q) cc[c2][q] = 0.f;
#pragma unroll
        for (int ks = 0; ks < 8; ++ks)
#pragma unroll
            for (int c2 = 0; c2 < 2; ++c2) cc[c2] = MFMA32(row_frag(lds + 65536, 32 * (2 * eh + c2), lane, ks), qf[ks], cc[c2]);
#pragma unroll
        for (int c2 = 0; c2 < 2; ++c2)
#pragma unroll
            for (int q = 0; q < 16; ++q) { y[c2][q] = xf * cc[c2][q]; cc[c2][q] = 0.f; }
        __builtin_amdgcn_sched_barrier(0);
#pragma unroll
        for (int ks = 0; ks < 8; ++ks)
#pragma unroll
            for (int c2 = 0; c2 < 2; ++c2) cc[c2] = MFMA32(row_frag(lds + 98304, 32 * (2 * eh + c2), lane, ks), qf[ks], cc[c2]);
#pragma unroll
        for (int c2 = 0; c2 < 2; ++c2)
#pragma unroll
            for (int q = 0; q < 16; ++q) y[c2][q] += xb * cc[c2][q];
        __builtin_amdgcn_sched_barrier(0);
    }
#pragma unroll
    for (int jt = 0; jt < 4; ++jt) {
        f32x16 st;
#pragma unroll
        for (int q = 0; q < 16; ++q) st[q] = 0.f;
#pragma unroll
        for (int ks = 0; ks < 8; ++ks) st = MFMA32(row_frag(lds, 32 * jt, lane, ks), qf[ks], st);
#pragma unroll
        for (int q = 0; q < 16; ++q) { const int d = i - (32 * jt + crow(q, h)); const float f = ex2((float)d * (d >= 0 ? lf2 : -lb2)); st[q] *= f; }
        const bf16x8 p0 = pack_step<0>(st), p1 = pack_step<1>(st);
#pragma unroll
        for (int c2 = 0; c2 < 2; ++c2) { y[c2] = MFMA32(tr_frag_perm(lds + 32768, 32 * jt, lane, 2 * eh + c2, 0), p0, y[c2]); y[c2] = MFMA32(tr_frag_perm(lds + 32768, 32 * jt, lane, 2 * eh + c2, 1), p1, y[c2]); }
    }
    float ss = 0.f;
#pragma unroll
    for (int c2 = 0; c2 < 2; ++c2)
#pragma unroll
        for (int q = 0; q < 16; ++q) ss += y[c2][q] * y[c2][q];
    ss += __shfl_xor(ss, 32);
    if (h == 0) part[w * 32 + r] = ss;
    __syncthreads();
    const float tot = part[w * 32 + r] + part[(w ^ 4) * 32 + r];
    const float rstd = 1.0f / sqrtf(tot * (1.f / 128.f) + RMS_EPS);
#pragma unroll
    for (int c2 = 0; c2 < 2; ++c2)
#pragma unroll
        for (int g4 = 0; g4 < 4; ++g4) { const int e0 = 32 * (2 * eh + c2) + 8 * g4 + 4 * h;
            const v2u gv = *(const GAS v2u*)(gg + (size_t)i * pitch + e0);
            v2u x; x.x = pk2(y[c2][4 * g4] * rstd * bflo(gv.x), y[c2][4 * g4 + 1] * rstd * bfhi(gv.x)); x.y = pk2(y[c2][4 * g4 + 2] * rstd * bflo(gv.y), y[c2][4 * g4 + 3] * rstd * bfhi(gv.y));
            *(GAS v2u*)(yg + (size_t)i * ypitch + e0) = x; }
}
DI void tile_load(v4u (&r)[4], const bf16* g, size_t pitch, int tid) {
#pragma unroll
    for (int i = 0; i < 4; ++i) { const int n = tid + 512 * i, row = n >> 4, ch = n & 15; r[i] = *(const GAS v4u*)(g + (size_t)row * pitch + ch * 8); }
}
DI void tile_write(LAS unsigned char* img, const v4u (&r)[4], int tid) {
#pragma unroll
    for (int i = 0; i < 4; ++i) { const int n = tid + 512 * i, row = n >> 4, ch = n & 15; *(LAS v4u*)(img + off_b(row, ch)) = r[i]; }
}
DI void tile_write_scaled(LAS unsigned char* img, const v4u (&r)[4], int tid, float a, float b) {
#pragma unroll
    for (int i = 0; i < 4; ++i) { const int n = tid + 512 * i, row = n >> 4, ch = n & 15; const v4u v = r[i]; const float sc = ex2(a + b * (float)row);
        v4u o; o.x = pk2(bflo(v.x) * sc, bfhi(v.x) * sc); o.y = pk2(bflo(v.y) * sc, bfhi(v.y) * sc); o.z = pk2(bflo(v.z) * sc, bfhi(v.z) * sc); o.w = pk2(bflo(v.w) * sc, bfhi(v.w) * sc);
        *(LAS v4u*)(img + off_b(row, ch)) = o; }
}

template <bool WIN, int g>
DI void attn_phase(LAS unsigned char* L, const bf16* QB, const bf16* KB, const bf16* VB, bf16* OB, const float* TB, const float* sink, int tid, int G) {
    constexpr int nbs = g ? 64 : 32, NU = WIN ? 1024 : 512;
    constexpr size_t qpitch = WIN ? INW : MEMW, kvpitch = WIN ? INW : 2 * MEMW, opitch = WIN ? DM : MEMW;
    const int lane0 = tid & 63, wave = __builtin_amdgcn_readfirstlane(tid >> 6);
    LAS float* const tb = (LAS float*)(L + TAB_OFF);
    if (WIN) for (int e = tid; e < 16 * TBW; e += NTHREADS) tb[e] = TB[e];
    int u = blockIdx.x; if (u >= NU) return;
    int lo, hi, dk;
#define ATT_RANGE(uu, lo_, hi_) do { if (WIN) { const int nb_ = ((uu) >> 3) % nbs; lo_ = nb_ == 0 ? 0 : -1; hi_ = nb_ == nbs - 1 ? 1 : 2; } else { lo_ = 0; hi_ = 2; } } while (0)
#define ATT_KROW(uu, dd) (WIN ? (size_t)(((uu) >> 3) * 128 + (dd) * 128) : (size_t)(((((uu) >> 2) * 256) < HTOK ? ((((uu) >> 2) * 256) >> 12) * 256 : 1024 + (((((uu) >> 2) * 256) - HTOK) >> 13) * 256) + (dd) * 128))
#define ATT_KCOL(uu) (WIN ? (((uu) & 7) >> 1) * HD : ((uu) & 3) * HD)
    ATT_RANGE(u, lo, hi); dk = lo;
    v4u rk[4], rv[4];
    tile_load(rk, KB + ATT_KROW(u, dk) * kvpitch + ATT_KCOL(u), kvpitch, tid); tile_load(rv, VB + ATT_KROW(u, dk) * kvpitch + ATT_KCOL(u), kvpitch, tid);
    tile_write(L, rk, tid); tile_write(L + 32768, rv, tid);
    int un = u, dkn = dk + 1, lon = lo, hin = hi;
    if (dkn == hin) { un = u + G; if (un < NU) { ATT_RANGE(un, lon, hin); dkn = lon; } }
    if (un < NU) { tile_load(rk, KB + ATT_KROW(un, dkn) * kvpitch + ATT_KCOL(un), kvpitch, tid); tile_load(rv, VB + ATT_KROW(un, dkn) * kvpitch + ATT_KCOL(un), kvpitch, tid); }
    bf16x8 qf[8]; f32x16 o[4]; float m = 0.f, l = 0.f;
    int b = 0;
    for (;;) {
        int lane = lane0; asm volatile("" : "+v"(lane));
        const int r = lane & 31, h = lane >> 5;
        __syncthreads();
        LAS unsigned char* const imgK = L + b * 65536; LAS unsigned char* const imgV = imgK + 32768;
        const int qrow = WIN ? (u >> 3) * 128 + 32 * (wave & 3) : (u >> 2) * 256 + 32 * wave;
        const int qcol = WIN ? QA_OFF + (2 * (u & 7) + (wave >> 2)) * HD : (u & 3) * HD;
        if (dk == lo) {
            const bf16* qptr = QB + (size_t)qrow * qpitch + qcol;
#pragma unroll
            for (int ks = 0; ks < 8; ++ks) qf[ks] = *(const GAS bf16x8*)(qptr + (size_t)r * qpitch + 16 * ks + 8 * h);
#pragma unroll
            for (int c = 0; c < 4; ++c)
#pragma unroll
                for (int i = 0; i < 16; ++i) o[c][i] = 0.f;
            if (WIN) { m = sink[2 * (u & 7) + (wave >> 2)] * LOG2E; l = 1.0f; } else { m = -1e30f; l = 0.f; }
        }
        const LAS float* const tbh = tb + (2 * (u & 7) + (wave >> 2)) * TBW;
        const int iq = 32 * (wave & 3) + r;
#pragma unroll
        for (int kh = 0; kh < 2; ++kh) {
            f32x16 st[2];
#pragma unroll
            for (int kt = 0; kt < 2; ++kt) {
#pragma unroll
                for (int i = 0; i < 16; ++i) st[kt][i] = 0.f;
#pragma unroll
                for (int ks = 0; ks < 8; ++ks) st[kt] = MFMA32(row_frag(imgK, 64 * kh + 32 * kt, lane, ks), qf[ks], st[kt]);
            }
            if (WIN) {
                const int relb = 128 * dk - iq + 128 + 64 * kh;
#pragma unroll
                for (int kt = 0; kt < 2; ++kt)
#pragma unroll
                    for (int i = 0; i < 16; ++i) { const int idx = relb + 32 * kt + crow(i, h); const bool ok = (unsigned)idx <= 256u;
                        const float bias = tbh[ok ? idx : 0]; st[kt][i] = ok ? st[kt][i] + bias : -1e30f; }
            }
            float mx = st[0][0];
#pragma unroll
            for (int kt = 0; kt < 2; ++kt)
#pragma unroll
                for (int i = 0; i < 16; ++i) mx = fmaxf(mx, st[kt][i]);
            mx = fmaxf(mx, __shfl_xor(mx, 32));
            const float mnew = fmaxf(m, mx), alpha = ex2(m - mnew); m = mnew;
            float rs = 0.f;
#pragma unroll
            for (int kt = 0; kt < 2; ++kt)
#pragma unroll
                for (int i = 0; i < 16; ++i) { const float p = ex2(st[kt][i] - mnew); st[kt][i] = p; rs += p; }
            rs += __shfl_xor(rs, 32);
            l = l * alpha + rs;
#pragma unroll
            for (int c = 0; c < 4; ++c)
#pragma unroll
                for (int i = 0; i < 16; ++i) o[c][i] *= alpha;
#pragma unroll
            for (int kt = 0; kt < 2; ++kt) {
                const bf16x8 p0 = pack_step<0>(st[kt]), p1 = pack_step<1>(st[kt]);
#pragma unroll
                for (int c = 0; c < 4; ++c) { o[c] = MFMA32(tr_frag_perm(imgV, 64 * kh + 32 * kt, lane, c, 0), p0, o[c]); o[c] = MFMA32(tr_frag_perm(imgV, 64 * kh + 32 * kt, lane, c, 1), p1, o[c]); }
            }
        }
        if (dk == hi - 1) {
            const float inv = 1.0f / l;
            bf16* optr = OB + (size_t)qrow * opitch + (WIN ? RETW + (2 * (u & 7) + (wave >> 2)) * HD : (u & 3) * HD);
#pragma unroll
            for (int c = 0; c < 4; ++c)
#pragma unroll
                for (int g4 = 0; g4 < 4; ++g4) { v2u w; w.x = pk2(o[c][4 * g4] * inv, o[c][4 * g4 + 1] * inv); w.y = pk2(o[c][4 * g4 + 2] * inv, o[c][4 * g4 + 3] * inv);
                    *(GAS v2u*)(optr + (size_t)r * opitch + 32 * c + 8 * g4 + 4 * h) = w; }
        }
        if (un >= NU) break;
        tile_write(L + (b ^ 1) * 65536, rk, tid); tile_write(L + (b ^ 1) * 65536 + 32768, rv, tid);
        u = un; dk = dkn; lo = lon; hi = hin; b ^= 1;
        dkn = dk + 1;
        if (dkn == hin) { un = u + G; if (un < NU) { ATT_RANGE(un, lon, hin); dkn = lon; } }
        if (un < NU) { tile_load(rk, KB + ATT_KROW(un, dkn) * kvpitch + ATT_KCOL(un), kvpitch, tid); tile_load(rv, VB + ATT_KROW(un, dkn) * kvpitch + ATT_KCOL(un), kvpitch, tid); }
    }
#undef ATT_RANGE
#undef ATT_KROW
#undef ATT_KCOL
}

DI void ret_kv_phase(LAS unsigned char* L, const bf16* PROJ, bf16* ST, const float* dec_f, const float* dec_b, int tid, int G) {
    constexpr int NU = 2048;
    const int lane0 = tid & 63, w = __builtin_amdgcn_readfirstlane(tid >> 6);
    int u = blockIdx.x; if (u >= NU) return;
    v4u rk[4], rv[4];
    { const bf16* rowp = PROJ + (size_t)(u >> 4) * 128 * INW + (u & 15) * HD; tile_load(rk, rowp + RETW, INW, tid); tile_load(rv, rowp + 2 * RETW, INW, tid); }
    for (;;) {
        int lane = lane0; asm volatile("" : "+v"(lane)); const int r = lane & 31, h = lane >> 5;
        const int hh = u & 15, c = u >> 4;
        const float lf2 = -expf(dec_f[hh]) * LOG2E, lb2 = -expf(dec_b[hh]) * LOG2E;
        __syncthreads();
        tile_write(L, rv, tid);
        tile_write_scaled(L + 32768, rk, tid, 127.f * lf2, -lf2);
        tile_write_scaled(L + 65536, rk, tid, 0.f, lb2);
        __syncthreads();
        const int un = u + G;
        if (un < NU) { const bf16* rowp = PROJ + (size_t)(un >> 4) * 128 * INW + (un & 15) * HD; tile_load(rk, rowp + RETW, INW, tid); tile_load(rv, rowp + 2 * RETW, INW, tid); }
        const int dir = w & 1, ce = w >> 1;
        const LAS unsigned char* imgK = L + 32768 + dir * 32768;
        f32x16 acc[4];
#pragma unroll
        for (int cc = 0; cc < 4; ++cc)
#pragma unroll
            for (int i = 0; i < 16; ++i) acc[cc][i] = 0.f;
#pragma unroll
        for (int ks = 0; ks < 8; ++ks) { const bf16x8 bfr = tr_frag_nat(L, 0, lane, ce, ks);
#pragma unroll
            for (int cd = 0; cd < 4; ++cd) acc[cd] = MFMA32(tr_frag_nat(imgK, 0, lane, cd, ks), bfr, acc[cd]); }
        bf16* dst = ST + ((size_t)(c * 16 + hh) * 2 + dir) * 16384 + (size_t)(32 * ce + r) * 128 + 4 * h;
#pragma unroll
        for (int cd = 0; cd < 4; ++cd)
#pragma unroll
            for (int g4 = 0; g4 < 4; ++g4) { v2u x; x.x = pk2(acc[cd][4 * g4], acc[cd][4 * g4 + 1]); x.y = pk2(acc[cd][4 * g4 + 2], acc[cd][4 * g4 + 3]); *(GAS v2u*)(dst + 32 * cd + 8 * g4) = x; }
        if (un >= NU) break;
        u = un;
    }
}

DI void ret_out_phase(LAS unsigned char* L, const bf16* PROJ, bf16* Y, const bf16* ST, const float* dec_f, const float* dec_b, int tid, int G) {
    constexpr int NU = 2048;
    const int lane0 = tid & 63, w = __builtin_amdgcn_readfirstlane(tid >> 6);
    LAS float* const part = (LAS float*)(L + TAB_OFF);
    LAS unsigned char* const A0 = L; LAS unsigned char* const A1 = L + 32768; LAS unsigned char* const B0 = L + 65536; LAS unsigned char* const B1 = L + 98304;
    int u = blockIdx.x; if (u >= NU) return;
    v4u ra[4], rb[4];
#define RO_LOAD_A(uu) do { const bf16* rowp_ = PROJ + (size_t)((uu) >> 4) * 128 * INW + ((uu) & 15) * HD; tile_load(ra, rowp_ + RETW, INW, tid); tile_load(rb, rowp_ + 2 * RETW, INW, tid); } while (0)
#define RO_LOAD_B(uu) do { const bf16* stp_ = ST + (size_t)(uu) * 2 * 16384; tile_load(ra, stp_, 128, tid); tile_load(rb, stp_ + 16384, 128, tid); } while (0)
    RO_LOAD_A(u);
    tile_write(A0, ra, tid); tile_write(A1, rb, tid);
    RO_LOAD_B(u);
    const int eh = w >> 2;
    f32x16 y[2]; v2u gv[8];
    int fin_u = -1;
#define RO_FINAL() do { const float tot_ = part[w * 32 + r] + part[(w ^ 4) * 32 + r]; const float rstd_ = __builtin_amdgcn_rsqf(tot_ * (1.f / 128.f) + RMS_EPS); \
        bf16* yg_ = Y + (size_t)((fin_u >> 4) * 128 + i) * DM + (fin_u & 15) * HD; \
        _Pragma("unroll") for (int c2 = 0; c2 < 2; ++c2) _Pragma("unroll") for (int g4 = 0; g4 < 4; ++g4) { const int e0 = 32 * (2 * eh + c2) + 8 * g4 + 4 * h; const v2u gq = gv[c2 * 4 + g4]; \
            v2u x; x.x = pk2(y[c2][4 * g4] * rstd_ * bflo(gq.x), y[c2][4 * g4 + 1] * rstd_ * bfhi(gq.x)); x.y = pk2(y[c2][4 * g4 + 2] * rstd_ * bflo(gq.y), y[c2][4 * g4 + 3] * rstd_ * bfhi(gq.y)); \
            *(GAS v2u*)(yg_ + e0) = x; } } while (0)
    for (;;) {
        const int un = u + G;
        int lane = lane0; asm volatile("" : "+v"(lane));
        const int r = lane & 31, h = lane >> 5, i = 32 * (w & 3) + r;
        __syncthreads();
        if (fin_u >= 0) RO_FINAL();
        const int hh = u & 15;
        const float lf2 = -expf(dec_f[hh]) * LOG2E, lb2 = -expf(dec_b[hh]) * LOG2E;
        bf16x8 qf[8];
        { const bf16* qg = PROJ + (size_t)((u >> 4) * 128 + i) * INW + hh * HD;
#pragma unroll
          for (int ks = 0; ks < 8; ++ks) qf[ks] = *(const GAS bf16x8*)(qg + 16 * ks + 8 * h); }
#pragma unroll
        for (int c2 = 0; c2 < 2; ++c2)
#pragma unroll
            for (int q = 0; q < 16; ++q) y[c2][q] = 0.f;
#pragma unroll
        for (int jt = 0; jt < 4; ++jt) {
            f32x16 st;
#pragma unroll
            for (int q = 0; q < 16; ++q) st[q] = 0.f;
#pragma unroll
            for (int ks = 0; ks < 8; ++ks) st = MFMA32(row_frag(A0, 32 * jt, lane, ks), qf[ks], st);
#pragma unroll
            for (int q = 0; q < 16; ++q) { const int d = i - (32 * jt + crow(q, h)); const float f = ex2((float)d * (d >= 0 ? lf2 : -lb2)); st[q] *= f; }
            const bf16x8 p0 = pack_step<0>(st), p1 = pack_step<1>(st);
#pragma unroll
            for (int c2 = 0; c2 < 2; ++c2) { y[c2] = MFMA32(tr_frag_perm(A1, 32 * jt, lane, 2 * eh + c2, 0), p0, y[c2]); y[c2] = MFMA32(tr_frag_perm(A1, 32 * jt, lane, 2 * eh + c2, 1), p1, y[c2]); }
        }
        tile_write(B0, ra, tid); tile_write(B1, rb, tid);
        if (un < NU) RO_LOAD_A(un);
        { const bf16* gg = PROJ + (size_t)((u >> 4) * 128 + i) * INW + 3 * RETW + hh * HD;
#pragma unroll
          for (int c2 = 0; c2 < 2; ++c2)
#pragma unroll
              for (int g4 = 0; g4 < 4; ++g4) gv[c2 * 4 + g4] = *(const GAS v2u*)(gg + 32 * (2 * eh + c2) + 8 * g4 + 4 * h); }
        __syncthreads();
        {
            const float xf = ex2((float)(i + 1) * lf2), xb = ex2((float)(128 - i) * lb2);
            f32x16 cc[2];
#pragma unroll
            for (int c2 = 0; c2 < 2; ++c2)
#pragma unroll
                for (int q = 0; q < 16; ++q) cc[c2][q] = 0.f;
#pragma unroll
            for (int ks = 0; ks < 8; ++ks)
#pragma unroll
                for (int c2 = 0; c2 < 2; ++c2) cc[c2] = MFMA32(row_frag(B0, 32 * (2 * eh + c2), lane, ks), qf[ks], cc[c2]);
#pragma unroll
            for (int c2 = 0; c2 < 2; ++c2)
#pragma unroll
                for (int q = 0; q < 16; ++q) { y[c2][q] += xf * cc[c2][q]; cc[c2][q] = 0.f; }
            __builtin_amdgcn_sched_barrier(0);
#pragma unroll
            for (int ks = 0; ks < 8; ++ks)
#pragma unroll
                for (int c2 = 0; c2 < 2; ++c2) cc[c2] = MFMA32(row_frag(B1, 32 * (2 * eh + c2), lane, ks), qf[ks], cc[c2]);
            float ss = 0.f;
#pragma unroll
            for (int c2 = 0; c2 < 2; ++c2)
#pragma unroll
                for (int q = 0; q < 16; ++q) { const float v = y[c2][q] + xb * cc[c2][q]; y[c2][q] = v; ss += v * v; }
            ss += __shfl_xor(ss, 32);
            if (h == 0) part[w * 32 + r] = ss;
            fin_u = u;
        }
        if (un >= NU) break;
        tile_write(A0, ra, tid); tile_write(A1, rb, tid);
        RO_LOAD_B(un);
        u = un;
    }
    { const int lane = lane0, r = lane & 31, h = lane >> 5, i = 32 * (w & 3) + r; __syncthreads(); RO_FINAL(); }
#undef RO_LOAD_A
#undef RO_LOAD_B
#undef RO_FINAL
}
struct Args { const float* in[20]; float* out; unsigned char* ws; int ph_lo, ph_hi, li, pad; };
DI int t5_bucket(int rel) {
    const int n = rel < 0 ? -rel : rel;
    const int b = n < 8 ? n : n < 12 ? 8 : n < 16 ? 9 : n < 23 ? 10 : n < 32 ? 11 : n < 46 ? 12 : n < 64 ? 13 : n < 91 ? 14 : 15;
    return b + (rel > 0 ? 16 : 0);
}

#define PH_BEGIN() int tid = threadIdx.x; asm volatile("" : "+v"(tid)); unsigned char* ws = args.ws; asm volatile("" : "+s"(ws)); \
    LAS unsigned char* const L = (LAS unsigned char*)lds; const int lane = tid & 63, wave = __builtin_amdgcn_readfirstlane(tid >> 6), G = gridDim.x; \
    const int vcu = (G % 8 == 0) ? ((int)blockIdx.x % 8) * (G / 8) + (int)blockIdx.x / 8 : (int)blockIdx.x; (void)lane; (void)wave; (void)vcu; (void)L
#define GRID_BAR() do { if (N_LAUNCHES == 1) { unsigned* bp_ = (unsigned*)(args.ws + WS_CTL) + CW_BAR; asm volatile("" : "+s"(bp_)); XcdBarrier b_; b_.bar = bp_; b_.x = xb_xcc_id(); \
    b_.st = (volatile LAS unsigned*)((LAS unsigned char*)lds + MISC_OFF) + 8; xcd_barrier(b_); if (NREP(19) > 1) xcd_barrier(b_); } } while (0)
#ifndef REPMASK
#define REPMASK 0
#endif
#define NREP(k) ((((REPMASK) >> (k)) & 1) ? 2 : 1)
#ifndef PHMASK
#define PHMASK 0x7ffff
#endif
#define IN(k) ((((PHMASK) >> (k)) & 1) && lo <= (k) && (k) < hi)
#define BOTH(k) (IN(k) && IN((k) + 1))
template <int g> DI void mixer_half(const Args& args, unsigned char* lds, const int lo, const int hi) {
        const int pb = 1 + 5 * g;
        const int nbs = g ? 64 : 32, nseq = g ? 2 : 4;
        if (IN(pb)) {
            PH_BEGIN();
            pg8::Gemm gm{(const bf16*)(ws + WS_XN) + (size_t)g * HTOK * DM, (const bf16*)(ws + WS_WIN), HTOK, INW, DM}; pg8::StaticOrder S; S.init(HTOK, INW, G, (int)blockIdx.x);
            pg8::EpiProj E{(bf16*)(ws + WS_PROJ), INW, (const float*)(ws + WS_COS), (const float*)(ws + WS_SIN), g ? 8191 : 4095};
            _Pragma("unroll 1") for (int rep = 0; rep < NREP(1); ++rep) pg8::gemm_phase<pg8::EpiProj, pg8::StaticOrder, PG8_ALIGN, PG8_SP2>(L + RING_OFF, gm, S, E);
            if (BOTH(pb)) GRID_BAR();
        }
        if (IN(pb + 1)) {
          _Pragma("unroll 1") for (int rep = 0; rep < NREP(2); ++rep) {
            PH_BEGIN();
            bf16* const PROJ = (bf16*)(ws + WS_PROJ);
            ret_kv_phase(L, PROJ, (bf16*)(ws + WS_ST), args.in[6], args.in[7], tid, G);
            __syncthreads();
            attn_phase<true, g>(L, PROJ, PROJ + KA_OFF, PROJ + VA_OFF, (bf16*)(ws + WS_Y), (const float*)(ws + WS_TB), args.in[8], tid, G);
          }
            if (BOTH(pb + 1)) GRID_BAR();
        }
        if (IN(pb + 2)) {
            PH_BEGIN();
            if (g == 0) {
                if ((int)blockIdx.x >= G - 24) {
                    pg8::Gemm gm{(const bf16*)(ws + WS_MEMN), (const bf16*)(ws + WS_WCKV), NMEM, 2 * MEMW, DM}; pg8::StaticOrder S; S.init(NMEM, 2 * MEMW, 24, (int)blockIdx.x - (G - 24));
                    pg8::EpiBf16S<0, false> E{(bf16*)(ws + WS_KVM), 2 * MEMW, 1.0f, nullptr};
                    pg8::gemm_phase<pg8::EpiBf16S<0, false>, pg8::StaticOrder, PG8_ALIGN, PG8_SP2>(L + RING_OFF, gm, S, E);
                } else ret_scan((bf16*)(ws + WS_ST), nseq, nbs, args.in[6], args.in[7], blockIdx.x * NTHREADS + tid, (G - 24) * NTHREADS);
            } else ret_scan((bf16*)(ws + WS_ST), nseq, nbs, args.in[6], args.in[7], blockIdx.x * NTHREADS + tid, G * NTHREADS);
            if (BOTH(pb + 2)) GRID_BAR();
        }
        if (IN(pb + 3)) {
          _Pragma("unroll 1") for (int rep = 0; rep < NREP(4); ++rep) {
            PH_BEGIN();
            ret_out_phase(L, (const bf16*)(ws + WS_PROJ), (bf16*)(ws + WS_Y), (const bf16*)(ws + WS_ST), args.in[6], args.in[7], tid, G);
          }
            if (BOTH(pb + 3)) GRID_BAR();
        }
        if (IN(pb + 4)) {
            PH_BEGIN();
            pg8::Gemm gm{(const bf16*)(ws + WS_Y), (const bf16*)(ws + WS_WOUT), HTOK, DM, DM}; pg8::StaticOrder S; S.init(HTOK, DM, G, (int)blockIdx.x);
            if (NREP(5) > 1) { pg8::EpiResB<true> E2{args.in[g], nullptr, (bf16*)(ws + WS_PROBE5), DM, (float*)(ws + WS_PROBE_SS)}; pg8::gemm_phase<pg8::EpiResB<true>, pg8::StaticOrder, PG8_ALIGN, PG8_SP2>(L + RING_OFF, gm, S, E2); }
            pg8::EpiResB<true> E{args.in[g], nullptr, (bf16*)(ws + WS_XN) + (size_t)g * HTOK * DM, DM, (float*)(ws + WS_SS) + g * HTOK};
            pg8::gemm_phase<pg8::EpiResB<true>, pg8::StaticOrder, PG8_ALIGN, PG8_SP2>(L + RING_OFF, gm, S, E);
            if (BOTH(pb + 4)) GRID_BAR();
        }
}

__global__ void __launch_bounds__(NTHREADS, 2) hymba_fwd(Args args) {
    extern __shared__ __attribute__((aligned(16))) unsigned char lds[];
    {
        const int t0 = threadIdx.x;
        for (int u = t0; u < (LDS_BYTES - LDSCTL_OFF) / 4; u += NTHREADS) ((LAS unsigned*)((LAS unsigned char*)lds + LDSCTL_OFF))[u] = 0u;
        __syncthreads();
        if (N_LAUNCHES == 1) (void)xcd_barrier_post((unsigned*)(args.ws + WS_CTL) + CW_BAR, (volatile LAS unsigned*)((LAS unsigned char*)lds + MISC_OFF) + 8);
    }
    const int lo = args.ph_lo, hi = args.ph_hi;

    if (IN(0)) {
      _Pragma("unroll 1") for (int rep = 0; rep < NREP(0); ++rep) {
        PH_BEGIN();
        const int gw = vcu * NWAVES + wave, NGW = G * NWAVES, gtid = blockIdx.x * NTHREADS + tid, NT = G * NTHREADS;
        LAS float* scr = (LAS float*)(L + RING_OFF + wave * 16384);
        constexpr int I_IN = (DM / 64) * (INW / 32), I_OUT = (DM / 64) * (DM / 32), I_CQ = (DM / 64) * (MEMW / 32), I_CKV = (DM / 64) * (2 * MEMW / 32), I_CO = (MEMW / 64) * (DM / 32),
                      I_1 = (DM / 64) * (DFF / 32), I_2 = (DFF / 64) * (DM / 32);
        constexpr int NITEMS = I_IN + I_OUT + I_CQ + I_CKV + I_CO + I_1 + I_2;
        for (int it = gw; it < NITEMS; it += NGW) {
            int r = it;
            if (r < I_IN) { p0_transpose_item<true>(args.in[5], DM, INW, (bf16*)(ws + WS_WIN), scr, r, lane); continue; } r -= I_IN;
            if (r < I_OUT) { p0_transpose_item<false>(args.in[10], DM, DM, (bf16*)(ws + WS_WOUT), scr, r, lane); continue; } r -= I_OUT;
            if (r < I_CQ) { p0_transpose_item<false>(args.in[13], DM, MEMW, (bf16*)(ws + WS_WCQ), scr, r, lane, args.in[11]); continue; } r -= I_CQ;
            if (r < I_CKV) { p0_transpose_item<false>(args.in[14], DM, 2 * MEMW, (bf16*)(ws + WS_WCKV), scr, r, lane); continue; } r -= I_CKV;
            if (r < I_CO) { p0_transpose_item<false>(args.in[15], MEMW, DM, (bf16*)(ws + WS_WCO), scr, r, lane); continue; } r -= I_CO;
            if (r < I_1) { p0_transpose_item<false>(args.in[17], DM, DFF, (bf16*)(ws + WS_W1), scr, r, lane, args.in[16]); continue; } r -= I_1;
            p0_transpose_item<false>(args.in[18], DFF, DM, (bf16*)(ws + WS_W2), scr, r, lane);
        }
        float* const COS = (float*)(ws + WS_COS); float* const SIN = (float*)(ws + WS_SIN); float* const TB = (float*)(ws + WS_TB);
        for (int e = gtid; e < 8192 * 64; e += NT) { const int pos = e >> 6, i = e & 63;
            const float inv = exp2f(-(float)i * (13.287712379549449f / 64.0f));
            const float ang = (float)pos * inv;
            double rev = (double)ang * 0.15915494309189535; rev -= floor(rev);
            const float rf = (float)rev;
            COS[e] = __builtin_amdgcn_cosf(rf); SIN[e] = __builtin_amdgcn_sinf(rf); }
        for (int e = gtid; e < 16 * TBW; e += NT) { const int hh = e / TBW, idx = e % TBW; const int rel = idx - 128;
            TB[e] = (idx <= 256) ? args.in[9][t5_bucket(rel) * 16 + hh] * LOG2E : 0.f; }
        bf16* const XN = (bf16*)(ws + WS_XN);
        for (int m = gw; m < NTOK; m += NGW) { const float* src = (m < HTOK) ? args.in[0] + (size_t)m * DM : args.in[1] + (size_t)(m - HTOK) * DM; rms_row_to_bf16(src, args.in[4], XN + (size_t)m * DM, lane); }
        for (int m = gw; m < NMEM; m += NGW) { const float* src = (m < 1024) ? args.in[2] + (size_t)m * DM : args.in[3] + (size_t)(m - 1024) * DM; rms_row_to_bf16(src, args.in[12], (bf16*)(ws + WS_MEMN) + (size_t)m * DM, lane); }
      }
        if (BOTH(0)) GRID_BAR();
    }

    mixer_half<0>(args, lds, lo, hi);
    mixer_half<1>(args, lds, lo, hi);

    if (IN(11)) {
        PH_BEGIN();
        pg8::Gemm gm{(const bf16*)(ws + WS_XN), (const bf16*)(ws + WS_WCQ), NTOK, MEMW, DM}; pg8::StaticOrder S; S.init(NTOK, MEMW, G, (int)blockIdx.x);
        pg8::EpiBf16S<0, true> E{(bf16*)(ws + WS_QC), MEMW, 0.12751743074602224f, (const float*)(ws + WS_SS)};
        _Pragma("unroll 1") for (int rep = 0; rep < NREP(11); ++rep) pg8::gemm_phase<pg8::EpiBf16S<0, true>, pg8::StaticOrder, PG8_ALIGN, PG8_SP2>(L + RING_OFF, gm, S, E);
        if (BOTH(11)) GRID_BAR();
    }
    if (IN(12)) {
      _Pragma("unroll 1") for (int rep = 0; rep < NREP(12); ++rep) {
        PH_BEGIN();
        const bf16* KVM = (const bf16*)(ws + WS_KVM);
        attn_phase<false, 0>(L, (const bf16*)(ws + WS_QC), KVM, KVM + MEMW, (bf16*)(ws + WS_OC), nullptr, nullptr, tid, G);
      }
        if (BOTH(12)) GRID_BAR();
    }
    if (IN(13)) {
        PH_BEGIN();
        pg8::Gemm gm{(const bf16*)(ws + WS_OC), (const bf16*)(ws + WS_WCO), NTOK, DM, MEMW}; pg8::StaticOrder S; S.init(NTOK, DM, G, (int)blockIdx.x);
        if (NREP(13) > 1) { pg8::EpiResB<false> E2{nullptr, (const bf16*)(ws + WS_XN), (bf16*)(ws + WS_PROBE13), DM, (float*)(ws + WS_PROBE_SS)}; pg8::gemm_phase<pg8::EpiResB<false>, pg8::StaticOrder, PG8_ALIGN, PG8_SP2>(L + RING_OFF, gm, S, E2); }
        pg8::EpiResB<false> E{nullptr, (const bf16*)(ws + WS_XN), (bf16*)(ws + WS_XN), DM, (float*)(ws + WS_SS) + NTOK};
        pg8::gemm_phase<pg8::EpiResB<false>, pg8::StaticOrder, PG8_ALIGN, PG8_SP2>(L + RING_OFF, gm, S, E);
        if (BOTH(13)) GRID_BAR();
    }
#pragma unroll
    for (int g = 0; g < 2; ++g) {
        if (IN(14 + 2 * g)) {
            PH_BEGIN();
            pg8::Gemm gm{(const bf16*)(ws + WS_XN) + (size_t)g * HTOK * DM, (const bf16*)(ws + WS_W1), HTOK, DFF, DM}; pg8::StaticOrder S; S.init(HTOK, DFF, G, (int)blockIdx.x);
            pg8::EpiBf16S<1, true> E{(bf16*)(ws + WS_HID), DFF, 1.0f, (const float*)(ws + WS_SS) + NTOK + g * HTOK};
            _Pragma("unroll 1") for (int rep = 0; rep < NREP(14); ++rep) pg8::gemm_phase<pg8::EpiBf16S<1, true>, pg8::StaticOrder, PG8_ALIGN, PG8_SP2>(L + RING_OFF, gm, S, E);
            if (BOTH(14 + 2 * g)) GRID_BAR();
        }
        if (IN(15 + 2 * g)) {
            PH_BEGIN();
            pg8::Gemm gm{(const bf16*)(ws + WS_HID), (const bf16*)(ws + WS_W2), HTOK, DM, DFF}; pg8::StaticOrder S; S.init(HTOK, DM, G, (int)blockIdx.x);
            if (NREP(15) > 1) { pg8::EpiResB<false> E2{nullptr, (const bf16*)(ws + WS_XN) + (size_t)g * HTOK * DM, (bf16*)(ws + WS_PROBE15), DM, (float*)(ws + WS_PROBE_SS)}; pg8::gemm_phase<pg8::EpiResB<false>, pg8::StaticOrder, PG8_ALIGN, PG8_SP2>(L + RING_OFF, gm, S, E2); }
            pg8::EpiResB<false> E{nullptr, (const bf16*)(ws + WS_XN) + (size_t)g * HTOK * DM, (bf16*)(ws + WS_XN) + (size_t)g * HTOK * DM, DM, (float*)(ws + WS_SS) + 2 * NTOK + g * HTOK};
            pg8::gemm_phase<pg8::EpiResB<false>, pg8::StaticOrder, PG8_ALIGN, PG8_SP2>(L + RING_OFF, gm, S, E);
            if (BOTH(15 + 2 * g)) GRID_BAR();
        }
    }
    if (IN(18)) {
        PH_BEGIN();
        const bool poison = (N_LAUNCHES == 1) && (__hip_atomic_load((gu32*)((unsigned*)(ws + WS_CTL) + CW_BAR + XB_TMO), RLX_AGENT) != 0u);
        const int gw = vcu * NWAVES + wave, NGW = G * NWAVES; float* const o = args.out; const bf16* const X = (const bf16*)(ws + WS_XN); const float* const ss3 = (const float*)(ws + WS_SS) + 2 * NTOK;
        _Pragma("unroll 1") for (int rep = 0; rep < NREP(18); ++rep) for (int m = gw; m < NTOK; m += NGW) final_row(X + (size_t)m * DM, ss3[m], args.in[19], o + (size_t)m * DM, lane, poison);
    }
#undef IN
#undef BOTH
}

extern "C" void kernel_launch(void* const* d_in, const int* in_sizes, int n_in, void* d_out, int out_size, void* d_ws, size_t ws_size, hipStream_t stream) {
    static int grid = 0;
    if (grid == 0) {
        if (n_in != 20 || out_size != NTOK * DM || ws_size < WS_END) { fprintf(stderr, "kernel_launch: shape/workspace mismatch (n_in %d, out %d, ws %zu, need %zu); nothing launched\n", n_in, out_size, ws_size, (size_t)WS_END); grid = -1; return; }
        int dev = 0, cus = 0, per_cu = 0;
        if (hipGetDevice(&dev) != hipSuccess || hipDeviceGetAttribute(&cus, hipDeviceAttributeMultiprocessorCount, dev) != hipSuccess) { grid = -1; return; }
        if (hipFuncSetAttribute((const void*)hymba_fwd, hipFuncAttributeMaxDynamicSharedMemorySize, LDS_BYTES) != hipSuccess) { fprintf(stderr, "kernel_launch: hipFuncSetAttribute failed\n"); grid = -1; return; }
        if (hipOccupancyMaxActiveBlocksPerMultiprocessor(&per_cu, (const void*)hymba_fwd, NTHREADS, LDS_BYTES) != hipSuccess || per_cu < 1)
            fprintf(stderr, "kernel_launch: note: occupancy query reports %d workgroups per CU\n", per_cu);
        (void)hipGetLastError();
        grid = cus;
    }
    if (grid < 0) return;
    if (hipMemsetAsync((char*)d_ws + WS_CTL, 0, CTL_ZERO_BYTES, stream) != hipSuccess) return;
    Args a{};
    for (int i = 0; i < 20; ++i) a.in[i] = (const float*)d_in[i];
    a.out = (float*)d_out; a.ws = (unsigned char*)d_ws; a.pad = 0;
    for (int li = 0; li < N_LAUNCHES; ++li) {
        a.ph_lo = (N_LAUNCHES == 1) ? 0 : li; a.ph_hi = (N_LAUNCHES == 1) ? NPHASE : li + 1; a.li = li;
        hipLaunchKernelGGL(hymba_fwd, dim3(grid), dim3(NTHREADS), LDS_BYTES, stream, a);
        const hipError_t le = hipPeekAtLastError();
        if (le != hipSuccess) { fprintf(stderr, "kernel_launch: launch %d failed: %s\n", li, hipGetErrorName(le)); break; }
    }
}
```

```cpp
#include <hip/hip_runtime.h>
#include <cstdio>
#include <cstdint>
namespace pg8 {
#define PG8_LAS __attribute__((address_space(3)))
typedef unsigned short bf16_t;
typedef short bf16x8 __attribute__((ext_vector_type(8)));
typedef float f32x4 __attribute__((ext_vector_type(4)));
typedef unsigned u32x4 __attribute__((ext_vector_type(4)));
constexpr int BM = 256, BK = 64, HALF = 128, HTB = HALF * BK * 2  , STAGE_BYTES = 8 * HTB, NXCD = 8, WGM = 8;

__host__ __device__ __forceinline__ int lds_byte(int r, int c) { const int st = (r >> 4) * 2 + (c >> 5), rr = r & 15, cc = c & 31, ob = rr * 64 + cc * 2; return st * 1024 + (ob ^ (((ob >> 9) & 1) << 5)); }
__host__ __device__ __forceinline__ void stage_rc(int b, int& R, int& C) { const int st = b / 1024, sb = b % 1024, swz = sb ^ (((sb >> 9) & 1) << 5); R = (st >> 1) * 16 + swz / 64; C = (st & 1) * 32 + (swz % 64) / 2; }
__host__ __device__ __forceinline__ int perm32(int rho) { const int n = rho >> 4, i = rho & 15; return 8 * (i >> 2) + 4 * n + (i & 3); }

struct Unit { int pm, pn; };
struct Gemm { const bf16_t* A; const bf16_t* Bt; int M, N, K; int ablk; };

struct StaticOrder {
    int nM, nN, nwg, G, c, rm;
    __host__ __device__ __forceinline__ void init(int M, int N, int G_, int c_, int rm_ = 0) { nM = M / BM; nN = N / BM; nwg = nM * nN; G = G_; c = c_; rm = (rm_ && G_ % NXCD == 0 && nwg % G_ == 0) ? 1 : 0; }
    __host__ __device__ __forceinline__ bool next(int i, Unit& u) const {
        const long L = (long)i * G + c; if (L >= nwg) return false;
        int wgid = (int)L; if (rm) wgid = i * G + (c % NXCD) * (G / NXCD) + c / NXCD; else { const int q = nwg / NXCD, r = nwg % NXCD, xcd = wgid % NXCD, off = wgid / NXCD; wgid = (xcd < r ? xcd * (q + 1) : r * (q + 1) + (xcd - r) * q) + off; }
        const int nig = WGM * nN, gid = wgid / nig, fm = gid * WGM, gsz = (nM - fm) < WGM ? (nM - fm) : WGM;
        u.pm = fm + ((wgid % nig) % gsz); u.pn = (wgid % nig) / gsz; return true;
    }
    __device__ __forceinline__ void a_ready(const Unit&) const {}
    __device__ __forceinline__ void done(const Unit&) const {}
};

typedef float f32x2 __attribute__((ext_vector_type(2)));
typedef __bf16 bf16x2_t __attribute__((ext_vector_type(2)));
__device__ __forceinline__ unsigned cvt_pk_bf16(float lo, float hi) { f32x2 v = {lo, hi}; bf16x2_t b = __builtin_convertvector(v, bf16x2_t); return __builtin_bit_cast(unsigned, b); }
__device__ __forceinline__ u32x4 pack8(const f32x4& v0, const f32x4& v1) { u32x4 w; w.x = cvt_pk_bf16(v0[0], v0[1]); w.y = cvt_pk_bf16(v0[2], v0[3]); w.z = cvt_pk_bf16(v1[0], v1[1]); w.w = cvt_pk_bf16(v1[2], v1[3]); return w; }

template <int ACT, bool RS> struct EpiBf16S {
    static constexpr bool PERM = true, AFTER_DRAIN = false;
    bf16_t* O; int ldc; float scale; const float* ss;
    __device__ __forceinline__ void operator()(const f32x4 (&acc)[2][2][4][2], const Unit& u, int wr, int wc, int fr, int fq) const {
        const int row0 = u.pm * BM + wr * 64 + fr, col0 = u.pn * BM + wc * 32 + 8 * fq;
        float rsv[2][4];
#pragma unroll
        for (int ai = 0; ai < 2; ++ai)
#pragma unroll
            for (int m = 0; m < 4; ++m) rsv[ai][m] = RS ? ss[row0 + ai * HALF + m * 16] : 0.f;
#pragma unroll
        for (int ai = 0; ai < 2; ++ai)
#pragma unroll
            for (int m = 0; m < 4; ++m) { const int row = row0 + ai * HALF + m * 16;
                bf16_t* rowp = ACT == 1 ? O + (size_t)u.pm * BM * ldc + (size_t)u.pn * 65536 + (size_t)(row - u.pm * BM) * 256 + (col0 - u.pn * BM) : O + (size_t)row * ldc + col0;
                float rs = scale;
                if (RS) rs = scale * __builtin_amdgcn_rsqf(rsv[ai][m] * (1.0f / 4096.0f) + 1e-6f);
#pragma unroll
                for (int bj = 0; bj < 2; ++bj) { f32x4 v0 = acc[ai][bj][m][0] * rs, v1 = acc[ai][bj][m][1] * rs;
                    if (ACT == 1) {
#pragma unroll
                        for (int e = 0; e < 4; ++e) { const float a = fmaxf(v0[e], 0.f), b = fmaxf(v1[e], 0.f); v0[e] = a * a; v1[e] = b * b; } }
                    *(u32x4*)(rowp + bj * HALF) = pack8(v0, v1); } }
    }
};
template <bool BASE_F32> struct EpiResB {
    static constexpr bool PERM = true, AFTER_DRAIN = false;
    const float* basef; const bf16_t* Xin; bf16_t* X; int ldc; float* ss;
    __device__ __forceinline__ void operator()(const f32x4 (&acc)[2][2][4][2], const Unit& u, int wr, int wc, int fr, int fq) const {
        const int row0 = u.pm * BM + wr * 64 + fr, col0 = u.pn * BM + wc * 32 + 8 * fq;
#pragma unroll
        for (int ai = 0; ai < 2; ++ai) {
            f32x4 bf[4][2][2]; u32x4 bw[4][2];
#pragma unroll
            for (int m = 0; m < 4; ++m) { const size_t off = (size_t)(row0 + ai * HALF + m * 16) * ldc + col0;
#pragma unroll
                for (int bj = 0; bj < 2; ++bj) {
                    if (BASE_F32) { bf[m][bj][0] = *(const f32x4*)(basef + off + bj * HALF); bf[m][bj][1] = *(const f32x4*)(basef + off + bj * HALF + 4); }
                    else bw[m][bj] = *(const u32x4*)(Xin + off + bj * HALF); } }
#pragma unroll
            for (int m = 0; m < 4; ++m) { const int row = row0 + ai * HALF + m * 16; const size_t off = (size_t)row * ldc + col0;
                float s = 0.f;
#pragma unroll
                for (int bj = 0; bj < 2; ++bj) {
                    f32x4 b0, b1;
                    if (BASE_F32) { b0 = bf[m][bj][0]; b1 = bf[m][bj][1]; }
                    else { const u32x4 w = bw[m][bj];
                        b0 = (f32x4){__uint_as_float(w.x << 16), __uint_as_float(w.x & 0xffff0000u), __uint_as_float(w.y << 16), __uint_as_float(w.y & 0xffff0000u)};
                        b1 = (f32x4){__uint_as_float(w.z << 16), __uint_as_float(w.z & 0xffff0000u), __uint_as_float(w.w << 16), __uint_as_float(w.w & 0xffff0000u)}; }
                    const f32x4 v0 = b0 + acc[ai][bj][m][0], v1 = b1 + acc[ai][bj][m][1];
                    s += (v0[0] * v0[0] + v0[1] * v0[1]) + (v0[2] * v0[2] + v0[3] * v0[3]) + (v1[0] * v1[0] + v1[1] * v1[1]) + (v1[2] * v1[2] + v1[3] * v1[3]);
                    *(u32x4*)(X + off + bj * HALF) = pack8(v0, v1); }
                s += __shfl_xor(s, 16); s += __shfl_xor(s, 32);
                if (fq == 0) (void)__hip_atomic_fetch_add(ss + row, s, __ATOMIC_RELAXED, __HIP_MEMORY_SCOPE_AGENT); }
        }
    }
};
struct EpiProj {
    static constexpr bool PERM = true, AFTER_DRAIN = false;
    bf16_t* O; int M; const float* cs; const float* sn; int posmask;
    __device__ __forceinline__ void operator()(const f32x4 (&acc)[2][2][4][2], const Unit& u, int wr, int wc, int fr, int fq) const {
        const int row0 = u.pm * BM + wr * 64 + fr;
        const int sec = u.pn >> 3;
        bf16_t* const obase = O + ((size_t)(2 * u.pn) * M + row0) * 128 + wc * 32 + 8 * fq;
        const size_t bjs = (size_t)M * 128;
        if (sec < 2) {
            const int i0 = 16 * wc + 4 * fq; const float ks = sec == 1 ? 0.08838834764831845f : 1.0f;
            f32x4 c4[2][4], s4[2][4];
#pragma unroll
            for (int ai = 0; ai < 2; ++ai)
#pragma unroll
                for (int m = 0; m < 4; ++m) { const int pos = (row0 + ai * HALF + m * 16) & posmask; c4[ai][m] = *(const f32x4*)(cs + (size_t)pos * 64 + i0); s4[ai][m] = *(const f32x4*)(sn + (size_t)pos * 64 + i0); }
#pragma unroll
            for (int ai = 0; ai < 2; ++ai)
#pragma unroll
                for (int m = 0; m < 4; ++m) { const f32x4 c = c4[ai][m] * ks, sv = s4[ai][m] * ks; bf16_t* rowp = obase + (size_t)(ai * HALF + m * 16) * 128;
#pragma unroll
                    for (int bj = 0; bj < 2; ++bj) { const f32x4 v0 = acc[ai][bj][m][0], v1 = acc[ai][bj][m][1]; f32x4 o0, o1;
                        o0[0] = v0[0] * c[0] - v0[1] * sv[0]; o0[1] = v0[0] * sv[0] + v0[1] * c[0];
                        o0[2] = v0[2] * c[1] - v0[3] * sv[1]; o0[3] = v0[2] * sv[1] + v0[3] * c[1];
                        o1[0] = v1[0] * c[2] - v1[1] * sv[2]; o1[1] = v1[0] * sv[2] + v1[1] * c[2];
                        o1[2] = v1[2] * c[3] - v1[3] * sv[3]; o1[3] = v1[2] * sv[3] + v1[3] * c[3];
                        *(u32x4*)(rowp + bj * bjs) = pack8(o0, o1); } }
        } else if (sec == 3) {
#pragma unroll
            for (int ai = 0; ai < 2; ++ai)
#pragma unroll
                for (int m = 0; m < 4; ++m) { bf16_t* rowp = obase + (size_t)(ai * HALF + m * 16) * 128;
#pragma unroll
                    for (int bj = 0; bj < 2; ++bj) { f32x4 v0 = acc[ai][bj][m][0], v1 = acc[ai][bj][m][1];
#pragma unroll
                        for (int e = 0; e < 4; ++e) { v0[e] = v0[e] * __builtin_amdgcn_rcpf(1.f + __builtin_amdgcn_exp2f(-1.4426950408889634f * v0[e]));
                                                      v1[e] = v1[e] * __builtin_amdgcn_rcpf(1.f + __builtin_amdgcn_exp2f(-1.4426950408889634f * v1[e])); }
                        *(u32x4*)(rowp + bj * bjs) = pack8(v0, v1); } }
        } else {
            const float sc = sec == 4 ? 0.12751743074602224f : 1.0f;
#pragma unroll
            for (int ai = 0; ai < 2; ++ai)
#pragma unroll
                for (int m = 0; m < 4; ++m) { bf16_t* rowp = obase + (size_t)(ai * HALF + m * 16) * 128;
#pragma unroll
                    for (int bj = 0; bj < 2; ++bj) *(u32x4*)(rowp + bj * bjs) = pack8(acc[ai][bj][m][0] * sc, acc[ai][bj][m][1] * sc); }
        }
    }
};
template <class Epi, class Sched, bool ALIGN_EPI = false, bool SP2 = false>
__device__ __forceinline__ void gemm_phase(PG8_LAS unsigned char* lds, const Gemm g, const Sched& S, const Epi& E) {
    int tid_ = threadIdx.x; asm volatile("" : "+v"(tid_));
    const int tid = tid_, wid = __builtin_amdgcn_readfirstlane(tid >> 6), lane = tid & 63, wr = wid >> 2, wc = wid & 3, fr = lane & 15, fq = lane >> 4;
    const int K = g.K, nt = K / BK;
    unsigned voffA[2], voffB[2];
#pragma unroll
    for (int i = 0; i < 2; ++i) { int R, C; stage_rc(tid * 16 + i * 8192, R, C); const int Rb = Epi::PERM ? ((R & ~31) + perm32(R & 31)) : R;
        voffA[i] = (unsigned)(R * ((g.ablk & 1) ? 256 : K) + C) * 2u; voffB[i] = (unsigned)(Rb * ((g.ablk & 2) ? 256 : K) + C) * 2u; }
    const size_t kstep = (size_t)(BK * 2);
    const size_t hstep = (size_t)HALF * K * 2;
    const size_t tstep = 2 * hstep;
    const size_t hstepA = (g.ablk & 1) ? (size_t)HALF * 256 * 2 : hstep, hstepB = (g.ablk & 2) ? (size_t)HALF * 256 * 2 : hstep;
#define PG8_KOFF(t_) ((g.ablk & 1) ? (size_t)((t_) >> 2) * 131072 + (size_t)((t_) & 3) * 128 : (size_t)(t_) * kstep)
#define PG8_KOFFB(t_) ((g.ablk & 2) ? (size_t)((t_) >> 2) * 131072 + (size_t)((t_) & 3) * 128 : (size_t)(t_) * kstep)
    const unsigned ldsw = (unsigned)wid * 1024u;
    const int aoff = lds_byte(wr * 64 + fr, fq * 8), boff = lds_byte(wc * 32 + fr, fq * 8);
#define PG8_SA(b, h) (((b) * 2 + (h)) * HTB)
#define PG8_SB(b, h) ((4 + (b) * 2 + (h)) * HTB)
#define PG8_STAGE(bufoff, gbase, voff) do { _Pragma("unroll") for (int _i = 0; _i < 2; ++_i) \
        __builtin_amdgcn_global_load_lds((const unsigned*)((const char*)(gbase) + (voff)[_i]), (PG8_LAS unsigned*)(lds + (bufoff) + ldsw + _i * 8192), 16, 0, 0); } while (0)
#define PG8_LDA(dst, b, h) do { _Pragma("unroll") for (int m = 0; m < 4; ++m) _Pragma("unroll") for (int k = 0; k < 2; ++k) dst[m][k] = *(const PG8_LAS bf16x8*)(lds + PG8_SA(b, h) + aoff + m * 2048 + k * 1024); } while (0)
#define PG8_LDB(dst, b, h) do { _Pragma("unroll") for (int n = 0; n < 2; ++n) _Pragma("unroll") for (int k = 0; k < 2; ++k) dst[n][k] = *(const PG8_LAS bf16x8*)(lds + PG8_SB(b, h) + boff + n * 2048 + k * 1024); } while (0)
#define PG8_MMA(ai, bj, At, Bt) do { __builtin_amdgcn_s_setprio(1); _Pragma("unroll") for (int m = 0; m < 4; ++m) _Pragma("unroll") for (int n = 0; n < 2; ++n) _Pragma("unroll") for (int k = 0; k < 2; ++k) \
        acc[ai][bj][m][n] = __builtin_amdgcn_mfma_f32_16x16x32_bf16(Bt[n][k], At[m][k], acc[ai][bj][m][n], 0, 0, 0); __builtin_amdgcn_s_setprio(0); } while (0)
#define PG8_WAIT_V(n) asm volatile("s_waitcnt vmcnt(" #n ")" ::: "memory")
#define PG8_WAIT_L(n) asm volatile("s_waitcnt lgkmcnt(" #n ")" ::: "memory")
#define PG8_BAR __builtin_amdgcn_s_barrier()
#define PG8_SCHED __builtin_amdgcn_sched_barrier(0)
    Unit cur, nxt; int ui = 0;
    if (!S.next(0, cur)) return;
    f32x4 acc[2][2][4][2];
#pragma unroll
    for (int a = 0; a < 2; ++a)
#pragma unroll
        for (int b = 0; b < 2; ++b)
#pragma unroll
            for (int m = 0; m < 4; ++m)
#pragma unroll
                for (int n = 0; n < 2; ++n) acc[a][b][m][n] = (f32x4){0.f, 0.f, 0.f, 0.f};
    bf16x8 At[4][2], B0[2][2], B1[2][2];
    const char* cA = (const char*)g.A + (size_t)cur.pm * tstep; const char* cB = (const char*)g.Bt + (size_t)cur.pn * tstep;
    S.a_ready(cur);
    if constexpr (SP2) {
        PG8_STAGE(PG8_SB(0, 0), cB, voffB); PG8_STAGE(PG8_SB(0, 1), cB + hstepB, voffB); PG8_STAGE(PG8_SA(0, 0), cA, voffA); PG8_STAGE(PG8_SA(0, 1), cA + hstepA, voffA);
        if (wr == 1) PG8_BAR;
        PG8_WAIT_V(2); PG8_BAR;
        PG8_STAGE(PG8_SB(1, 0), cB + kstep, voffB); PG8_STAGE(PG8_SA(1, 0), cA + kstep, voffA); PG8_STAGE(PG8_SB(1, 1), cB + hstepB + kstep, voffB);
        PG8_WAIT_V(6); PG8_BAR;
    } else {
        PG8_STAGE(PG8_SB(0, 0), cB, voffB); PG8_STAGE(PG8_SA(0, 0), cA, voffA); PG8_STAGE(PG8_SB(0, 1), cB + hstepB, voffB); PG8_STAGE(PG8_SA(0, 1), cA + hstepA, voffA);
        if (wr == 1) PG8_BAR;
        PG8_WAIT_V(4); PG8_BAR;
        PG8_STAGE(PG8_SB(1, 0), cB + kstep, voffB); PG8_STAGE(PG8_SA(1, 0), cA + kstep, voffA); PG8_STAGE(PG8_SB(1, 1), cB + hstepB + kstep, voffB);
        PG8_WAIT_V(6); PG8_BAR;
    }
    for (;;) {
        const bool has_next = S.next(ui + 1, nxt);
        const char* nA = has_next ? (const char*)g.A + (size_t)nxt.pm * tstep : cA; const char* nB = has_next ? (const char*)g.Bt + (size_t)nxt.pn * tstep : cB;
        for (int t = 0; t < nt; t += 2) {
            const bool last = (t == nt - 2);
            const char* a1 = cA + PG8_KOFF(t) + kstep;
            const char* a2 = last ? nA : cA + PG8_KOFF(t + 2); const char* b2 = last ? nB : cB + PG8_KOFFB(t + 2);
            const char* a3 = a2 + kstep; const char* b3 = b2 + kstep;
            if (last && has_next) S.a_ready(nxt);
            if constexpr (SP2) {
            PG8_LDB(B0, 0, 0); PG8_LDB(B1, 0, 1); PG8_SCHED; PG8_LDA(At, 0, 0); PG8_STAGE(PG8_SA(1, 1), a1 + hstepA, voffA);
            PG8_WAIT_V(8); PG8_WAIT_L(0); PG8_BAR; PG8_MMA(0, 0, At, B0); PG8_MMA(0, 1, At, B1); PG8_BAR; PG8_SCHED;
            PG8_LDA(At, 0, 1); PG8_STAGE(PG8_SB(0, 0), b2, voffB); PG8_STAGE(PG8_SB(0, 1), b2 + hstepB, voffB); PG8_STAGE(PG8_SA(0, 0), a2, voffA);
            PG8_WAIT_V(8); PG8_WAIT_L(0); PG8_BAR; PG8_MMA(1, 0, At, B0); PG8_MMA(1, 1, At, B1); PG8_BAR; PG8_SCHED;
            PG8_LDB(B0, 1, 0); PG8_LDB(B1, 1, 1); PG8_SCHED; PG8_LDA(At, 1, 0); PG8_STAGE(PG8_SA(0, 1), a2 + hstepA, voffA);
            PG8_WAIT_V(8); PG8_WAIT_L(0); PG8_BAR; PG8_MMA(0, 0, At, B0); PG8_MMA(0, 1, At, B1); PG8_BAR; PG8_SCHED;
            PG8_LDA(At, 1, 1); PG8_STAGE(PG8_SB(1, 0), b3, voffB); PG8_STAGE(PG8_SB(1, 1), b3 + hstepB, voffB); PG8_STAGE(PG8_SA(1, 0), a3, voffA);
            PG8_WAIT_V(8); PG8_WAIT_L(0); PG8_BAR; PG8_MMA(1, 0, At, B0); PG8_MMA(1, 1, At, B1); PG8_BAR; PG8_SCHED;
            } else {
            PG8_LDB(B0, 0, 0); PG8_SCHED; PG8_LDA(At, 0, 0); PG8_STAGE(PG8_SA(1, 1), a1 + hstepA, voffA);
            PG8_WAIT_L(8); PG8_BAR; PG8_WAIT_L(0); PG8_MMA(0, 0, At, B0); PG8_BAR; PG8_SCHED;
            PG8_LDB(B1, 0, 1); PG8_STAGE(PG8_SB(0, 0), b2, voffB);
            PG8_BAR; PG8_WAIT_L(0); PG8_MMA(0, 1, At, B1); PG8_BAR;
            PG8_LDA(At, 0, 1); PG8_STAGE(PG8_SA(0, 0), a2, voffA);
            PG8_BAR; PG8_WAIT_L(0); PG8_MMA(1, 0, At, B0); PG8_BAR; PG8_SCHED;
            PG8_STAGE(PG8_SB(0, 1), b2 + hstepB, voffB);
            PG8_WAIT_V(6); PG8_BAR; PG8_MMA(1, 1, At, B1); PG8_BAR;
            PG8_LDB(B0, 1, 0); PG8_SCHED; PG8_LDA(At, 1, 0); PG8_STAGE(PG8_SA(0, 1), a2 + hstepA, voffA);
            PG8_WAIT_L(8); PG8_BAR; PG8_WAIT_L(0); PG8_MMA(0, 0, At, B0); PG8_BAR; PG8_SCHED;
            PG8_LDB(B1, 1, 1); PG8_STAGE(PG8_SB(1, 0), b3, voffB);
            PG8_BAR; PG8_WAIT_L(0); PG8_MMA(0, 1, At, B1); PG8_BAR;
            PG8_LDA(At, 1, 1); PG8_STAGE(PG8_SA(1, 0), a3, voffA);
            PG8_BAR; PG8_WAIT_L(0); PG8_MMA(1, 0, At, B0); PG8_BAR; PG8_SCHED;
            PG8_STAGE(PG8_SB(1, 1), b3 + hstepB, voffB);
            PG8_WAIT_V(6); PG8_BAR; PG8_MMA(1, 1, At, B1); PG8_BAR;
            }
        }
        if constexpr (ALIGN_EPI) { if (wr == 0) PG8_BAR; }
        if constexpr (!Epi::AFTER_DRAIN) { E(acc, cur, wr, wc, fr, fq); S.done(cur); }
        if (!has_next) break;
#pragma unroll
        for (int a = 0; a < 2; ++a)
#pragma unroll
            for (int b = 0; b < 2; ++b)
#pragma unroll
                for (int m = 0; m < 4; ++m)
#pragma unroll
                    for (int n = 0; n < 2; ++n) acc[a][b][m][n] = (f32x4){0.f, 0.f, 0.f, 0.f};
        cur = nxt; cA = nA; cB = nB; ++ui;
        if constexpr (ALIGN_EPI) { if (wr == 1) PG8_BAR; }
    }
    PG8_WAIT_V(0);
    if constexpr (!ALIGN_EPI) { if (wr == 0) PG8_BAR; }
    PG8_BAR;
    if constexpr (Epi::AFTER_DRAIN) { E.fused(acc, cur, wr, wc, fr, fq, lds, wid, lane); S.done(cur); }
#undef PG8_SA
#undef PG8_KOFF
#undef PG8_KOFFB
#undef PG8_SB
#undef PG8_STAGE
#undef PG8_LDA
#undef PG8_LDB
#undef PG8_MMA
#undef PG8_WAIT_V
#undef PG8_WAIT_L
#undef PG8_BAR
#undef PG8_SCHED
}
}
#ifndef PG8_SP2
#define PG8_SP2 true
#endif
#ifndef PG8_ALIGN
#define PG8_ALIGN true
#endif

constexpr int NWAVES = 8, NTHREADS = 512;
constexpr int MLPG = 4;
constexpr int NPHASE = 14 + 2 * MLPG;
#ifndef MK_N_LAUNCHES
#define MK_N_LAUNCHES 1
#endif
constexpr int N_LAUNCHES = MK_N_LAUNCHES;

constexpr int DM = 4096, NTOK = 32768, HTOK = 16384, INW = 11264, DFF = 16384, MEMW = 512, NMEM = 1536, HD = 128;
constexpr int RETW = 2048, QA_OFF = 8192, KA_OFF = 10240, VA_OFF = 10752;
constexpr float RMS_EPS = 1e-6f, LOG2E = 1.4426950408889634f;
constexpr int TBW = 264;

constexpr size_t MiB = 1u << 20;
constexpr size_t WS_CTL = 0, CTL_ZERO_BYTES = 1 * MiB;
constexpr size_t WS_COS = 1 * MiB, WS_SIN = 3 * MiB, WS_TB = 5 * MiB;
constexpr size_t WS_MEMN = 6 * MiB, WS_KVM = 18 * MiB;
constexpr size_t WS_WIN = 24 * MiB, WS_WOUT = 112 * MiB, WS_WCQ = 144 * MiB, WS_WCKV = 148 * MiB, WS_WCO = 156 * MiB, WS_W1 = 160 * MiB, WS_W2 = 288 * MiB;
constexpr size_t WS_XN = 416 * MiB;
constexpr size_t WS_R = 672 * MiB;
constexpr size_t WS_PROJ = WS_R, WS_Y = WS_R + 352 * MiB, WS_ST = WS_Y + 128 * MiB, WS_END = WS_ST + 128 * MiB;
constexpr size_t WS_QC = WS_R, WS_OC = WS_R + 32 * MiB;
constexpr size_t WS_HID = WS_R;
constexpr size_t WS_PROBE5 = WS_PROJ, WS_PROBE13 = WS_R + 64 * MiB, WS_PROBE15 = WS_WIN, WS_PROBE_SS = 896 * 1024;
static_assert(WS_HID + (size_t)HTOK * DFF * 2 <= WS_END && WS_END == 1280 * MiB, "d_ws map");
constexpr int CW_TMO = 0, CW_BAR = 4096;
constexpr int CW_BQ_HEAD = 8192, CW_ARR = 8192 + 64;
constexpr int BQ_I1 = (DM / 64) * (DFF / 32), BQ_I2 = (DFF / 64) * (DM / 32), BQ_ITEMS = BQ_I1 + BQ_I2;
constexpr size_t WS_SS = 512 * 1024;

constexpr int RING_OFF = 0, RING_BYTES = 131072;
constexpr int LDSCTL_OFF = RING_BYTES, MISC_OFF = LDSCTL_OFF + 320;
constexpr int TAB_OFF = LDSCTL_OFF + 1024;
constexpr int LDS_BYTES = 163840;
static_assert(TAB_OFF + 16 * TBW * 4 <= LDS_BYTES, "LDS map");

#define GAS __attribute__((address_space(1)))
#define LAS __attribute__((address_space(3)))
#define DI __device__ __forceinline__
typedef unsigned short bf16;
typedef unsigned v4u __attribute__((ext_vector_type(4)));
typedef unsigned v2u __attribute__((ext_vector_type(2)));
typedef float f32x4 __attribute__((ext_vector_type(4)));
typedef float f32x16 __attribute__((ext_vector_type(16)));
typedef short bf16x8 __attribute__((ext_vector_type(8)));
typedef short v4i16_t __attribute__((ext_vector_type(4)));
typedef GAS unsigned gu32;
#define RLX_AGENT __ATOMIC_RELAXED, __HIP_MEMORY_SCOPE_AGENT
#define LDS_WAIT() asm volatile("s_waitcnt lgkmcnt(0)" ::: "memory")
#define VM_WAIT() asm volatile("s_waitcnt vmcnt(0)" ::: "memory")
DI unsigned f2bf(float f) { unsigned u = __builtin_bit_cast(unsigned, f); return (u + 0x7fffu + ((u >> 16) & 1u)) >> 16; }
DI unsigned pk2(float lo, float hi) { return pg8::cvt_pk_bf16(lo, hi); }
DI float bflo(unsigned w) { return __uint_as_float(w << 16); }
DI float bfhi(unsigned w) { return __uint_as_float(w & 0xffff0000u); }
DI float ex2(float x) { return __builtin_amdgcn_exp2f(x); }
#define XB_TMO      128
#define XB_XCNT(j)  (256  + 64 * (j))
#define XB_XSUB(j)  (1280 + 64 * (j))
#define XB_XGEN(j)  (2304 + 64 * (j))
#define XB_TOP      3328
#define XB_TOPGEN   3392
#define XCD_BAR_WORDS 3456
#define XB_SPIN_CAP (1u << 18)

__device__ __forceinline__ unsigned xb_ld(unsigned* p)              { return __hip_atomic_load(p, __ATOMIC_RELAXED, __HIP_MEMORY_SCOPE_AGENT); }
__device__ __forceinline__ unsigned xb_add(unsigned* p, unsigned v) { return __hip_atomic_fetch_add(p, v, __ATOMIC_RELAXED, __HIP_MEMORY_SCOPE_AGENT); }
__device__ __forceinline__ unsigned xb_xcc_id() { return (unsigned)__builtin_amdgcn_s_getreg((3 << 11) | 20) & 0xFu; }
#define XB_SPIN(cond, bar) do { unsigned _sp = 0; while (cond) { __builtin_amdgcn_s_sleep(1); \
    if ((++_sp & 255u) == 0u) { if (xb_ld(&(bar)[XB_TMO])) break; if (_sp > XB_SPIN_CAP) { atomicAdd(&(bar)[XB_TMO], 1u); break; } } } } while (0)

struct XcdBarrier {
    unsigned* bar; unsigned x;
    volatile LAS unsigned* st;
};

__device__ __forceinline__ XcdBarrier xcd_barrier_post(unsigned* bar, volatile LAS unsigned* st) {
    XcdBarrier b; b.bar = bar; b.x = xb_xcc_id(); b.st = st;
    if (threadIdx.x == 0) (void)xb_add(&bar[XB_XCNT(b.x)], 1u);
    return b;
}
__device__ __forceinline__ void xcd_barrier_complete(unsigned* bar, unsigned x, unsigned& nloc, unsigned& nx) {
    const unsigned G = gridDim.x * gridDim.y * gridDim.z;
    unsigned sum, cnt, mine, sp = 0u;
    for (;;) {
        sum = 0u; cnt = 0u; mine = 0u;
#pragma unroll
        for (unsigned j = 0; j < 16; ++j) { const unsigned c = xb_ld(&bar[XB_XCNT(j)]); sum += c; cnt += (c > 0u) ? 1u : 0u; mine = (j == x) ? c : mine; }
        if (sum == G) break;
        __builtin_amdgcn_s_sleep(1);
        if ((++sp & 255u) == 0u) { if (xb_ld(&bar[XB_TMO])) break; if (sp > XB_SPIN_CAP) { atomicAdd(&bar[XB_TMO], 1u); break; } }
    }
    nloc = mine > 0u ? mine : 1u; nx = cnt > 0u ? cnt : 1u;
}

__device__ __forceinline__ void xcd_barrier(const XcdBarrier& b) {
    asm volatile("s_waitcnt vmcnt(0)" ::: "memory");
    __syncthreads();
    if (threadIdx.x == 0) {
        unsigned* bar = b.bar;
        __builtin_amdgcn_s_waitcnt(0);
        unsigned nloc = b.st[0], nx = b.st[1];
        if (nloc == 0u) { xcd_barrier_complete(bar, b.x, nloc, nx); b.st[0] = nloc; b.st[1] = nx; }
        const unsigned old = xb_add(&bar[XB_XSUB(b.x)], 1u);
        const unsigned gen = old / nloc;
        if (old + 1u == (gen + 1u) * nloc) {
            __builtin_amdgcn_fence(__ATOMIC_RELEASE, "agent");
            asm volatile("s_waitcnt vmcnt(0)" ::: "memory");
            const unsigned og = xb_add(&bar[XB_TOP], 1u);
            const unsigned tg = og / nx;
            if (og + 1u == (tg + 1u) * nx) xb_add(&bar[XB_TOPGEN], 1u);
            else XB_SPIN(xb_ld(&bar[XB_TOPGEN]) == tg, bar);
            __builtin_amdgcn_fence(__ATOMIC_ACQUIRE, "agent");
            xb_add(&bar[XB_XGEN(b.x)], 1u);
            asm volatile("s_waitcnt vmcnt(0)" ::: "memory");
        } else {
            XB_SPIN(xb_ld(&bar[XB_XGEN(b.x)]) == gen, bar);
            __builtin_amdgcn_fence(__ATOMIC_ACQUIRE, "agent");
            asm volatile("s_waitcnt vmcnt(0)" ::: "memory");
        }
    }
    __syncthreads();
}

DI float wave_sum(float v) {
#pragma unroll
    for (int o = 1; o < 64; o <<= 1) v += __shfl_xor(v, o);
    return v;
}
template <bool ROPEPERM, bool BLK = false>
DI void p0_transpose_item(const float* W, int K, int N, bf16* WT, LAS float* scr, int item, int lane, const float* gain = nullptr) {
    const int nblk = N / 32, kb = item / nblk, nb = item % nblk, k0 = 64 * kb, n0 = 32 * nb;
    int ncol = n0 + (lane & 31);
    if (ROPEPERM && ncol < 4096) { const int o = ncol & 127; ncol = (ncol & ~127) + (o >> 1) + 64 * (o & 1); }
    float wv[32];
#pragma unroll
    for (int i = 0; i < 32; ++i) { const int kk = 2 * i + (lane >> 5); wv[i] = W[(size_t)(k0 + kk) * N + ncol]; }
    if (gain) {
#pragma unroll
        for (int i = 0; i < 32; ++i) wv[i] *= gain[k0 + 2 * i + (lane >> 5)]; }
#pragma unroll
    for (int i = 0; i < 32; ++i) { const int kk = 2 * i + (lane >> 5); scr[kk * 33 + (lane & 31)] = wv[i]; }
    LDS_WAIT(); asm volatile("" ::: "memory");
    const int c = lane & 7;
#pragma unroll
    for (int j = 0; j < 4; ++j) { const int n = (lane >> 3) + 8 * j; const LAS float* s = scr + (8 * c) * 33 + n;
        v4u o; o.x = pk2(s[0 * 33], s[1 * 33]); o.y = pk2(s[2 * 33], s[3 * 33]); o.z = pk2(s[4 * 33], s[5 * 33]); o.w = pk2(s[6 * 33], s[7 * 33]);
        bf16* dst = BLK ? WT + (size_t)((n0 + n) >> 8) * 256 * K + (size_t)(k0 >> 8) * 65536 + (size_t)((n0 + n) & 255) * 256 + (k0 & 255) + 8 * c : WT + (size_t)(n0 + n) * K + k0 + 8 * c;
        *(GAS v4u*)dst = o; }
    LDS_WAIT(); asm volatile("" ::: "memory");
}
DI void rms_row_to_bf16(const float* xrow, const float* gain, bf16* orow, int lane) {
    const GAS f32x4* xr = (const GAS f32x4*)xrow + lane;
    f32x4 v[16]; float s = 0.f;
#pragma unroll
    for (int j = 0; j < 16; ++j) { v[j] = xr[64 * j]; s += (v[j].x * v[j].x + v[j].y * v[j].y) + (v[j].z * v[j].z + v[j].w * v[j].w); }
    const float rstd = 1.0f / sqrtf(wave_sum(s) * (1.f / DM) + RMS_EPS);
    const GAS f32x4* gr = (const GAS f32x4*)gain + lane;
    GAS v2u* o8 = (GAS v2u*)orow + lane;
#pragma unroll
    for (int j = 0; j < 16; ++j) { const f32x4 g = gr[64 * j]; v2u w; w.x = pk2(v[j].x * rstd * g.x, v[j].y * rstd * g.y); w.y = pk2(v[j].z * rstd * g.z, v[j].w * rstd * g.w); o8[64 * j] = w; }
}
DI void final_row(const bf16* xrow, float ssrow, const float* gain, float* orow, int lane, bool poison) {
    float rstd = __builtin_amdgcn_rsqf(ssrow * (1.f / DM) + RMS_EPS);
    if (poison) rstd = __builtin_nanf("");
    const GAS v2u* xr = (const GAS v2u*)xrow + lane; const GAS f32x4* gr = (const GAS f32x4*)gain + lane; GAS f32x4* o = (GAS f32x4*)orow + lane;
    v2u v[16];
#pragma unroll
    for (int j = 0; j < 16; ++j) v[j] = xr[64 * j];
#pragma unroll
    for (int j = 0; j < 16; ++j) { const f32x4 g0 = gr[64 * j];
        o[64 * j] = (f32x4){bflo(v[j].x) * rstd * g0.x, bfhi(v[j].x) * rstd * g0.y, bflo(v[j].y) * rstd * g0.z, bfhi(v[j].y) * rstd * g0.w}; }
}

#define MFMA32(a, b, c) __builtin_amdgcn_mfma_f32_32x32x16_bf16((a), (b), (c), 0, 0, 0)
DI int crow(int reg, int h) { return (reg & 3) + 8 * (reg >> 2) + 4 * h; }
DI unsigned off_b(unsigned row, unsigned ch) { return 256u * row + 16u * (ch ^ (((row & 3u) << 2) | ((row >> 2) & 3u))); }
DI bf16x8 row_frag(const LAS unsigned char* img, int rowbase, int lane, int ks) { return *(const LAS bf16x8*)(img + off_b(rowbase + (lane & 31), 2 * ks + (lane >> 5))); }
DI v4i16_t tr4(const LAS unsigned char* p) { return __builtin_amdgcn_ds_read_tr16_b64_v4i16((LAS v4i16_t*)p); }
DI bf16x8 tr_frag_nat(const LAS unsigned char* img, int rowbase, int lane, int c, int ks) {
    const unsigned h = lane >> 5, blk = (lane >> 4) & 1, q = (lane & 15) >> 2, p = lane & 3;
    const unsigned r0 = rowbase + 16 * ks + 8 * h + q, ch = 4 * c + 2 * blk + (p >> 1);
    const v4i16_t lo = tr4(img + off_b(r0, ch) + 8 * (p & 1)), hi = tr4(img + off_b(r0 + 4, ch) + 8 * (p & 1));
    return __builtin_shufflevector(lo, hi, 0, 1, 2, 3, 4, 5, 6, 7);
}
DI bf16x8 tr_frag_perm(const LAS unsigned char* img, int rowbase, int lane, int c, int s) {
    const unsigned h = lane >> 5, blk = (lane >> 4) & 1, q = (lane & 15) >> 2, p = lane & 3;
    const unsigned r0 = rowbase + 16 * s + 4 * h + q, ch = 4 * c + 2 * blk + (p >> 1);
    const v4i16_t lo = tr4(img + off_b(r0, ch) + 8 * (p & 1)), hi = tr4(img + off_b(r0 + 8, ch) + 8 * (p & 1));
    return __builtin_shufflevector(lo, hi, 0, 1, 2, 3, 4, 5, 6, 7);
}
template <int S> DI bf16x8 pack_step(const f32x16& x) {
    v4u p; p.x = pk2(x[8 * S], x[8 * S + 1]); p.y = pk2(x[8 * S + 2], x[8 * S + 3]); p.z = pk2(x[8 * S + 4], x[8 * S + 5]); p.w = pk2(x[8 * S + 6], x[8 * S + 7]);
    return __builtin_bit_cast(bf16x8, p);
}
DI void ret_scan(bf16* ST, int nseq, int nchunk, const float* dec_f, const float* dec_b, int gtid, int nthreads) {
    const int ntask = nseq * 32 * 2048;
    for (int task = gtid; task < ntask; task += nthreads) {
        const int chain = task >> 11, eo = (task & 2047) * 8, seq = chain >> 5, hh = (chain >> 1) & 15, dir = chain & 1;
        const float lg = -expf(dir ? dec_b[hh] : dec_f[hh]), cd = ex2(128.f * lg * LOG2E);
        float s[8];
#pragma unroll
        for (int e = 0; e < 8; ++e) s[e] = 0.f;
        const ptrdiff_t cstride = (ptrdiff_t)16 * 2 * 16384 * (dir ? -1 : 1);
        bf16* p = ST + ((size_t)((seq * nchunk + (dir ? nchunk - 1 : 0)) * 16 + hh) * 2 + dir) * 16384 + eo;
        for (int cc = 0; cc < nchunk; cc += 8) {
            v4u v[8];
#pragma unroll
            for (int u = 0; u < 8; ++u) v[u] = *(const GAS v4u*)(p + u * cstride);
#pragma unroll
            for (int u = 0; u < 8; ++u) {
                v4u o; o.x = pk2(s[0], s[1]); o.y = pk2(s[2], s[3]); o.z = pk2(s[4], s[5]); o.w = pk2(s[6], s[7]);
                *(GAS v4u*)(p + u * cstride) = o;
                s[0] = s[0] * cd + bflo(v[u].x); s[1] = s[1] * cd + bfhi(v[u].x); s[2] = s[2] * cd + bflo(v[u].y); s[3] = s[3] * cd + bfhi(v[u].y);
                s[4] = s[4] * cd + bflo(v[u].z); s[5] = s[5] * cd + bfhi(v[u].z); s[6] = s[6] * cd + bflo(v[u].w); s[7] = s[7] * cd + bfhi(v[u].w);
            }
            p += 8 * cstride;
        }
    }
}
#define PJ(base, cb, row) ((base) + ((size_t)(cb) * HTOK + (size_t)(row)) * HD)
DI void tile_load(v4u (&r)[4], const bf16* g, size_t pitch, int tid) {
#pragma unroll
    for (int i = 0; i < 4; ++i) { const int n = tid + 512 * i, row = n >> 4, ch = n & 15; r[i] = *(const GAS v4u*)(g + (size_t)row * pitch + ch * 8); }
}
DI void tile_write(LAS unsigned char* img, const v4u (&r)[4], int tid) {
#pragma unroll
    for (int i = 0; i < 4; ++i) { const int n = tid + 512 * i, row = n >> 4, ch = n & 15; *(LAS v4u*)(img + off_b(row, ch)) = r[i]; }
}
DI void tile_write_scaled(LAS unsigned char* img, const v4u (&r)[4], int tid, float a, float b) {
#pragma unroll
    for (int i = 0; i < 4; ++i) { const int n = tid + 512 * i, row = n >> 4, ch = n & 15; const v4u v = r[i]; const float sc = ex2(a + b * (float)row);
        v4u o; o.x = pk2(bflo(v.x) * sc, bfhi(v.x) * sc); o.y = pk2(bflo(v.y) * sc, bfhi(v.y) * sc); o.z = pk2(bflo(v.z) * sc, bfhi(v.z) * sc); o.w = pk2(bflo(v.w) * sc, bfhi(v.w) * sc);
        *(LAS v4u*)(img + off_b(row, ch)) = o; }
}

template <bool WIN, int g>
DI void attn_phase(LAS unsigned char* L, const bf16* QB, const bf16* KB, const bf16* VB, bf16* OB, const float* TB, const float* sink, int tid, const int u_begin, const int G, const int NU) {
    constexpr int nbs = g ? 64 : 32;
    constexpr size_t qpitch = WIN ? HD : MEMW, kvpitch = WIN ? HD : 2 * MEMW, opitch = WIN ? DM : MEMW;
    const int lane0 = tid & 63, wave = __builtin_amdgcn_readfirstlane(tid >> 6);
    LAS float* const tb = (LAS float*)(L + TAB_OFF);
    if (WIN) for (int e = tid; e < 16 * TBW; e += NTHREADS) tb[e] = TB[e];
    int u = u_begin; if (u >= NU) return;
    int lo, hi, dk;
#define ATT_RANGE(uu, lo_, hi_) do { if (WIN) { const int nb_ = ((uu) >> 3) % nbs; lo_ = nb_ == 0 ? 0 : -1; hi_ = nb_ == nbs - 1 ? 1 : 2; } else { lo_ = 0; hi_ = 2; } } while (0)
#define ATT_KROW(uu, dd) (WIN ? (size_t)((((uu) & 7) >> 1) * HTOK + ((uu) >> 3) * 128 + (dd) * 128) : (size_t)(((((uu) >> 2) * 256) < HTOK ? ((((uu) >> 2) * 256) >> 12) * 256 : 1024 + (((((uu) >> 2) * 256) - HTOK) >> 13) * 256) + (dd) * 128))
#define ATT_KCOL(uu) (WIN ? 0 : ((uu) & 3) * HD)
    ATT_RANGE(u, lo, hi); dk = lo;
    v4u rk[4], rv[4];
    tile_load(rk, KB + ATT_KROW(u, dk) * kvpitch + ATT_KCOL(u), kvpitch, tid); tile_load(rv, VB + ATT_KROW(u, dk) * kvpitch + ATT_KCOL(u), kvpitch, tid);
    tile_write(L, rk, tid); tile_write(L + 32768, rv, tid);
    int un = u, dkn = dk + 1, lon = lo, hin = hi;
    if (dkn == hin) { un = u + G; if (un < NU) { ATT_RANGE(un, lon, hin); dkn = lon; } }
    if (un < NU) { tile_load(rk, KB + ATT_KROW(un, dkn) * kvpitch + ATT_KCOL(un), kvpitch, tid); tile_load(rv, VB + ATT_KROW(un, dkn) * kvpitch + ATT_KCOL(un), kvpitch, tid); }
    bf16x8 qf[8]; f32x16 o[4]; float m = 0.f, l = 0.f;
    int b = 0;
    for (;;) {
        int lane = lane0; asm volatile("" : "+v"(lane));
        const int r = lane & 31, h = lane >> 5;
        __syncthreads();
        LAS unsigned char* const imgK = L + b * 65536; LAS unsigned char* const imgV = imgK + 32768;
        const int qrow = WIN ? (u >> 3) * 128 + 32 * (wave & 3) : (u >> 2) * 256 + 32 * wave;
        const int qcol = WIN ? 0 : (u & 3) * HD;
        if (dk == lo) {
            const bf16* qptr = WIN ? PJ(QB, 64 + 2 * (u & 7) + (wave >> 2), qrow) : QB + (size_t)qrow * qpitch + qcol;
#pragma unroll
            for (int ks = 0; ks < 8; ++ks) qf[ks] = *(const GAS bf16x8*)(qptr + (size_t)r * qpitch + 16 * ks + 8 * h);
#pragma unroll
            for (int c = 0; c < 4; ++c)
#pragma unroll
                for (int i = 0; i < 16; ++i) o[c][i] = 0.f;
            if (WIN) { m = sink[2 * (u & 7) + (wave >> 2)] * LOG2E; l = 1.0f; } else { m = -1e30f; l = 0.f; }
        }
        const LAS float* const tbh = tb + (2 * (u & 7) + (wave >> 2)) * TBW;
        const int iq = 32 * (wave & 3) + r;
#pragma unroll
        for (int kh = 0; kh < 2; ++kh) {
            f32x16 st[2];
#pragma unroll
            for (int kt = 0; kt < 2; ++kt) {
#pragma unroll
                for (int i = 0; i < 16; ++i) st[kt][i] = 0.f;
#pragma unroll
                for (int ks = 0; ks < 8; ++ks) st[kt] = MFMA32(row_frag(imgK, 64 * kh + 32 * kt, lane, ks), qf[ks], st[kt]);
            }
            if (WIN) {
                const int relb = 128 * dk - iq + 128 + 64 * kh;
#pragma unroll
                for (int kt = 0; kt < 2; ++kt)
#pragma unroll
                    for (int i = 0; i < 16; ++i) { const int idx = relb + 32 * kt + crow(i, h); const bool ok = (unsigned)idx <= 256u;
                        const float bias = tbh[ok ? idx : 0]; st[kt][i] = ok ? st[kt][i] + bias : -1e30f; }
            }
            float mx = st[0][0];
#pragma unroll
            for (int kt = 0; kt < 2; ++kt)
#pragma unroll
                for (int i = 0; i < 16; ++i) mx = fmaxf(mx, st[kt][i]);
            mx = fmaxf(mx, __shfl_xor(mx, 32));
            const float mnew = fmaxf(m, mx), alpha = ex2(m - mnew); m = mnew;
            float rs = 0.f;
#pragma unroll
            for (int kt = 0; kt < 2; ++kt)
#pragma unroll
                for (int i = 0; i < 16; ++i) { const float p = ex2(st[kt][i] - mnew); st[kt][i] = p; rs += p; }
            rs += __shfl_xor(rs, 32);
            l = l * alpha + rs;
#pragma unroll
            for (int c = 0; c < 4; ++c)
#pragma unroll
                for (int i = 0; i < 16; ++i) o[c][i] *= alpha;
#pragma unroll
            for (int kt = 0; kt < 2; ++kt) {
                const bf16x8 p0 = pack_step<0>(st[kt]), p1 = pack_step<1>(st[kt]);
#pragma unroll
                for (int c = 0; c < 4; ++c) { o[c] = MFMA32(tr_frag_perm(imgV, 64 * kh + 32 * kt, lane, c, 0), p0, o[c]); o[c] = MFMA32(tr_frag_perm(imgV, 64 * kh + 32 * kt, lane, c, 1), p1, o[c]); }
            }
        }
        if (dk == hi - 1) {
            const float inv = 1.0f / l;
            bf16* optr = OB + (size_t)qrow * opitch + (WIN ? RETW + (2 * (u & 7) + (wave >> 2)) * HD : (u & 3) * HD);
#pragma unroll
            for (int c = 0; c < 4; ++c)
#pragma unroll
                for (int g4 = 0; g4 < 4; ++g4) { v2u w; w.x = pk2(o[c][4 * g4] * inv, o[c][4 * g4 + 1] * inv); w.y = pk2(o[c][4 * g4 + 2] * inv, o[c][4 * g4 + 3] * inv);
                    *(GAS v2u*)(optr + (size_t)r * opitch + 32 * c + 8 * g4 + 4 * h) = w; }
        }
        if (un >= NU) break;
        tile_write(L + (b ^ 1) * 65536, rk, tid); tile_write(L + (b ^ 1) * 65536 + 32768, rv, tid);
        u = un; dk = dkn; lo = lon; hi = hin; b ^= 1;
        dkn = dk + 1;
        if (dkn == hin) { un = u + G; if (un < NU) { ATT_RANGE(un, lon, hin); dkn = lon; } }
        if (un < NU) { tile_load(rk, KB + ATT_KROW(un, dkn) * kvpitch + ATT_KCOL(un), kvpitch, tid); tile_load(rv, VB + ATT_KROW(un, dkn) * kvpitch + ATT_KCOL(un), kvpitch, tid); }
    }
#undef ATT_RANGE
#undef ATT_KROW
#undef ATT_KCOL
}

DI void ret_kv_phase(LAS unsigned char* L, const bf16* PROJ, bf16* ST, const float* dec_f, const float* dec_b, int tid, int G) {
    constexpr int NU = 2048;
    const int lane0 = tid & 63, w = __builtin_amdgcn_readfirstlane(tid >> 6);
    int u = blockIdx.x; if (u >= NU) return;
    v4u rk[4], rv[4];
    { tile_load(rk, PJ(PROJ, 16 + (u & 15), (u >> 4) * 128), HD, tid); tile_load(rv, PJ(PROJ, 32 + (u & 15), (u >> 4) * 128), HD, tid); }
    for (;;) {
        int lane = lane0; asm volatile("" : "+v"(lane)); const int r = lane & 31, h = lane >> 5;
        const int hh = u & 15, c = u >> 4;
        const float lf2 = -expf(dec_f[hh]) * LOG2E, lb2 = -expf(dec_b[hh]) * LOG2E;
        __syncthreads();
        tile_write(L, rv, tid);
        tile_write_scaled(L + 32768, rk, tid, 127.f * lf2, -lf2);
        tile_write_scaled(L + 65536, rk, tid, 0.f, lb2);
        __syncthreads();
        const int un = u + G;
        if (un < NU) { tile_load(rk, PJ(PROJ, 16 + (un & 15), (un >> 4) * 128), HD, tid); tile_load(rv, PJ(PROJ, 32 + (un & 15), (un >> 4) * 128), HD, tid); }
        const int dir = w & 1, ce = w >> 1;
        const LAS unsigned char* imgK = L + 32768 + dir * 32768;
        f32x16 acc[4];
#pragma unroll
        for (int cc = 0; cc < 4; ++cc)
#pragma unroll
            for (int i = 0; i < 16; ++i) acc[cc][i] = 0.f;
#pragma unroll
        for (int ks = 0; ks < 8; ++ks) { const bf16x8 bfr = tr_frag_nat(L, 0, lane, ce, ks);
#pragma unroll
            for (int cd = 0; cd < 4; ++cd) acc[cd] = MFMA32(tr_frag_nat(imgK, 0, lane, cd, ks), bfr, acc[cd]); }
        bf16* dst = ST + ((size_t)(c * 16 + hh) * 2 + dir) * 16384 + (size_t)(32 * ce + r) * 128 + 4 * h;
#pragma unroll
        for (int cd = 0; cd < 4; ++cd)
#pragma unroll
            for (int g4 = 0; g4 < 4; ++g4) { v2u x; x.x = pk2(acc[cd][4 * g4], acc[cd][4 * g4 + 1]); x.y = pk2(acc[cd][4 * g4 + 2], acc[cd][4 * g4 + 3]); *(GAS v2u*)(dst + 32 * cd + 8 * g4) = x; }
        if (un >= NU) break;
        u = un;
    }
}

DI void ret_out_phase(LAS unsigned char* L, const bf16* PROJ, bf16* Y, const bf16* ST, const float* dec_f, const float* dec_b, int tid, int G) {
    constexpr int NU = 2048;
    const int lane0 = tid & 63, w = __builtin_amdgcn_readfirstlane(tid >> 6);
    LAS float* const part = (LAS float*)(L + TAB_OFF);
    LAS unsigned char* const A0 = L; LAS unsigned char* const A1 = L + 32768; LAS unsigned char* const B0 = L + 65536; LAS unsigned char* const B1 = L + 98304;
    int u = blockIdx.x; if (u >= NU) return;
    v4u ra[4], rb[4];
#define RO_LOAD_A(uu) do { tile_load(ra, PJ(PROJ, 16 + ((uu) & 15), ((uu) >> 4) * 128), HD, tid); tile_load(rb, PJ(PROJ, 32 + ((uu) & 15), ((uu) >> 4) * 128), HD, tid); } while (0)
#define RO_LOAD_B(uu) do { const bf16* stp_ = ST + (size_t)(uu) * 2 * 16384; tile_load(ra, stp_, 128, tid); tile_load(rb, stp_ + 16384, 128, tid); } while (0)
    RO_LOAD_A(u);
    tile_write(A0, ra, tid); tile_write(A1, rb, tid);
    RO_LOAD_B(u);
    const int eh = w >> 2;
    f32x16 y[2]; v2u gv[8];
    int fin_u = -1;
#define RO_FINAL() do { const float tot_ = part[w * 32 + r] + part[(w ^ 4) * 32 + r]; const float rstd_ = __builtin_amdgcn_rsqf(tot_ * (1.f / 128.f) + RMS_EPS); \
        bf16* yg_ = Y + (size_t)((fin_u >> 4) * 128 + i) * DM + (fin_u & 15) * HD; \
        _Pragma("unroll") for (int c2 = 0; c2 < 2; ++c2) _Pragma("unroll") for (int g4 = 0; g4 < 4; ++g4) { const int e0 = 32 * (2 * eh + c2) + 8 * g4 + 4 * h; const v2u gq = gv[c2 * 4 + g4]; \
            v2u x; x.x = pk2(y[c2][4 * g4] * rstd_ * bflo(gq.x), y[c2][4 * g4 + 1] * rstd_ * bfhi(gq.x)); x.y = pk2(y[c2][4 * g4 + 2] * rstd_ * bflo(gq.y), y[c2][4 * g4 + 3] * rstd_ * bfhi(gq.y)); \
            *(GAS v2u*)(yg_ + e0) = x; } } while (0)
    for (;;) {
        const int un = u + G;
        int lane = lane0; asm volatile("" : "+v"(lane));
        const int r = lane & 31, h = lane >> 5, i = 32 * (w & 3) + r;
        __syncthreads();
        if (fin_u >= 0) RO_FINAL();
        const int hh = u & 15;
        const float lf2 = -expf(dec_f[hh]) * LOG2E, lb2 = -expf(dec_b[hh]) * LOG2E;
        bf16x8 qf[8];
        { const bf16* qg = PJ(PROJ, hh, (u >> 4) * 128 + i);
#pragma unroll
          for (int ks = 0; ks < 8; ++ks) qf[ks] = *(const GAS bf16x8*)(qg + 16 * ks + 8 * h); }
#pragma unroll
        for (int c2 = 0; c2 < 2; ++c2)
#pragma unroll
            for (int q = 0; q < 16; ++q) y[c2][q] = 0.f;
#pragma unroll
        for (int jt = 0; jt < 4; ++jt) {
            f32x16 st;
#pragma unroll
            for (int q = 0; q < 16; ++q) st[q] = 0.f;
#pragma unroll
            for (int ks = 0; ks < 8; ++ks) st = MFMA32(row_frag(A0, 32 * jt, lane, ks), qf[ks], st);
#pragma unroll
            for (int q = 0; q < 16; ++q) { const int d = i - (32 * jt + crow(q, h)); const float f = ex2((float)d * (d >= 0 ? lf2 : -lb2)); st[q] *= f; }
            const bf16x8 p0 = pack_step<0>(st), p1 = pack_step<1>(st);
#pragma unroll
            for (int c2 = 0; c2 < 2; ++c2) { y[c2] = MFMA32(tr_frag_perm(A1, 32 * jt, lane, 2 * eh + c2, 0), p0, y[c2]); y[c2] = MFMA32(tr_frag_perm(A1, 32 * jt, lane, 2 * eh + c2, 1), p1, y[c2]); }
        }
        tile_write(B0, ra, tid); tile_write(B1, rb, tid);
        if (un < NU) RO_LOAD_A(un);
        { const bf16* gg = PJ(PROJ, 48 + hh, (u >> 4) * 128 + i);
#pragma unroll
          for (int c2 = 0; c2 < 2; ++c2)
#pragma unroll
              for (int g4 = 0; g4 < 4; ++g4) gv[c2 * 4 + g4] = *(const GAS v2u*)(gg + 32 * (2 * eh + c2) + 8 * g4 + 4 * h); }
        __syncthreads();
        {
            const float xf = ex2((float)(i + 1) * lf2), xb = ex2((float)(128 - i) * lb2);
            f32x16 cc[2];
#pragma unroll
            for (int c2 = 0; c2 < 2; ++c2)
#pragma unroll
                for (int q = 0; q < 16; ++q) cc[c2][q] = 0.f;
#pragma unroll
            for (int ks = 0; ks < 8; ++ks)
#pragma unroll
                for (int c2 = 0; c2 < 2; ++c2) cc[c2] = MFMA32(row_frag(B0, 32 * (2 * eh + c2), lane, ks), qf[ks], cc[c2]);
#pragma unroll
            for (int c2 = 0; c2 < 2; ++c2)
#pragma unroll
                for (int q = 0; q < 16; ++q) { y[c2][q] += xf * cc[c2][q]; cc[c2][q] = 0.f; }
            __builtin_amdgcn_sched_barrier(0);
#pragma unroll
            for (int ks = 0; ks < 8; ++ks)
#pragma unroll
                for (int c2 = 0; c2 < 2; ++c2) cc[c2] = MFMA32(row_frag(B1, 32 * (2 * eh + c2), lane, ks), qf[ks], cc[c2]);
            float ss = 0.f;
#pragma unroll
            for (int c2 = 0; c2 < 2; ++c2)
#pragma unroll
                for (int q = 0; q < 16; ++q) { const float v = y[c2][q] + xb * cc[c2][q]; y[c2][q] = v; ss += v * v; }
            ss += __shfl_xor(ss, 32);
            if (h == 0) part[w * 32 + r] = ss;
            fin_u = u;
        }
        if (un >= NU) break;
        tile_write(A0, ra, tid); tile_write(A1, rb, tid);
        RO_LOAD_B(un);
        u = un;
    }
    { const int lane = lane0, r = lane & 31, h = lane >> 5, i = 32 * (w & 3) + r; __syncthreads(); RO_FINAL(); }
#undef RO_LOAD_A
#undef RO_LOAD_B
#undef RO_FINAL
}
struct Args { const float* in[20]; float* out; unsigned char* ws; int ph_lo, ph_hi, li, pad; };
DI int t5_bucket(int rel) {
    const int n = rel < 0 ? -rel : rel;
    const int b = n < 8 ? n : n < 12 ? 8 : n < 16 ? 9 : n < 23 ? 10 : n < 32 ? 11 : n < 46 ? 12 : n < 64 ? 13 : n < 91 ? 14 : 15;
    return b + (rel > 0 ? 16 : 0);
}

#define PH_BEGIN() int tid = threadIdx.x; asm volatile("" : "+v"(tid)); GAS unsigned char* wsg_ = (GAS unsigned char*)args.ws; asm volatile("" : "+s"(wsg_)); unsigned char* ws = (unsigned char*)wsg_;   \
    LAS unsigned char* const L = (LAS unsigned char*)lds; const int lane = tid & 63, wave = __builtin_amdgcn_readfirstlane(tid >> 6), G = gridDim.x; \
    const int vcu = (G % 8 == 0) ? ((int)blockIdx.x % 8) * (G / 8) + (int)blockIdx.x / 8 : (int)blockIdx.x; (void)lane; (void)wave; (void)vcu; (void)L
#ifndef PROBE_BARMASK
#define PROBE_BARMASK 0x3ffff
#endif
#define GRID_BAR(id) do { if (N_LAUNCHES == 1) { GAS unsigned* bpg_ = (GAS unsigned*)(args.ws + WS_CTL) + CW_BAR; asm volatile("" : "+s"(bpg_)); unsigned* bp_ = (unsigned*)bpg_; XcdBarrier b_; b_.bar = bp_; b_.x = xb_xcc_id(); \
    b_.st = (volatile LAS unsigned*)((LAS unsigned char*)lds + MISC_OFF) + 8; unsigned long long t0_ = 0; if (PROBE_KIND == 1 && (((PROBE_BARMASK) >> (id)) & 1) && threadIdx.x == 0) t0_ = __builtin_amdgcn_s_memrealtime(); xcd_barrier(b_); if (NREP(19) > 1) xcd_barrier(b_); if (PROBE_KIND == 1 && (((PROBE_BARMASK) >> (id)) & 1) && threadIdx.x == 0) atomicAdd((unsigned long long*)(args.ws + WS_TS), (unsigned long long)(__builtin_amdgcn_s_memrealtime() - t0_)); } } while (0)
#ifndef REPMASK
#define REPMASK 0
#endif
#ifndef PROBE_KIND
#define PROBE_KIND 0
#endif
#ifndef PROBE_K
#define PROBE_K 4
#endif
#ifndef PROBE_PHMASK
#define PROBE_PHMASK 0
#endif
#define WS_TS (960 * 1024)
#define NREP(k) ((((REPMASK) >> (k)) & 1) ? 2 : 1)
#ifndef PHMASK
#define PHMASK 0x3ffffff
#endif
#define IN(k) ((((PHMASK) >> (k)) & 1) && lo <= (k) && (k) < hi)
#define SPAN_T0(k) unsigned long long sp0_ = 0; if (PROBE_KIND == 2 && (((PROBE_PHMASK) >> (k)) & 1) && blockIdx.x == 0 && threadIdx.x == 0) sp0_ = __builtin_amdgcn_s_memrealtime()
#define SPAN_T1(k) do { if (PROBE_KIND == 2 && (((PROBE_PHMASK) >> (k)) & 1) && blockIdx.x == 0 && threadIdx.x == 0) atomicAdd((unsigned long long*)(args.ws + WS_TS) + 1, (unsigned long long)(__builtin_amdgcn_s_memrealtime() - sp0_)); } while (0)
#define BOTH(k) (IN(k) && IN((k) + 1))
constexpr int BQ_LAG = 1;
DI void bq_run(const Args& args, unsigned char* lds, const int phase, const bool drain) {
    int tid = threadIdx.x; asm volatile("" : "+v"(tid)); GAS unsigned char* wsg_ = (GAS unsigned char*)args.ws; asm volatile("" : "+s"(wsg_)); unsigned char* ws = (unsigned char*)wsg_;
    LAS unsigned char* const L = (LAS unsigned char*)lds; const int lane = tid & 63, wave = __builtin_amdgcn_readfirstlane(tid >> 6), G = gridDim.x;
    gu32* const head = (gu32*)(ws + WS_CTL) + CW_BQ_HEAD; gu32* const arr = (gu32*)(ws + WS_CTL) + CW_ARR + 64 * phase;
    volatile LAS unsigned* const word = (volatile LAS unsigned*)(L + MISC_OFF) + 16;
    LAS float* const scr = (LAS float*)(L + RING_OFF + wave * 16384);
    if (tid == 0) (void)__hip_atomic_fetch_add(arr, 1u, RLX_AGENT);
    for (;;) {
        __syncthreads();
        if (tid == 0) { unsigned h = BQ_ITEMS;
            if ((drain || __hip_atomic_load(arr, RLX_AGENT) + BQ_LAG < (unsigned)G) && __hip_atomic_load(head, RLX_AGENT) < (unsigned)BQ_ITEMS) h = __hip_atomic_fetch_add(head, 8u, RLX_AGENT);
            *word = h; }
        __syncthreads();
        const int it = (int)*word + wave;
        if (it >= BQ_ITEMS) { if ((int)*word >= BQ_ITEMS) break; else continue; }
        if (it < BQ_I1) p0_transpose_item<false, true>(args.in[17], DM, DFF, (bf16*)(ws + WS_W1), scr, it, lane, args.in[16]);
        else p0_transpose_item<false, true>(args.in[18], DFF, DM, (bf16*)(ws + WS_W2), scr, it - BQ_I1, lane);
    }
}

template <int g> DI void mixer_half(const Args& args, unsigned char* lds, const int lo, const int hi) {
        const int pb = 1 + 5 * g;
        const int nbs = g ? 64 : 32, nseq = g ? 2 : 4;
        if (IN(pb)) {
            PH_BEGIN();
            pg8::Gemm gm{(const bf16*)(ws + WS_XN) + (size_t)g * HTOK * DM, (const bf16*)(ws + WS_WIN), HTOK, INW, DM, 0}; pg8::StaticOrder S; S.init(HTOK, INW, G, (int)blockIdx.x);
            pg8::EpiProj E{(bf16*)(ws + WS_PROJ), HTOK, (const float*)(ws + WS_COS), (const float*)(ws + WS_SIN), g ? 8191 : 4095};
            _Pragma("unroll 1") for (int rep = 0; rep < NREP(1); ++rep) pg8::gemm_phase<pg8::EpiProj, pg8::StaticOrder, PG8_ALIGN, PG8_SP2>(L + RING_OFF, gm, S, E);
            bq_run(args, lds, pb, false);
            if (BOTH(pb)) GRID_BAR(pb);
        }
        if (IN(pb + 1)) {
            SPAN_T0(pb + 1);
          _Pragma("unroll 1") for (int rep = 0; rep < NREP(2); ++rep) {
            PH_BEGIN();
            bf16* const PROJ = (bf16*)(ws + WS_PROJ);
            const bool flip = (((int)blockIdx.x >> 3) & 1) != 0;
            if (!flip) {
                ret_kv_phase(L, PROJ, (bf16*)(ws + WS_ST), args.in[6], args.in[7], tid, G);
                __syncthreads();
                attn_phase<true, g>(L, PROJ, PJ(PROJ, 80, 0), PJ(PROJ, 84, 0), (bf16*)(ws + WS_Y), (const float*)(ws + WS_TB), args.in[8], tid, (int)blockIdx.x, G, 1024);
            } else {
                attn_phase<true, g>(L, PROJ, PJ(PROJ, 80, 0), PJ(PROJ, 84, 0), (bf16*)(ws + WS_Y), (const float*)(ws + WS_TB), args.in[8], tid, (int)blockIdx.x, G, 1024);
                __syncthreads();
                int tid2 = threadIdx.x; asm volatile("" : "+v"(tid2));
                ret_kv_phase(L, PROJ, (bf16*)(ws + WS_ST), args.in[6], args.in[7], tid2, G);
            }
          }
            bq_run(args, lds, pb + 1, false);
            if (BOTH(pb + 1)) GRID_BAR(pb + 1);
            SPAN_T1(pb + 1);
        }
        if (IN(pb + 2)) {
            SPAN_T0(pb + 2);
            PH_BEGIN();
            if (g == 0) {
                if ((int)blockIdx.x >= G - 24) {
                    pg8::Gemm gm{(const bf16*)(ws + WS_MEMN), (const bf16*)(ws + WS_WCKV), NMEM, 2 * MEMW, DM, 0}; pg8::StaticOrder S; S.init(NMEM, 2 * MEMW, 24, (int)blockIdx.x - (G - 24));
                    pg8::EpiBf16S<0, false> E{(bf16*)(ws + WS_KVM), 2 * MEMW, 1.0f, nullptr};
                    pg8::gemm_phase<pg8::EpiBf16S<0, false>, pg8::StaticOrder, PG8_ALIGN, PG8_SP2>(L + RING_OFF, gm, S, E);
                } else ret_scan((bf16*)(ws + WS_ST), nseq, nbs, args.in[6], args.in[7], blockIdx.x * NTHREADS + tid, (G - 24) * NTHREADS);
            } else ret_scan((bf16*)(ws + WS_ST), nseq, nbs, args.in[6], args.in[7], blockIdx.x * NTHREADS + tid, G * NTHREADS);
            bq_run(args, lds, pb + 2, false);
            if (BOTH(pb + 2)) GRID_BAR(pb + 2);
            SPAN_T1(pb + 2);
        }
        if (IN(pb + 3)) {
            SPAN_T0(pb + 3);
          _Pragma("unroll 1") for (int rep = 0; rep < NREP(4); ++rep) {
            PH_BEGIN();
            ret_out_phase(L, (const bf16*)(ws + WS_PROJ), (bf16*)(ws + WS_Y), (const bf16*)(ws + WS_ST), args.in[6], args.in[7], tid, G);
          }
            bq_run(args, lds, pb + 3, false);
            if (BOTH(pb + 3)) GRID_BAR(pb + 3);
            SPAN_T1(pb + 3);
        }
        if (IN(pb + 4)) {
            PH_BEGIN();
            pg8::Gemm gm{(const bf16*)(ws + WS_Y), (const bf16*)(ws + WS_WOUT), HTOK, DM, DM, 0}; pg8::StaticOrder S; S.init(HTOK, DM, G, (int)blockIdx.x);
            if (NREP(5) > 1) { pg8::EpiResB<true> E2{args.in[g], nullptr, (bf16*)(ws + WS_PROBE5), DM, (float*)(ws + WS_PROBE_SS)}; pg8::gemm_phase<pg8::EpiResB<true>, pg8::StaticOrder, PG8_ALIGN, PG8_SP2>(L + RING_OFF, gm, S, E2); }
            pg8::EpiResB<true> E{args.in[g], nullptr, (bf16*)(ws + WS_XN) + (size_t)g * HTOK * DM, DM, (float*)(ws + WS_SS) + g * HTOK};
            pg8::gemm_phase<pg8::EpiResB<true>, pg8::StaticOrder, PG8_ALIGN, PG8_SP2>(L + RING_OFF, gm, S, E);
            if (g == 1) bq_run(args, lds, pb + 4, false);
            if (g == 1 && BOTH(pb + 4)) GRID_BAR(pb + 4);
        }
}

__global__ void __launch_bounds__(NTHREADS, 2) hymba_fwd(Args args) {
    extern __shared__ __attribute__((aligned(16))) unsigned char lds[];
    {
        const int t0 = threadIdx.x;
        for (int u = t0; u < (LDS_BYTES - LDSCTL_OFF) / 4; u += NTHREADS) ((LAS unsigned*)((LAS unsigned char*)lds + LDSCTL_OFF))[u] = 0u;
        __syncthreads();
        if (N_LAUNCHES == 1) (void)xcd_barrier_post((unsigned*)(args.ws + WS_CTL) + CW_BAR, (volatile LAS unsigned*)((LAS unsigned char*)lds + MISC_OFF) + 8);
    }
    const int lo = args.ph_lo, hi = args.ph_hi;

    if (IN(0)) {
        SPAN_T0(0);
      _Pragma("unroll 1") for (int rep = 0; rep < NREP(0); ++rep) {
        PH_BEGIN();
        const int gw = vcu * NWAVES + wave, NGW = G * NWAVES, gtid = blockIdx.x * NTHREADS + tid, NT = G * NTHREADS;
        LAS float* scr = (LAS float*)(L + RING_OFF + wave * 16384);
        constexpr int I_IN = (DM / 64) * (INW / 32), I_OUT = (DM / 64) * (DM / 32), I_CQ = (DM / 64) * (MEMW / 32), I_CKV = (DM / 64) * (2 * MEMW / 32), I_CO = (MEMW / 64) * (DM / 32);
        constexpr int NITEMS = I_IN + I_OUT + I_CQ + I_CKV + I_CO;
        for (int it = gw; it < NITEMS; it += NGW) {
            int r = it;
            if (r < I_IN) { p0_transpose_item<true>(args.in[5], DM, INW, (bf16*)(ws + WS_WIN), scr, r, lane); continue; } r -= I_IN;
            if (r < I_OUT) { p0_transpose_item<false>(args.in[10], DM, DM, (bf16*)(ws + WS_WOUT), scr, r, lane); continue; } r -= I_OUT;
            if (r < I_CQ) { p0_transpose_item<false>(args.in[13], DM, MEMW, (bf16*)(ws + WS_WCQ), scr, r, lane, args.in[11]); continue; } r -= I_CQ;
            if (r < I_CKV) { p0_transpose_item<false>(args.in[14], DM, 2 * MEMW, (bf16*)(ws + WS_WCKV), scr, r, lane); continue; } r -= I_CKV;
            p0_transpose_item<false>(args.in[15], MEMW, DM, (bf16*)(ws + WS_WCO), scr, r, lane);
        }
        float* const COS = (float*)(ws + WS_COS); float* const SIN = (float*)(ws + WS_SIN); float* const TB = (float*)(ws + WS_TB);
        for (int e = gtid; e < 8192 * 64; e += NT) { const int pos = e >> 6, i = e & 63;
            const float inv = exp2f(-(float)i * (13.287712379549449f / 64.0f));
            const float ang = (float)pos * inv;
            double rev = (double)ang * 0.15915494309189535; rev -= floor(rev);
            const float rf = (float)rev;
            COS[e] = __builtin_amdgcn_cosf(rf); SIN[e] = __builtin_amdgcn_sinf(rf); }
        for (int e = gtid; e < 16 * TBW; e += NT) { const int hh = e / TBW, idx = e % TBW; const int rel = idx - 128;
            TB[e] = (idx <= 256) ? args.in[9][t5_bucket(rel) * 16 + hh] * LOG2E : 0.f; }
        bf16* const XN = (bf16*)(ws + WS_XN);
        for (int m = gw; m < NTOK; m += NGW) { const float* src = (m < HTOK) ? args.in[0] + (size_t)m * DM : args.in[1] + (size_t)(m - HTOK) * DM; rms_row_to_bf16(src, args.in[4], XN + (size_t)m * DM, lane); }
        for (int m = gw; m < NMEM; m += NGW) { const float* src = (m < 1024) ? args.in[2] + (size_t)m * DM : args.in[3] + (size_t)(m - 1024) * DM; rms_row_to_bf16(src, args.in[12], (bf16*)(ws + WS_MEMN) + (size_t)m * DM, lane); }
      }
        if (BOTH(0)) GRID_BAR(0);
        SPAN_T1(0);
    }

    mixer_half<0>(args, lds, lo, hi);
    mixer_half<1>(args, lds, lo, hi);

    if (IN(11)) {
        SPAN_T0(11);
        PH_BEGIN();
        pg8::Gemm gm{(const bf16*)(ws + WS_XN), (const bf16*)(ws + WS_WCQ), NTOK, MEMW, DM, 0}; pg8::StaticOrder S; S.init(NTOK, MEMW, G, (int)blockIdx.x);
        pg8::EpiBf16S<0, true> E{(bf16*)(ws + WS_QC), MEMW, 0.12751743074602224f, (const float*)(ws + WS_SS)};
        _Pragma("unroll 1") for (int rep = 0; rep < NREP(11); ++rep) pg8::gemm_phase<pg8::EpiBf16S<0, true>, pg8::StaticOrder, PG8_ALIGN, PG8_SP2>(L + RING_OFF, gm, S, E);
        __builtin_amdgcn_fence(__ATOMIC_ACQUIRE, "agent"); asm volatile("s_waitcnt vmcnt(0)" ::: "memory"); __syncthreads();
        const bf16* KVM = (const bf16*)(ws + WS_KVM);
        int tid2 = threadIdx.x; asm volatile("" : "+v"(tid2));
        pg8::Unit uu;
        _Pragma("unroll 1") for (int i = 0; S.next(i, uu); ++i) { const int ua = 4 * uu.pm + 2 * uu.pn;
            attn_phase<false, 0>(L, (const bf16*)(ws + WS_QC), KVM, KVM + MEMW, (bf16*)(ws + WS_OC), nullptr, nullptr, tid2, ua, 1, ua + 2); __syncthreads(); }
        bq_run(args, lds, 11, false);
        if (BOTH(11)) GRID_BAR(11);
        SPAN_T1(11);
    }
    if (IN(12)) {
        PH_BEGIN();
        pg8::Gemm gm{(const bf16*)(ws + WS_OC), (const bf16*)(ws + WS_WCO), NTOK, DM, MEMW, 0}; pg8::StaticOrder S; S.init(NTOK, DM, G, (int)blockIdx.x);
        if (NREP(12) > 1) { pg8::EpiResB<false> E2{nullptr, (const bf16*)(ws + WS_XN), (bf16*)(ws + WS_PROBE13), DM, (float*)(ws + WS_PROBE_SS)}; pg8::gemm_phase<pg8::EpiResB<false>, pg8::StaticOrder, PG8_ALIGN, PG8_SP2>(L + RING_OFF, gm, S, E2); }
        pg8::EpiResB<false> E{nullptr, (const bf16*)(ws + WS_XN), (bf16*)(ws + WS_XN), DM, (float*)(ws + WS_SS) + NTOK};
        pg8::gemm_phase<pg8::EpiResB<false>, pg8::StaticOrder, PG8_ALIGN, PG8_SP2>(L + RING_OFF, gm, S, E);
        bq_run(args, lds, 12, true);
        if (BOTH(12)) GRID_BAR(12);
    }
    constexpr int MTOK = NTOK / MLPG;
#pragma unroll
    for (int g = 0; g < MLPG; ++g) {
        if (IN(13 + 2 * g)) {
            PH_BEGIN();
            pg8::Gemm gm{(const bf16*)(ws + WS_XN) + (size_t)g * MTOK * DM, (const bf16*)(ws + WS_W1), MTOK, DFF, DM, 2}; pg8::StaticOrder S; S.init(MTOK, DFF, G, (int)blockIdx.x);
            pg8::EpiBf16S<1, true> E{(bf16*)(ws + WS_HID) + (size_t)(g & 1) * MTOK * DFF, DFF, 1.0f, (const float*)(ws + WS_SS) + NTOK + g * MTOK};
            _Pragma("unroll 1") for (int rep = 0; rep < NREP(13); ++rep) pg8::gemm_phase<pg8::EpiBf16S<1, true>, pg8::StaticOrder, PG8_ALIGN, PG8_SP2>(L + RING_OFF, gm, S, E);
            if (BOTH(13 + 2 * g)) GRID_BAR(13 + 2 * g);
        }
        if (IN(14 + 2 * g)) {
            PH_BEGIN();
            pg8::Gemm gm{(const bf16*)(ws + WS_HID) + (size_t)(g & 1) * MTOK * DFF, (const bf16*)(ws + WS_W2), MTOK, DM, DFF, 3}; pg8::StaticOrder S; S.init(MTOK, DM, G, (int)blockIdx.x, 1);
            if (NREP(14) > 1) { pg8::EpiResB<false> E2{nullptr, (const bf16*)(ws + WS_XN) + (size_t)g * MTOK * DM, (bf16*)(ws + WS_PROBE15), DM, (float*)(ws + WS_PROBE_SS)}; pg8::gemm_phase<pg8::EpiResB<false>, pg8::StaticOrder, PG8_ALIGN, PG8_SP2>(L + RING_OFF, gm, S, E2); }
            pg8::EpiResB<false> E{nullptr, (const bf16*)(ws + WS_XN) + (size_t)g * MTOK * DM, (bf16*)(ws + WS_XN) + (size_t)g * MTOK * DM, DM, (float*)(ws + WS_SS) + 2 * NTOK + g * MTOK};
            pg8::gemm_phase<pg8::EpiResB<false>, pg8::StaticOrder, PG8_ALIGN, PG8_SP2>(L + RING_OFF, gm, S, E);
            if (BOTH(14 + 2 * g) && (N_LAUNCHES != 1 || g == MLPG - 1)) GRID_BAR(14 + 2 * g);
        }
    }
    SPAN_T0(13 + 2 * MLPG);
    if (IN(13 + 2 * MLPG)) {
        PH_BEGIN();
        const bool poison = (N_LAUNCHES == 1) && (__hip_atomic_load((gu32*)((unsigned*)(ws + WS_CTL) + CW_BAR + XB_TMO), RLX_AGENT) != 0u);
        const int gw = vcu * NWAVES + wave, NGW = G * NWAVES; float* const o = args.out; const bf16* const X = (const bf16*)(ws + WS_XN); const float* const ss3 = (const float*)(ws + WS_SS) + 2 * NTOK;
        _Pragma("unroll 1") for (int rep = 0; rep < NREP(13 + 2 * MLPG); ++rep) for (int m = gw; m < NTOK; m += NGW) final_row(X + (size_t)m * DM, ss3[m], args.in[19], o + (size_t)m * DM, lane, poison);
    }
    if (PROBE_KIND != 0 && N_LAUNCHES == 1) {
        SPAN_T1(13 + 2 * MLPG);
        __syncthreads();
        if (blockIdx.x == 0 && threadIdx.x == 0) {
            const unsigned long long* ts = (const unsigned long long*)(args.ws + WS_TS);
            unsigned long long q = (PROBE_KIND == 1) ? __hip_atomic_load(ts, RLX_AGENT) / gridDim.x : __hip_atomic_load(ts + 1, RLX_AGENT);
            const unsigned long long t0 = __builtin_amdgcn_s_memrealtime(), want = q * PROBE_K;
            while (__builtin_amdgcn_s_memrealtime() - t0 < want) __builtin_amdgcn_s_sleep(8);
        }
        __syncthreads();
    }
#undef IN
#undef BOTH
}

extern "C" void kernel_launch(void* const* d_in, const int* in_sizes, int n_in, void* d_out, int out_size, void* d_ws, size_t ws_size, hipStream_t stream) {
    static int grid = 0;
    if (grid == 0) {
        if (n_in != 20 || out_size != NTOK * DM || ws_size < WS_END) { fprintf(stderr, "kernel_launch: shape/workspace mismatch (n_in %d, out %d, ws %zu, need %zu); nothing launched\n", n_in, out_size, ws_size, (size_t)WS_END); grid = -1; return; }
        int dev = 0, cus = 0, per_cu = 0;
        if (hipGetDevice(&dev) != hipSuccess || hipDeviceGetAttribute(&cus, hipDeviceAttributeMultiprocessorCount, dev) != hipSuccess) { grid = -1; return; }
        if (hipFuncSetAttribute((const void*)hymba_fwd, hipFuncAttributeMaxDynamicSharedMemorySize, LDS_BYTES) != hipSuccess) { fprintf(stderr, "kernel_launch: hipFuncSetAttribute failed\n"); grid = -1; return; }
        if (hipOccupancyMaxActiveBlocksPerMultiprocessor(&per_cu, (const void*)hymba_fwd, NTHREADS, LDS_BYTES) != hipSuccess || per_cu < 1)
            fprintf(stderr, "kernel_launch: note: occupancy query reports %d workgroups per CU\n", per_cu);
        (void)hipGetLastError();
        grid = cus;
    }
    if (grid < 0) return;
    if (hipMemsetAsync((char*)d_ws + WS_CTL, 0, CTL_ZERO_BYTES, stream) != hipSuccess) return;
    Args a{};
    for (int i = 0; i < 20; ++i) a.in[i] = (const float*)d_in[i];
    a.out = (float*)d_out; a.ws = (unsigned char*)d_ws; a.pad = 0;
    for (int li = 0; li < N_LAUNCHES; ++li) {
        a.ph_lo = (N_LAUNCHES == 1) ? 0 : li; a.ph_hi = (N_LAUNCHES == 1) ? NPHASE : li + 1; a.li = li;
        hipLaunchKernelGGL(hymba_fwd, dim3(grid), dim3(NTHREADS), LDS_BYTES, stream, a);
        const hipError_t le = hipPeekAtLastError();
        if (le != hipSuccess) { fprintf(stderr, "kernel_launch: launch %d failed: %s\n", li, hipGetErrorName(le)); break; }
    }
}
```

```cpp
#include <hip/hip_runtime.h>
#include <cstdio>
#include <cstdint>
namespace pg8 {
#define PG8_LAS __attribute__((address_space(3)))
typedef unsigned short bf16_t;
typedef short bf16x8 __attribute__((ext_vector_type(8)));
typedef float f32x4 __attribute__((ext_vector_type(4)));
typedef unsigned u32x4 __attribute__((ext_vector_type(4)));
constexpr int BM = 256, BK = 64, HALF = 128, HTB = HALF * BK * 2  , STAGE_BYTES = 8 * HTB, NXCD = 8, WGM = 8;

__host__ __device__ __forceinline__ int lds_byte(int r, int c) { const int st = (r >> 4) * 2 + (c >> 5), rr = r & 15, cc = c & 31, ob = rr * 64 + cc * 2; return st * 1024 + (ob ^ (((ob >> 9) & 1) << 5)); }
__host__ __device__ __forceinline__ void stage_rc(int b, int& R, int& C) { const int st = b / 1024, sb = b % 1024, swz = sb ^ (((sb >> 9) & 1) << 5); R = (st >> 1) * 16 + swz / 64; C = (st & 1) * 32 + (swz % 64) / 2; }
__host__ __device__ __forceinline__ int perm32(int rho) { const int n = rho >> 4, i = rho & 15; return 8 * (i >> 2) + 4 * n + (i & 3); }

struct Unit { int pm, pn; };
struct Gemm { const bf16_t* A; const bf16_t* Bt; int M, N, K; int ablk; };

struct StaticOrder {
    int nM, nN, nwg, G, c, rm;
    __host__ __device__ __forceinline__ void init(int M, int N, int G_, int c_, int rm_ = 0) { nM = M / BM; nN = N / BM; nwg = nM * nN; G = G_; c = c_; rm = (rm_ && G_ % NXCD == 0 && nwg % G_ == 0) ? 1 : 0; }
    __host__ __device__ __forceinline__ bool next(int i, Unit& u) const {
        const long L = (long)i * G + c; if (L >= nwg) return false;
        int wgid = (int)L; if (rm) wgid = i * G + (c % NXCD) * (G / NXCD) + c / NXCD; else { const int q = nwg / NXCD, r = nwg % NXCD, xcd = wgid % NXCD, off = wgid / NXCD; wgid = (xcd < r ? xcd * (q + 1) : r * (q + 1) + (xcd - r) * q) + off; }
        const int nig = WGM * nN, gid = wgid / nig, fm = gid * WGM, gsz = (nM - fm) < WGM ? (nM - fm) : WGM;
        u.pm = fm + ((wgid % nig) % gsz); u.pn = (wgid % nig) / gsz; return true;
    }
    __device__ __forceinline__ void a_ready(const Unit&) const {}
    __device__ __forceinline__ void done(const Unit&) const {}
};

typedef float f32x2 __attribute__((ext_vector_type(2)));
typedef __bf16 bf16x2_t __attribute__((ext_vector_type(2)));
__device__ __forceinline__ unsigned cvt_pk_bf16(float lo, float hi) { f32x2 v = {lo, hi}; bf16x2_t b = __builtin_convertvector(v, bf16x2_t); return __builtin_bit_cast(unsigned, b); }
__device__ __forceinline__ u32x4 pack8(const f32x4& v0, const f32x4& v1) { u32x4 w; w.x = cvt_pk_bf16(v0[0], v0[1]); w.y = cvt_pk_bf16(v0[2], v0[3]); w.z = cvt_pk_bf16(v1[0], v1[1]); w.w = cvt_pk_bf16(v1[2], v1[3]); return w; }

template <int ACT, bool RS> struct EpiBf16S {
    static constexpr bool PERM = true, AFTER_DRAIN = false;
    bf16_t* O; int ldc; float scale; const float* ss;
    __device__ __forceinline__ void operator()(const f32x4 (&acc)[2][2][4][2], const Unit& u, int wr, int wc, int fr, int fq) const {
        const int row0 = u.pm * BM + wr * 64 + fr, col0 = u.pn * BM + wc * 32 + 8 * fq;
        float rsv[2][4];
#pragma unroll
        for (int ai = 0; ai < 2; ++ai)
#pragma unroll
            for (int m = 0; m < 4; ++m) rsv[ai][m] = RS ? ss[row0 + ai * HALF + m * 16] : 0.f;
#pragma unroll
        for (int ai = 0; ai < 2; ++ai)
#pragma unroll
            for (int m = 0; m < 4; ++m) { const int row = row0 + ai * HALF + m * 16;
                bf16_t* rowp = ACT == 1 ? O + (size_t)u.pm * BM * ldc + (size_t)u.pn * 65536 + (size_t)(row - u.pm * BM) * 256 + (col0 - u.pn * BM) : O + (size_t)row * ldc + col0;
                float rs = scale;
                if (RS) rs = scale * __builtin_amdgcn_rsqf(rsv[ai][m] * (1.0f / 4096.0f) + 1e-6f);
#pragma unroll
                for (int bj = 0; bj < 2; ++bj) { f32x4 v0 = acc[ai][bj][m][0] * rs, v1 = acc[ai][bj][m][1] * rs;
                    if (ACT == 1) {
#pragma unroll
                        for (int e = 0; e < 4; ++e) { const float a = fmaxf(v0[e], 0.f), b = fmaxf(v1[e], 0.f); v0[e] = a * a; v1[e] = b * b; } }
                    *(u32x4*)(rowp + bj * HALF) = pack8(v0, v1); } }
    }
};
template <bool BASE_F32> struct EpiResB {
    static constexpr bool PERM = true, AFTER_DRAIN = false;
    const float* basef; const bf16_t* Xin; bf16_t* X; int ldc; float* ss;
    __device__ __forceinline__ void operator()(const f32x4 (&acc)[2][2][4][2], const Unit& u, int wr, int wc, int fr, int fq) const {
        const int row0 = u.pm * BM + wr * 64 + fr, col0 = u.pn * BM + wc * 32 + 8 * fq;
#pragma unroll
        for (int ai = 0; ai < 2; ++ai) {
            f32x4 bf[4][2][2]; u32x4 bw[4][2];
#pragma unroll
            for (int m = 0; m < 4; ++m) { const size_t off = (size_t)(row0 + ai * HALF + m * 16) * ldc + col0;
#pragma unroll
                for (int bj = 0; bj < 2; ++bj) {
                    if (BASE_F32) { bf[m][bj][0] = *(const f32x4*)(basef + off + bj * HALF); bf[m][bj][1] = *(const f32x4*)(basef + off + bj * HALF + 4); }
                    else bw[m][bj] = *(const u32x4*)(Xin + off + bj * HALF); } }
#pragma unroll
            for (int m = 0; m < 4; ++m) { const int row = row0 + ai * HALF + m * 16; const size_t off = (size_t)row * ldc + col0;
                float s = 0.f;
#pragma unroll
                for (int bj = 0; bj < 2; ++bj) {
                    f32x4 b0, b1;
                    if (BASE_F32) { b0 = bf[m][bj][0]; b1 = bf[m][bj][1]; }
                    else { const u32x4 w = bw[m][bj];
                        b0 = (f32x4){__uint_as_float(w.x << 16), __uint_as_float(w.x & 0xffff0000u), __uint_as_float(w.y << 16), __uint_as_float(w.y & 0xffff0000u)};
                        b1 = (f32x4){__uint_as_float(w.z << 16), __uint_as_float(w.z & 0xffff0000u), __uint_as_float(w.w << 16), __uint_as_float(w.w & 0xffff0000u)}; }
                    const f32x4 v0 = b0 + acc[ai][bj][m][0], v1 = b1 + acc[ai][bj][m][1];
                    s += (v0[0] * v0[0] + v0[1] * v0[1]) + (v0[2] * v0[2] + v0[3] * v0[3]) + (v1[0] * v1[0] + v1[1] * v1[1]) + (v1[2] * v1[2] + v1[3] * v1[3]);
                    *(u32x4*)(X + off + bj * HALF) = pack8(v0, v1); }
                s += __shfl_xor(s, 16); s += __shfl_xor(s, 32);
                if (fq == 0) (void)__hip_atomic_fetch_add(ss + row, s, __ATOMIC_RELAXED, __HIP_MEMORY_SCOPE_AGENT); }
        }
    }
};
struct EpiProj {
    static constexpr bool PERM = true, AFTER_DRAIN = false;
    bf16_t* O; int M; const float* cs; const float* sn; int posmask;
    __device__ __forceinline__ void operator()(const f32x4 (&acc)[2][2][4][2], const Unit& u, int wr, int wc, int fr, int fq) const {
        const int row0 = u.pm * BM + wr * 64 + fr;
        const int sec = u.pn >> 3;
        bf16_t* const obase = O + ((size_t)(2 * u.pn) * M + row0) * 128 + wc * 32 + 8 * fq;
        const size_t bjs = (size_t)M * 128;
        if (sec < 2) {
            const int i0 = 16 * wc + 4 * fq; const float ks = sec == 1 ? 0.08838834764831845f : 1.0f;
            f32x4 c4[2][4], s4[2][4];
#pragma unroll
            for (int ai = 0; ai < 2; ++ai)
#pragma unroll
                for (int m = 0; m < 4; ++m) { const int pos = (row0 + ai * HALF + m * 16) & posmask; c4[ai][m] = *(const f32x4*)(cs + (size_t)pos * 64 + i0); s4[ai][m] = *(const f32x4*)(sn + (size_t)pos * 64 + i0); }
#pragma unroll
            for (int ai = 0; ai < 2; ++ai)
#pragma unroll
                for (int m = 0; m < 4; ++m) { const f32x4 c = c4[ai][m] * ks, sv = s4[ai][m] * ks; bf16_t* rowp = obase + (size_t)(ai * HALF + m * 16) * 128;
#pragma unroll
                    for (int bj = 0; bj < 2; ++bj) { const f32x4 v0 = acc[ai][bj][m][0], v1 = acc[ai][bj][m][1]; f32x4 o0, o1;
                        o0[0] = v0[0] * c[0] - v0[1] * sv[0]; o0[1] = v0[0] * sv[0] + v0[1] * c[0];
                        o0[2] = v0[2] * c[1] - v0[3] * sv[1]; o0[3] = v0[2] * sv[1] + v0[3] * c[1];
                        o1[0] = v1[0] * c[2] - v1[1] * sv[2]; o1[1] = v1[0] * sv[2] + v1[1] * c[2];
                        o1[2] = v1[2] * c[3] - v1[3] * sv[3]; o1[3] = v1[2] * sv[3] + v1[3] * c[3];
                        *(u32x4*)(rowp + bj * bjs) = pack8(o0, o1); } }
        } else if (sec == 3) {
#pragma unroll
            for (int ai = 0; ai < 2; ++ai)
#pragma unroll
                for (int m = 0; m < 4; ++m) { bf16_t* rowp = obase + (size_t)(ai * HALF + m * 16) * 128;
#pragma unroll
                    for (int bj = 0; bj < 2; ++bj) { f32x4 v0 = acc[ai][bj][m][0], v1 = acc[ai][bj][m][1];
#pragma unroll
                        for (int e = 0; e < 4; ++e) { v0[e] = v0[e] * __builtin_amdgcn_rcpf(1.f + __builtin_amdgcn_exp2f(-1.4426950408889634f * v0[e]));
                                                      v1[e] = v1[e] * __builtin_amdgcn_rcpf(1.f + __builtin_amdgcn_exp2f(-1.4426950408889634f * v1[e])); }
                        *(u32x4*)(rowp + bj * bjs) = pack8(v0, v1); } }
        } else {
            const float sc = sec == 4 ? 0.12751743074602224f : 1.0f;
#pragma unroll
            for (int ai = 0; ai < 2; ++ai)
#pragma unroll
                for (int m = 0; m < 4; ++m) { bf16_t* rowp = obase + (size_t)(ai * HALF + m * 16) * 128;
#pragma unroll
                    for (int bj = 0; bj < 2; ++bj) *(u32x4*)(rowp + bj * bjs) = pack8(acc[ai][bj][m][0] * sc, acc[ai][bj][m][1] * sc); }
        }
    }
};
template <class Epi, class Sched, bool ALIGN_EPI = false, bool SP2 = false>
__device__ __forceinline__ void gemm_phase(PG8_LAS unsigned char* lds, const Gemm g, const Sched& S, const Epi& E) {
    int tid_ = threadIdx.x; asm volatile("" : "+v"(tid_));
    const int tid = tid_, wid = __builtin_amdgcn_readfirstlane(tid >> 6), lane = tid & 63, wr = wid >> 2, wc = wid & 3, fr = lane & 15, fq = lane >> 4;
    const int K = g.K, nt = K / BK;
    unsigned voffA[2], voffB[2];
#pragma unroll
    for (int i = 0; i < 2; ++i) { int R, C; stage_rc(tid * 16 + i * 8192, R, C); const int Rb = Epi::PERM ? ((R & ~31) + perm32(R & 31)) : R;
        voffA[i] = (unsigned)(R * (g.ablk ? 256 : K) + C) * 2u; voffB[i] = (unsigned)(Rb * K + C) * 2u; }
    const size_t kstep = (size_t)(BK * 2);
    const size_t hstep = (size_t)HALF * K * 2;
    const size_t tstep = 2 * hstep;
    const size_t hstepA = g.ablk ? (size_t)HALF * 256 * 2 : hstep;
#define PG8_KOFF(t_) (g.ablk ? (size_t)((t_) >> 2) * 131072 + (size_t)((t_) & 3) * 128 : (size_t)(t_) * kstep)
    const unsigned ldsw = (unsigned)wid * 1024u;
    const int aoff = lds_byte(wr * 64 + fr, fq * 8), boff = lds_byte(wc * 32 + fr, fq * 8);
#define PG8_SA(b, h) (((b) * 2 + (h)) * HTB)
#define PG8_SB(b, h) ((4 + (b) * 2 + (h)) * HTB)
#define PG8_STAGE(bufoff, gbase, voff) do { _Pragma("unroll") for (int _i = 0; _i < 2; ++_i) \
        __builtin_amdgcn_global_load_lds((const unsigned*)((const char*)(gbase) + (voff)[_i]), (PG8_LAS unsigned*)(lds + (bufoff) + ldsw + _i * 8192), 16, 0, 0); } while (0)
#define PG8_LDA(dst, b, h) do { _Pragma("unroll") for (int m = 0; m < 4; ++m) _Pragma("unroll") for (int k = 0; k < 2; ++k) dst[m][k] = *(const PG8_LAS bf16x8*)(lds + PG8_SA(b, h) + aoff + m * 2048 + k * 1024); } while (0)
#define PG8_LDB(dst, b, h) do { _Pragma("unroll") for (int n = 0; n < 2; ++n) _Pragma("unroll") for (int k = 0; k < 2; ++k) dst[n][k] = *(const PG8_LAS bf16x8*)(lds + PG8_SB(b, h) + boff + n * 2048 + k * 1024); } while (0)
#define PG8_MMA(ai, bj, At, Bt) do { __builtin_amdgcn_s_setprio(1); _Pragma("unroll") for (int m = 0; m < 4; ++m) _Pragma("unroll") for (int n = 0; n < 2; ++n) _Pragma("unroll") for (int k = 0; k < 2; ++k) \
        acc[ai][bj][m][n] = __builtin_amdgcn_mfma_f32_16x16x32_bf16(Bt[n][k], At[m][k], acc[ai][bj][m][n], 0, 0, 0); __builtin_amdgcn_s_setprio(0); } while (0)
#define PG8_WAIT_V(n) asm volatile("s_waitcnt vmcnt(" #n ")" ::: "memory")
#define PG8_WAIT_L(n) asm volatile("s_waitcnt lgkmcnt(" #n ")" ::: "memory")
#define PG8_BAR __builtin_amdgcn_s_barrier()
#define PG8_SCHED __builtin_amdgcn_sched_barrier(0)
    Unit cur, nxt; int ui = 0;
    if (!S.next(0, cur)) return;
    f32x4 acc[2][2][4][2];
#pragma unroll
    for (int a = 0; a < 2; ++a)
#pragma unroll
        for (int b = 0; b < 2; ++b)
#pragma unroll
            for (int m = 0; m < 4; ++m)
#pragma unroll
                for (int n = 0; n < 2; ++n) acc[a][b][m][n] = (f32x4){0.f, 0.f, 0.f, 0.f};
    bf16x8 At[4][2], B0[2][2], B1[2][2];
    const char* cA = (const char*)g.A + (size_t)cur.pm * tstep; const char* cB = (const char*)g.Bt + (size_t)cur.pn * tstep;
    S.a_ready(cur);
    if constexpr (SP2) {
        PG8_STAGE(PG8_SB(0, 0), cB, voffB); PG8_STAGE(PG8_SB(0, 1), cB + hstep, voffB); PG8_STAGE(PG8_SA(0, 0), cA, voffA); PG8_STAGE(PG8_SA(0, 1), cA + hstepA, voffA);
        if (wr == 1) PG8_BAR;
        PG8_WAIT_V(2); PG8_BAR;
        PG8_STAGE(PG8_SB(1, 0), cB + kstep, voffB); PG8_STAGE(PG8_SA(1, 0), cA + kstep, voffA); PG8_STAGE(PG8_SB(1, 1), cB + hstep + kstep, voffB);
        PG8_WAIT_V(6); PG8_BAR;
    } else {
        PG8_STAGE(PG8_SB(0, 0), cB, voffB); PG8_STAGE(PG8_SA(0, 0), cA, voffA); PG8_STAGE(PG8_SB(0, 1), cB + hstep, voffB); PG8_STAGE(PG8_SA(0, 1), cA + hstepA, voffA);
        if (wr == 1) PG8_BAR;
        PG8_WAIT_V(4); PG8_BAR;
        PG8_STAGE(PG8_SB(1, 0), cB + kstep, voffB); PG8_STAGE(PG8_SA(1, 0), cA + kstep, voffA); PG8_STAGE(PG8_SB(1, 1), cB + hstep + kstep, voffB);
        PG8_WAIT_V(6); PG8_BAR;
    }
    for (;;) {
        const bool has_next = S.next(ui + 1, nxt);
        const char* nA = has_next ? (const char*)g.A + (size_t)nxt.pm * tstep : cA; const char* nB = has_next ? (const char*)g.Bt + (size_t)nxt.pn * tstep : cB;
        for (int t = 0; t < nt; t += 2) {
            const bool last = (t == nt - 2);
            const char* a1 = cA + PG8_KOFF(t) + kstep;
            const char* a2 = last ? nA : cA + PG8_KOFF(t + 2); const char* b2 = last ? nB : cB + (size_t)(t + 2) * kstep;
            const char* a3 = a2 + kstep; const char* b3 = b2 + kstep;
            if (last && has_next) S.a_ready(nxt);
            if constexpr (SP2) {
            PG8_LDB(B0, 0, 0); PG8_LDB(B1, 0, 1); PG8_SCHED; PG8_LDA(At, 0, 0); PG8_STAGE(PG8_SA(1, 1), a1 + hstepA, voffA);
            PG8_WAIT_V(8); PG8_WAIT_L(0); PG8_BAR; PG8_MMA(0, 0, At, B0); PG8_MMA(0, 1, At, B1); PG8_BAR; PG8_SCHED;
            PG8_LDA(At, 0, 1); PG8_STAGE(PG8_SB(0, 0), b2, voffB); PG8_STAGE(PG8_SB(0, 1), b2 + hstep, voffB); PG8_STAGE(PG8_SA(0, 0), a2, voffA);
            PG8_WAIT_V(8); PG8_WAIT_L(0); PG8_BAR; PG8_MMA(1, 0, At, B0); PG8_MMA(1, 1, At, B1); PG8_BAR; PG8_SCHED;
            PG8_LDB(B0, 1, 0); PG8_LDB(B1, 1, 1); PG8_SCHED; PG8_LDA(At, 1, 0); PG8_STAGE(PG8_SA(0, 1), a2 + hstepA, voffA);
            PG8_WAIT_V(8); PG8_WAIT_L(0); PG8_BAR; PG8_MMA(0, 0, At, B0); PG8_MMA(0, 1, At, B1); PG8_BAR; PG8_SCHED;
            PG8_LDA(At, 1, 1); PG8_STAGE(PG8_SB(1, 0), b3, voffB); PG8_STAGE(PG8_SB(1, 1), b3 + hstep, voffB); PG8_STAGE(PG8_SA(1, 0), a3, voffA);
            PG8_WAIT_V(8); PG8_WAIT_L(0); PG8_BAR; PG8_MMA(1, 0, At, B0); PG8_MMA(1, 1, At, B1); PG8_BAR; PG8_SCHED;
            } else {
            PG8_LDB(B0, 0, 0); PG8_SCHED; PG8_LDA(At, 0, 0); PG8_STAGE(PG8_SA(1, 1), a1 + hstepA, voffA);
            PG8_WAIT_L(8); PG8_BAR; PG8_WAIT_L(0); PG8_MMA(0, 0, At, B0); PG8_BAR; PG8_SCHED;
            PG8_LDB(B1, 0, 1); PG8_STAGE(PG8_SB(0, 0), b2, voffB);
            PG8_BAR; PG8_WAIT_L(0); PG8_MMA(0, 1, At, B1); PG8_BAR;
            PG8_LDA(At, 0, 1); PG8_STAGE(PG8_SA(0, 0), a2, voffA);
            PG8_BAR; PG8_WAIT_L(0); PG8_MMA(1, 0, At, B0); PG8_BAR; PG8_SCHED;
            PG8_STAGE(PG8_SB(0, 1), b2 + hstep, voffB);
            PG8_WAIT_V(6); PG8_BAR; PG8_MMA(1, 1, At, B1); PG8_BAR;
            PG8_LDB(B0, 1, 0); PG8_SCHED; PG8_LDA(At, 1, 0); PG8_STAGE(PG8_SA(0, 1), a2 + hstepA, voffA);
            PG8_WAIT_L(8); PG8_BAR; PG8_WAIT_L(0); PG8_MMA(0, 0, At, B0); PG8_BAR; PG8_SCHED;
            PG8_LDB(B1, 1, 1); PG8_STAGE(PG8_SB(1, 0), b3, voffB);
            PG8_BAR; PG8_WAIT_L(0); PG8_MMA(0, 1, At, B1); PG8_BAR;
            PG8_LDA(At, 1, 1); PG8_STAGE(PG8_SA(1, 0), a3, voffA);
            PG8_BAR; PG8_WAIT_L(0); PG8_MMA(1, 0, At, B0); PG8_BAR; PG8_SCHED;
            PG8_STAGE(PG8_SB(1, 1), b3 + hstep, voffB);
            PG8_WAIT_V(6); PG8_BAR; PG8_MMA(1, 1, At, B1); PG8_BAR;
            }
        }
        if constexpr (ALIGN_EPI) { if (wr == 0) PG8_BAR; }
        if constexpr (!Epi::AFTER_DRAIN) { E(acc, cur, wr, wc, fr, fq); S.done(cur); }
        if (!has_next) break;
#pragma unroll
        for (int a = 0; a < 2; ++a)
#pragma unroll
            for (int b = 0; b < 2; ++b)
#pragma unroll
                for (int m = 0; m < 4; ++m)
#pragma unroll
                    for (int n = 0; n < 2; ++n) acc[a][b][m][n] = (f32x4){0.f, 0.f, 0.f, 0.f};
        cur = nxt; cA = nA; cB = nB; ++ui;
        if constexpr (ALIGN_EPI) { if (wr == 1) PG8_BAR; }
    }
    PG8_WAIT_V(0);
    if constexpr (!ALIGN_EPI) { if (wr == 0) PG8_BAR; }
    PG8_BAR;
    if constexpr (Epi::AFTER_DRAIN) { E.fused(acc, cur, wr, wc, fr, fq, lds, wid, lane); S.done(cur); }
#undef PG8_SA
#undef PG8_KOFF
#undef PG8_SB
#undef PG8_STAGE
#undef PG8_LDA
#undef PG8_LDB
#undef PG8_MMA
#undef PG8_WAIT_V
#undef PG8_WAIT_L
#undef PG8_BAR
#undef PG8_SCHED
}
}
#ifndef PG8_SP2
#define PG8_SP2 true
#endif
#ifndef PG8_ALIGN
#define PG8_ALIGN true
#endif

constexpr int NWAVES = 8, NTHREADS = 512;
constexpr int MLPG = 4;
constexpr int NPHASE = 14 + 2 * MLPG;
#ifndef MK_N_LAUNCHES
#define MK_N_LAUNCHES 1
#endif
constexpr int N_LAUNCHES = MK_N_LAUNCHES;

constexpr int DM = 4096, NTOK = 32768, HTOK = 16384, INW = 11264, DFF = 16384, MEMW = 512, NMEM = 1536, HD = 128;
constexpr int RETW = 2048, QA_OFF = 8192, KA_OFF = 10240, VA_OFF = 10752;
constexpr float RMS_EPS = 1e-6f, LOG2E = 1.4426950408889634f;
constexpr int TBW = 264;

constexpr size_t MiB = 1u << 20;
constexpr size_t WS_CTL = 0, CTL_ZERO_BYTES = 1 * MiB;
constexpr size_t WS_COS = 1 * MiB, WS_SIN = 3 * MiB, WS_TB = 5 * MiB;
constexpr size_t WS_MEMN = 6 * MiB, WS_KVM = 18 * MiB;
constexpr size_t WS_WIN = 24 * MiB, WS_WOUT = 112 * MiB, WS_WCQ = 144 * MiB, WS_WCKV = 148 * MiB, WS_WCO = 156 * MiB, WS_W1 = 160 * MiB, WS_W2 = 288 * MiB;
constexpr size_t WS_XN = 416 * MiB;
constexpr size_t WS_R = 672 * MiB;
constexpr size_t WS_PROJ = WS_R, WS_Y = WS_R + 352 * MiB, WS_ST = WS_Y + 128 * MiB, WS_END = WS_ST + 128 * MiB;
constexpr size_t WS_QC = WS_R, WS_OC = WS_R + 32 * MiB;
constexpr size_t WS_HID = WS_R;
constexpr size_t WS_PROBE5 = WS_PROJ, WS_PROBE13 = WS_R + 64 * MiB, WS_PROBE15 = WS_WIN, WS_PROBE_SS = 896 * 1024;
static_assert(WS_HID + (size_t)HTOK * DFF * 2 <= WS_END && WS_END == 1280 * MiB, "d_ws map");
constexpr int CW_TMO = 0, CW_BAR = 4096;
constexpr int CW_BQ_HEAD = 8192, CW_ARR = 8192 + 64;
constexpr int BQ_I1 = (DM / 64) * (DFF / 32), BQ_I2 = (DFF / 64) * (DM / 32), BQ_ITEMS = BQ_I1 + BQ_I2;
constexpr size_t WS_SS = 512 * 1024;

constexpr int RING_OFF = 0, RING_BYTES = 131072;
constexpr int LDSCTL_OFF = RING_BYTES, MISC_OFF = LDSCTL_OFF + 320;
constexpr int TAB_OFF = LDSCTL_OFF + 1024;
constexpr int LDS_BYTES = 163840;
static_assert(TAB_OFF + 16 * TBW * 4 <= LDS_BYTES, "LDS map");

#define GAS __attribute__((address_space(1)))
#define LAS __attribute__((address_space(3)))
#define DI __device__ __forceinline__
typedef unsigned short bf16;
typedef unsigned v4u __attribute__((ext_vector_type(4)));
typedef unsigned v2u __attribute__((ext_vector_type(2)));
typedef float f32x4 __attribute__((ext_vector_type(4)));
typedef float f32x16 __attribute__((ext_vector_type(16)));
typedef short bf16x8 __attribute__((ext_vector_type(8)));
typedef short v4i16_t __attribute__((ext_vector_type(4)));
typedef GAS unsigned gu32;
#define RLX_AGENT __ATOMIC_RELAXED, __HIP_MEMORY_SCOPE_AGENT
#define LDS_WAIT() asm volatile("s_waitcnt lgkmcnt(0)" ::: "memory")
#define VM_WAIT() asm volatile("s_waitcnt vmcnt(0)" ::: "memory")
DI unsigned f2bf(float f) { unsigned u = __builtin_bit_cast(unsigned, f); return (u + 0x7fffu + ((u >> 16) & 1u)) >> 16; }
DI unsigned pk2(float lo, float hi) { return pg8::cvt_pk_bf16(lo, hi); }
DI float bflo(unsigned w) { return __uint_as_float(w << 16); }
DI float bfhi(unsigned w) { return __uint_as_float(w & 0xffff0000u); }
DI float ex2(float x) { return __builtin_amdgcn_exp2f(x); }
#define XB_TMO      128
#define XB_XCNT(j)  (256  + 64 * (j))
#define XB_XSUB(j)  (1280 + 64 * (j))
#define XB_XGEN(j)  (2304 + 64 * (j))
#define XB_TOP      3328
#define XB_TOPGEN   3392
#define XCD_BAR_WORDS 3456
#define XB_SPIN_CAP (1u << 18)

__device__ __forceinline__ unsigned xb_ld(unsigned* p)              { return __hip_atomic_load(p, __ATOMIC_RELAXED, __HIP_MEMORY_SCOPE_AGENT); }
__device__ __forceinline__ unsigned xb_add(unsigned* p, unsigned v) { return __hip_atomic_fetch_add(p, v, __ATOMIC_RELAXED, __HIP_MEMORY_SCOPE_AGENT); }
__device__ __forceinline__ unsigned xb_xcc_id() { return (unsigned)__builtin_amdgcn_s_getreg((3 << 11) | 20) & 0xFu; }
#define XB_SPIN(cond, bar) do { unsigned _sp = 0; while (cond) { __builtin_amdgcn_s_sleep(1); \
    if ((++_sp & 255u) == 0u) { if (xb_ld(&(bar)[XB_TMO])) break; if (_sp > XB_SPIN_CAP) { atomicAdd(&(bar)[XB_TMO], 1u); break; } } } } while (0)

struct XcdBarrier {
    unsigned* bar; unsigned x;
    volatile LAS unsigned* st;
};

__device__ __forceinline__ XcdBarrier xcd_barrier_post(unsigned* bar, volatile LAS unsigned* st) {
    XcdBarrier b; b.bar = bar; b.x = xb_xcc_id(); b.st = st;
    if (threadIdx.x == 0) (void)xb_add(&bar[XB_XCNT(b.x)], 1u);
    return b;
}
__device__ __forceinline__ void xcd_barrier_complete(unsigned* bar, unsigned x, unsigned& nloc, unsigned& nx) {
    const unsigned G = gridDim.x * gridDim.y * gridDim.z;
    unsigned sum, cnt, mine, sp = 0u;
    for (;;) {
        sum = 0u; cnt = 0u; mine = 0u;
#pragma unroll
        for (unsigned j = 0; j < 16; ++j) { const unsigned c = xb_ld(&bar[XB_XCNT(j)]); sum += c; cnt += (c > 0u) ? 1u : 0u; mine = (j == x) ? c : mine; }
        if (sum == G) break;
        __builtin_amdgcn_s_sleep(1);
        if ((++sp & 255u) == 0u) { if (xb_ld(&bar[XB_TMO])) break; if (sp > XB_SPIN_CAP) { atomicAdd(&bar[XB_TMO], 1u); break; } }
    }
    nloc = mine > 0u ? mine : 1u; nx = cnt > 0u ? cnt : 1u;
}

__device__ __forceinline__ void xcd_barrier(const XcdBarrier& b) {
    asm volatile("s_waitcnt vmcnt(0)" ::: "memory");
    __syncthreads();
    if (threadIdx.x == 0) {
        unsigned* bar = b.bar;
        __builtin_amdgcn_s_waitcnt(0);
        unsigned nloc = b.st[0], nx = b.st[1];
        if (nloc == 0u) { xcd_barrier_complete(bar, b.x, nloc, nx); b.st[0] = nloc; b.st[1] = nx; }
        const unsigned old = xb_add(&bar[XB_XSUB(b.x)], 1u);
        const unsigned gen = old / nloc;
        if (old + 1u == (gen + 1u) * nloc) {
            __builtin_amdgcn_fence(__ATOMIC_RELEASE, "agent");
            asm volatile("s_waitcnt vmcnt(0)" ::: "memory");
            const unsigned og = xb_add(&bar[XB_TOP], 1u);
            const unsigned tg = og / nx;
            if (og + 1u == (tg + 1u) * nx) xb_add(&bar[XB_TOPGEN], 1u);
            else XB_SPIN(xb_ld(&bar[XB_TOPGEN]) == tg, bar);
            __builtin_amdgcn_fence(__ATOMIC_ACQUIRE, "agent");
            xb_add(&bar[XB_XGEN(b.x)], 1u);
            asm volatile("s_waitcnt vmcnt(0)" ::: "memory");
        } else {
            XB_SPIN(xb_ld(&bar[XB_XGEN(b.x)]) == gen, bar);
            __builtin_amdgcn_fence(__ATOMIC_ACQUIRE, "agent");
            asm volatile("s_waitcnt vmcnt(0)" ::: "memory");
        }
    }
    __syncthreads();
}

DI float wave_sum(float v) {
#pragma unroll
    for (int o = 1; o < 64; o <<= 1) v += __shfl_xor(v, o);
    return v;
}
template <bool ROPEPERM>
DI void p0_transpose_item(const float* W, int K, int N, bf16* WT, LAS float* scr, int item, int lane, const float* gain = nullptr) {
    const int nblk = N / 32, kb = item / nblk, nb = item % nblk, k0 = 64 * kb, n0 = 32 * nb;
    int ncol = n0 + (lane & 31);
    if (ROPEPERM && ncol < 4096) { const int o = ncol & 127; ncol = (ncol & ~127) + (o >> 1) + 64 * (o & 1); }
    float wv[32];
#pragma unroll
    for (int i = 0; i < 32; ++i) { const int kk = 2 * i + (lane >> 5); wv[i] = W[(size_t)(k0 + kk) * N + ncol]; }
    if (gain) {
#pragma unroll
        for (int i = 0; i < 32; ++i) wv[i] *= gain[k0 + 2 * i + (lane >> 5)]; }
#pragma unroll
    for (int i = 0; i < 32; ++i) { const int kk = 2 * i + (lane >> 5); scr[kk * 33 + (lane & 31)] = wv[i]; }
    LDS_WAIT(); asm volatile("" ::: "memory");
    const int c = lane & 7;
#pragma unroll
    for (int j = 0; j < 4; ++j) { const int n = (lane >> 3) + 8 * j; const LAS float* s = scr + (8 * c) * 33 + n;
        v4u o; o.x = pk2(s[0 * 33], s[1 * 33]); o.y = pk2(s[2 * 33], s[3 * 33]); o.z = pk2(s[4 * 33], s[5 * 33]); o.w = pk2(s[6 * 33], s[7 * 33]);
        *(GAS v4u*)(WT + (size_t)(n0 + n) * K + k0 + 8 * c) = o; }
    LDS_WAIT(); asm volatile("" ::: "memory");
}
DI void rms_row_to_bf16(const float* xrow, const float* gain, bf16* orow, int lane) {
    const GAS f32x4* xr = (const GAS f32x4*)xrow + lane;
    f32x4 v[16]; float s = 0.f;
#pragma unroll
    for (int j = 0; j < 16; ++j) { v[j] = xr[64 * j]; s += (v[j].x * v[j].x + v[j].y * v[j].y) + (v[j].z * v[j].z + v[j].w * v[j].w); }
    const float rstd = 1.0f / sqrtf(wave_sum(s) * (1.f / DM) + RMS_EPS);
    const GAS f32x4* gr = (const GAS f32x4*)gain + lane;
    GAS v2u* o8 = (GAS v2u*)orow + lane;
#pragma unroll
    for (int j = 0; j < 16; ++j) { const f32x4 g = gr[64 * j]; v2u w; w.x = pk2(v[j].x * rstd * g.x, v[j].y * rstd * g.y); w.y = pk2(v[j].z * rstd * g.z, v[j].w * rstd * g.w); o8[64 * j] = w; }
}
DI void final_row(const bf16* xrow, float ssrow, const float* gain, float* orow, int lane, bool poison) {
    float rstd = __builtin_amdgcn_rsqf(ssrow * (1.f / DM) + RMS_EPS);
    if (poison) rstd = __builtin_nanf("");
    const GAS v2u* xr = (const GAS v2u*)xrow + lane; const GAS f32x4* gr = (const GAS f32x4*)gain + lane; GAS f32x4* o = (GAS f32x4*)orow + lane;
    v2u v[16];
#pragma unroll
    for (int j = 0; j < 16; ++j) v[j] = xr[64 * j];
#pragma unroll
    for (int j = 0; j < 16; ++j) { const f32x4 g0 = gr[64 * j];
        o[64 * j] = (f32x4){bflo(v[j].x) * rstd * g0.x, bfhi(v[j].x) * rstd * g0.y, bflo(v[j].y) * rstd * g0.z, bfhi(v[j].y) * rstd * g0.w}; }
}

#define MFMA32(a, b, c) __builtin_amdgcn_mfma_f32_32x32x16_bf16((a), (b), (c), 0, 0, 0)
DI int crow(int reg, int h) { return (reg & 3) + 8 * (reg >> 2) + 4 * h; }
DI unsigned off_b(unsigned row, unsigned ch) { return 256u * row + 16u * (ch ^ (((row & 3u) << 2) | ((row >> 2) & 3u))); }
DI bf16x8 row_frag(const LAS unsigned char* img, int rowbase, int lane, int ks) { return *(const LAS bf16x8*)(img + off_b(rowbase + (lane & 31), 2 * ks + (lane >> 5))); }
DI v4i16_t tr4(const LAS unsigned char* p) { return __builtin_amdgcn_ds_read_tr16_b64_v4i16((LAS v4i16_t*)p); }
DI bf16x8 tr_frag_nat(const LAS unsigned char* img, int rowbase, int lane, int c, int ks) {
    const unsigned h = lane >> 5, blk = (lane >> 4) & 1, q = (lane & 15) >> 2, p = lane & 3;
    const unsigned r0 = rowbase + 16 * ks + 8 * h + q, ch = 4 * c + 2 * blk + (p >> 1);
    const v4i16_t lo = tr4(img + off_b(r0, ch) + 8 * (p & 1)), hi = tr4(img + off_b(r0 + 4, ch) + 8 * (p & 1));
    return __builtin_shufflevector(lo, hi, 0, 1, 2, 3, 4, 5, 6, 7);
}
DI bf16x8 tr_frag_perm(const LAS unsigned char* img, int rowbase, int lane, int c, int s) {
    const unsigned h = lane >> 5, blk = (lane >> 4) & 1, q = (lane & 15) >> 2, p = lane & 3;
    const unsigned r0 = rowbase + 16 * s + 4 * h + q, ch = 4 * c + 2 * blk + (p >> 1);
    const v4i16_t lo = tr4(img + off_b(r0, ch) + 8 * (p & 1)), hi = tr4(img + off_b(r0 + 8, ch) + 8 * (p & 1));
    return __builtin_shufflevector(lo, hi, 0, 1, 2, 3, 4, 5, 6, 7);
}
template <int S> DI bf16x8 pack_step(const f32x16& x) {
    v4u p; p.x = pk2(x[8 * S], x[8 * S + 1]); p.y = pk2(x[8 * S + 2], x[8 * S + 3]); p.z = pk2(x[8 * S + 4], x[8 * S + 5]); p.w = pk2(x[8 * S + 6], x[8 * S + 7]);
    return __builtin_bit_cast(bf16x8, p);
}
DI void ret_scan(bf16* ST, int nseq, int nchunk, const float* dec_f, const float* dec_b, int gtid, int nthreads) {
    const int ntask = nseq * 32 * 2048;
    for (int task = gtid; task < ntask; task += nthreads) {
        const int chain = task >> 11, eo = (task & 2047) * 8, seq = chain >> 5, hh = (chain >> 1) & 15, dir = chain & 1;
        const float lg = -expf(dir ? dec_b[hh] : dec_f[hh]), cd = ex2(128.f * lg * LOG2E);
        float s[8];
#pragma unroll
        for (int e = 0; e < 8; ++e) s[e] = 0.f;
        const ptrdiff_t cstride = (ptrdiff_t)16 * 2 * 16384 * (dir ? -1 : 1);
        bf16* p = ST + ((size_t)((seq * nchunk + (dir ? nchunk - 1 : 0)) * 16 + hh) * 2 + dir) * 16384 + eo;
        for (int cc = 0; cc < nchunk; cc += 8) {
            v4u v[8];
#pragma unroll
            for (int u = 0; u < 8; ++u) v[u] = *(const GAS v4u*)(p + u * cstride);
#pragma unroll
            for (int u = 0; u < 8; ++u) {
                v4u o; o.x = pk2(s[0], s[1]); o.y = pk2(s[2], s[3]); o.z = pk2(s[4], s[5]); o.w = pk2(s[6], s[7]);
                *(GAS v4u*)(p + u * cstride) = o;
                s[0] = s[0] * cd + bflo(v[u].x); s[1] = s[1] * cd + bfhi(v[u].x); s[2] = s[2] * cd + bflo(v[u].y); s[3] = s[3] * cd + bfhi(v[u].y);
                s[4] = s[4] * cd + bflo(v[u].z); s[5] = s[5] * cd + bfhi(v[u].z); s[6] = s[6] * cd + bflo(v[u].w); s[7] = s[7] * cd + bfhi(v[u].w);
            }
            p += 8 * cstride;
        }
    }
}
#define PJ(base, cb, row) ((base) + ((size_t)(cb) * HTOK + (size_t)(row)) * HD)
DI void tile_load(v4u (&r)[4], const bf16* g, size_t pitch, int tid) {
#pragma unroll
    for (int i = 0; i < 4; ++i) { const int n = tid + 512 * i, row = n >> 4, ch = n & 15; r[i] = *(const GAS v4u*)(g + (size_t)row * pitch + ch * 8); }
}
DI void tile_write(LAS unsigned char* img, const v4u (&r)[4], int tid) {
#pragma unroll
    for (int i = 0; i < 4; ++i) { const int n = tid + 512 * i, row = n >> 4, ch = n & 15; *(LAS v4u*)(img + off_b(row, ch)) = r[i]; }
}
DI void tile_write_scaled(LAS unsigned char* img, const v4u (&r)[4], int tid, float a, float b) {
#pragma unroll
    for (int i = 0; i < 4; ++i) { const int n = tid + 512 * i, row = n >> 4, ch = n & 15; const v4u v = r[i]; const float sc = ex2(a + b * (float)row);
        v4u o; o.x = pk2(bflo(v.x) * sc, bfhi(v.x) * sc); o.y = pk2(bflo(v.y) * sc, bfhi(v.y) * sc); o.z = pk2(bflo(v.z) * sc, bfhi(v.z) * sc); o.w = pk2(bflo(v.w) * sc, bfhi(v.w) * sc);
        *(LAS v4u*)(img + off_b(row, ch)) = o; }
}

template <bool WIN, int g>
DI void attn_phase(LAS unsigned char* L, const bf16* QB, const bf16* KB, const bf16* VB, bf16* OB, const float* TB, const float* sink, int tid, const int u_begin, const int G, const int NU) {
    constexpr int nbs = g ? 64 : 32;
    constexpr size_t qpitch = WIN ? HD : MEMW, kvpitch = WIN ? HD : 2 * MEMW, opitch = WIN ? DM : MEMW;
    const int lane0 = tid & 63, wave = __builtin_amdgcn_readfirstlane(tid >> 6);
    LAS float* const tb = (LAS float*)(L + TAB_OFF);
    if (WIN) for (int e = tid; e < 16 * TBW; e += NTHREADS) tb[e] = TB[e];
    int u = u_begin; if (u >= NU) return;
    int lo, hi, dk;
#define ATT_RANGE(uu, lo_, hi_) do { if (WIN) { const int nb_ = ((uu) >> 3) % nbs; lo_ = nb_ == 0 ? 0 : -1; hi_ = nb_ == nbs - 1 ? 1 : 2; } else { lo_ = 0; hi_ = 2; } } while (0)
#define ATT_KROW(uu, dd) (WIN ? (size_t)((((uu) & 7) >> 1) * HTOK + ((uu) >> 3) * 128 + (dd) * 128) : (size_t)(((((uu) >> 2) * 256) < HTOK ? ((((uu) >> 2) * 256) >> 12) * 256 : 1024 + (((((uu) >> 2) * 256) - HTOK) >> 13) * 256) + (dd) * 128))
#define ATT_KCOL(uu) (WIN ? 0 : ((uu) & 3) * HD)
    ATT_RANGE(u, lo, hi); dk = lo;
    v4u rk[4], rv[4];
    tile_load(rk, KB + ATT_KROW(u, dk) * kvpitch + ATT_KCOL(u), kvpitch, tid); tile_load(rv, VB + ATT_KROW(u, dk) * kvpitch + ATT_KCOL(u), kvpitch, tid);
    tile_write(L, rk, tid); tile_write(L + 32768, rv, tid);
    int un = u, dkn = dk + 1, lon = lo, hin = hi;
    if (dkn == hin) { un = u + G; if (un < NU) { ATT_RANGE(un, lon, hin); dkn = lon; } }
    if (un < NU) { tile_load(rk, KB + ATT_KROW(un, dkn) * kvpitch + ATT_KCOL(un), kvpitch, tid); tile_load(rv, VB + ATT_KROW(un, dkn) * kvpitch + ATT_KCOL(un), kvpitch, tid); }
    bf16x8 qf[8]; f32x16 o[4]; float m = 0.f, l = 0.f;
    int b = 0;
    for (;;) {
        int lane = lane0; asm volatile("" : "+v"(lane));
        const int r = lane & 31, h = lane >> 5;
        __syncthreads();
        LAS unsigned char* const imgK = L + b * 65536; LAS unsigned char* const imgV = imgK + 32768;
        const int qrow = WIN ? (u >> 3) * 128 + 32 * (wave & 3) : (u >> 2) * 256 + 32 * wave;
        const int qcol = WIN ? 0 : (u & 3) * HD;
        if (dk == lo) {
            const bf16* qptr = WIN ? PJ(QB, 64 + 2 * (u & 7) + (wave >> 2), qrow) : QB + (size_t)qrow * qpitch + qcol;
#pragma unroll
            for (int ks = 0; ks < 8; ++ks) qf[ks] = *(const GAS bf16x8*)(qptr + (size_t)r * qpitch + 16 * ks + 8 * h);
#pragma unroll
            for (int c = 0; c < 4; ++c)
#pragma unroll
                for (int i = 0; i < 16; ++i) o[c][i] = 0.f;
            if (WIN) { m = sink[2 * (u & 7) + (wave >> 2)] * LOG2E; l = 1.0f; } else { m = -1e30f; l = 0.f; }
        }
        const LAS float* const tbh = tb + (2 * (u & 7) + (wave >> 2)) * TBW;
        const int iq = 32 * (wave & 3) + r;
#pragma unroll
        for (int kh = 0; kh < 2; ++kh) {
            f32x16 st[2];
#pragma unroll
            for (int kt = 0; kt < 2; ++kt) {
#pragma unroll
                for (int i = 0; i < 16; ++i) st[kt][i] = 0.f;
#pragma unroll
                for (int ks = 0; ks < 8; ++ks) st[kt] = MFMA32(row_frag(imgK, 64 * kh + 32 * kt, lane, ks), qf[ks], st[kt]);
            }
            if (WIN) {
                const int relb = 128 * dk - iq + 128 + 64 * kh;
#pragma unroll
                for (int kt = 0; kt < 2; ++kt)
#pragma unroll
                    for (int i = 0; i < 16; ++i) { const int idx = relb + 32 * kt + crow(i, h); const bool ok = (unsigned)idx <= 256u;
                        const float bias = tbh[ok ? idx : 0]; st[kt][i] = ok ? st[kt][i] + bias : -1e30f; }
            }
            float mx = st[0][0];
#pragma unroll
            for (int kt = 0; kt < 2; ++kt)
#pragma unroll
                for (int i = 0; i < 16; ++i) mx = fmaxf(mx, st[kt][i]);
            mx = fmaxf(mx, __shfl_xor(mx, 32));
            const float mnew = fmaxf(m, mx), alpha = ex2(m - mnew); m = mnew;
            float rs = 0.f;
#pragma unroll
            for (int kt = 0; kt < 2; ++kt)
#pragma unroll
                for (int i = 0; i < 16; ++i) { const float p = ex2(st[kt][i] - mnew); st[kt][i] = p; rs += p; }
            rs += __shfl_xor(rs, 32);
            l = l * alpha + rs;
#pragma unroll
            for (int c = 0; c < 4; ++c)
#pragma unroll
                for (int i = 0; i < 16; ++i) o[c][i] *= alpha;
#pragma unroll
            for (int kt = 0; kt < 2; ++kt) {
                const bf16x8 p0 = pack_step<0>(st[kt]), p1 = pack_step<1>(st[kt]);
#pragma unroll
                for (int c = 0; c < 4; ++c) { o[c] = MFMA32(tr_frag_perm(imgV, 64 * kh + 32 * kt, lane, c, 0), p0, o[c]); o[c] = MFMA32(tr_frag_perm(imgV, 64 * kh + 32 * kt, lane, c, 1), p1, o[c]); }
            }
        }
        if (dk == hi - 1) {
            const float inv = 1.0f / l;
            bf16* optr = OB + (size_t)qrow * opitch + (WIN ? RETW + (2 * (u & 7) + (wave >> 2)) * HD : (u & 3) * HD);
#pragma unroll
            for (int c = 0; c < 4; ++c)
#pragma unroll
                for (int m2 = 0; m2 < 2; ++m2) {
                    v2u wa, wb; const int ga = 2 * m2, gb = 2 * m2 + 1;
                    wa.x = pk2(o[c][4 * ga] * inv, o[c][4 * ga + 1] * inv); wa.y = pk2(o[c][4 * ga + 2] * inv, o[c][4 * ga + 3] * inv);
                    wb.x = pk2(o[c][4 * gb] * inv, o[c][4 * gb + 1] * inv); wb.y = pk2(o[c][4 * gb + 2] * inv, o[c][4 * gb + 3] * inv);
                    const v2u sx = __builtin_amdgcn_permlane32_swap(wa.x, wb.x, false, false), sy = __builtin_amdgcn_permlane32_swap(wa.y, wb.y, false, false);
                    v4u w; w.x = sx.x; w.y = sy.x; w.z = sx.y; w.w = sy.y;
                    *(GAS v4u*)(optr + (size_t)r * opitch + 32 * c + 16 * m2 + 8 * h) = w; }
        }
        if (un >= NU) break;
        tile_write(L + (b ^ 1) * 65536, rk, tid); tile_write(L + (b ^ 1) * 65536 + 32768, rv, tid);
        u = un; dk = dkn; lo = lon; hi = hin; b ^= 1;
        dkn = dk + 1;
        if (dkn == hin) { un = u + G; if (un < NU) { ATT_RANGE(un, lon, hin); dkn = lon; } }
        if (un < NU) { tile_load(rk, KB + ATT_KROW(un, dkn) * kvpitch + ATT_KCOL(un), kvpitch, tid); tile_load(rv, VB + ATT_KROW(un, dkn) * kvpitch + ATT_KCOL(un), kvpitch, tid); }
    }
#undef ATT_RANGE
#undef ATT_KROW
#undef ATT_KCOL
}

DI void ret_kv_phase(LAS unsigned char* L, const bf16* PROJ, bf16* ST, const float* dec_f, const float* dec_b, int tid, int G) {
    constexpr int NU = 2048;
    const int lane0 = tid & 63, w = __builtin_amdgcn_readfirstlane(tid >> 6);
    int u = blockIdx.x; if (u >= NU) return;
    v4u rk[4], rv[4];
    { tile_load(rk, PJ(PROJ, 16 + (u & 15), (u >> 4) * 128), HD, tid); tile_load(rv, PJ(PROJ, 32 + (u & 15), (u >> 4) * 128), HD, tid); }
    for (;;) {
        int lane = lane0; asm volatile("" : "+v"(lane)); const int r = lane & 31, h = lane >> 5;
        const int hh = u & 15, c = u >> 4;
        const float lf2 = -expf(dec_f[hh]) * LOG2E, lb2 = -expf(dec_b[hh]) * LOG2E;
        __syncthreads();
        tile_write(L, rv, tid);
        tile_write_scaled(L + 32768, rk, tid, 127.f * lf2, -lf2);
        tile_write_scaled(L + 65536, rk, tid, 0.f, lb2);
        __syncthreads();
        const int un = u + G;
        if (un < NU) { tile_load(rk, PJ(PROJ, 16 + (un & 15), (un >> 4) * 128), HD, tid); tile_load(rv, PJ(PROJ, 32 + (un & 15), (un >> 4) * 128), HD, tid); }
        const int dir = w & 1, ce = w >> 1;
        const LAS unsigned char* imgK = L + 32768 + dir * 32768;
        f32x16 acc[4];
#pragma unroll
        for (int cc = 0; cc < 4; ++cc)
#pragma unroll
            for (int i = 0; i < 16; ++i) acc[cc][i] = 0.f;
#pragma unroll
        for (int ks = 0; ks < 8; ++ks) { const bf16x8 bfr = tr_frag_nat(L, 0, lane, ce, ks);
#pragma unroll
            for (int cd = 0; cd < 4; ++cd) acc[cd] = MFMA32(tr_frag_nat(imgK, 0, lane, cd, ks), bfr, acc[cd]); }
        bf16* dst = ST + ((size_t)(c * 16 + hh) * 2 + dir) * 16384 + (size_t)(32 * ce + r) * 128 + 4 * h;
#pragma unroll
        for (int cd = 0; cd < 4; ++cd)
#pragma unroll
            for (int g4 = 0; g4 < 4; ++g4) { v2u x; x.x = pk2(acc[cd][4 * g4], acc[cd][4 * g4 + 1]); x.y = pk2(acc[cd][4 * g4 + 2], acc[cd][4 * g4 + 3]); *(GAS v2u*)(dst + 32 * cd + 8 * g4) = x; }
        if (un >= NU) break;
        u = un;
    }
}

DI void ret_out_phase(LAS unsigned char* L, const bf16* PROJ, bf16* Y, const bf16* ST, const float* dec_f, const float* dec_b, int tid, int G) {
    constexpr int NU = 2048;
    const int lane0 = tid & 63, w = __builtin_amdgcn_readfirstlane(tid >> 6);
    LAS float* const part = (LAS float*)(L + TAB_OFF);
    LAS unsigned char* const A0 = L; LAS unsigned char* const A1 = L + 32768; LAS unsigned char* const B0 = L + 65536; LAS unsigned char* const B1 = L + 98304;
    int u = blockIdx.x; if (u >= NU) return;
    v4u ra[4], rb[4];
#define RO_LOAD_A(uu) do { tile_load(ra, PJ(PROJ, 16 + ((uu) & 15), ((uu) >> 4) * 128), HD, tid); tile_load(rb, PJ(PROJ, 32 + ((uu) & 15), ((uu) >> 4) * 128), HD, tid); } while (0)
#define RO_LOAD_B(uu) do { const bf16* stp_ = ST + (size_t)(uu) * 2 * 16384; tile_load(ra, stp_, 128, tid); tile_load(rb, stp_ + 16384, 128, tid); } while (0)
    RO_LOAD_A(u);
    tile_write(A0, ra, tid); tile_write(A1, rb, tid);
    RO_LOAD_B(u);
    const int eh = w >> 2;
    f32x16 y[2]; v2u gv[8];
    int fin_u = -1;
#define RO_FINAL() do { const float tot_ = part[w * 32 + r] + part[(w ^ 4) * 32 + r]; const float rstd_ = __builtin_amdgcn_rsqf(tot_ * (1.f / 128.f) + RMS_EPS); \
        bf16* yg_ = Y + (size_t)((fin_u >> 4) * 128 + i) * DM + (fin_u & 15) * HD; \
        _Pragma("unroll") for (int c2 = 0; c2 < 2; ++c2) _Pragma("unroll") for (int g4 = 0; g4 < 4; ++g4) { const int e0 = 32 * (2 * eh + c2) + 8 * g4 + 4 * h; const v2u gq = gv[c2 * 4 + g4]; \
            v2u x; x.x = pk2(y[c2][4 * g4] * rstd_ * bflo(gq.x), y[c2][4 * g4 + 1] * rstd_ * bfhi(gq.x)); x.y = pk2(y[c2][4 * g4 + 2] * rstd_ * bflo(gq.y), y[c2][4 * g4 + 3] * rstd_ * bfhi(gq.y)); \
            *(GAS v2u*)(yg_ + e0) = x; } } while (0)
    for (;;) {
        const int un = u + G;
        int lane = lane0; asm volatile("" : "+v"(lane));
        const int r = lane & 31, h = lane >> 5, i = 32 * (w & 3) + r;
        __syncthreads();
        if (fin_u >= 0) RO_FINAL();
        const int hh = u & 15;
        const float lf2 = -expf(dec_f[hh]) * LOG2E, lb2 = -expf(dec_b[hh]) * LOG2E;
        bf16x8 qf[8];
        { const bf16* qg = PJ(PROJ, hh, (u >> 4) * 128 + i);
#pragma unroll
          for (int ks = 0; ks < 8; ++ks) qf[ks] = *(const GAS bf16x8*)(qg + 16 * ks + 8 * h); }
#pragma unroll
        for (int c2 = 0; c2 < 2; ++c2)
#pragma unroll
            for (int q = 0; q < 16; ++q) y[c2][q] = 0.f;
#pragma unroll
        for (int jt = 0; jt < 4; ++jt) {
            f32x16 st;
#pragma unroll
            for (int q = 0; q < 16; ++q) st[q] = 0.f;
#pragma unroll
            for (int ks = 0; ks < 8; ++ks) st = MFMA32(row_frag(A0, 32 * jt, lane, ks), qf[ks], st);
#pragma unroll
            for (int q = 0; q < 16; ++q) { const int d = i - (32 * jt + crow(q, h)); const float f = ex2((float)d * (d >= 0 ? lf2 : -lb2)); st[q] *= f; }
            const bf16x8 p0 = pack_step<0>(st), p1 = pack_step<1>(st);
#pragma unroll
            for (int c2 = 0; c2 < 2; ++c2) { y[c2] = MFMA32(tr_frag_perm(A1, 32 * jt, lane, 2 * eh + c2, 0), p0, y[c2]); y[c2] = MFMA32(tr_frag_perm(A1, 32 * jt, lane, 2 * eh + c2, 1), p1, y[c2]); }
        }
        tile_write(B0, ra, tid); tile_write(B1, rb, tid);
        if (un < NU) RO_LOAD_A(un);
        { const bf16* gg = PJ(PROJ, 48 + hh, (u >> 4) * 128 + i);
#pragma unroll
          for (int c2 = 0; c2 < 2; ++c2)
#pragma unroll
              for (int g4 = 0; g4 < 4; ++g4) gv[c2 * 4 + g4] = *(const GAS v2u*)(gg + 32 * (2 * eh + c2) + 8 * g4 + 4 * h); }
        __syncthreads();
        {
            const float xf = ex2((float)(i + 1) * lf2), xb = ex2((float)(128 - i) * lb2);
            f32x16 cc[2];
#pragma unroll
            for (int c2 = 0; c2 < 2; ++c2)
#pragma unroll
                for (int q = 0; q < 16; ++q) cc[c2][q] = 0.f;
#pragma unroll
            for (int ks = 0; ks < 8; ++ks)
#pragma unroll
                for (int c2 = 0; c2 < 2; ++c2) cc[c2] = MFMA32(row_frag(B0, 32 * (2 * eh + c2), lane, ks), qf[ks], cc[c2]);
#pragma unroll
            for (int c2 = 0; c2 < 2; ++c2)
#pragma unroll
                for (int q = 0; q < 16; ++q) { y[c2][q] += xf * cc[c2][q]; cc[c2][q] = 0.f; }
            __builtin_amdgcn_sched_barrier(0);
#pragma unroll
            for (int ks = 0; ks < 8; ++ks)
#pragma unroll
                for (int c2 = 0; c2 < 2; ++c2) cc[c2] = MFMA32(row_frag(B1, 32 * (2 * eh + c2), lane, ks), qf[ks], cc[c2]);
            float ss = 0.f;
#pragma unroll
            for (int c2 = 0; c2 < 2; ++c2)
#pragma unroll
                for (int q = 0; q < 16; ++q) { const float v = y[c2][q] + xb * cc[c2][q]; y[c2][q] = v; ss += v * v; }
            ss += __shfl_xor(ss, 32);
            if (h == 0) part[w * 32 + r] = ss;
            fin_u = u;
        }
        if (un >= NU) break;
        tile_write(A0, ra, tid); tile_write(A1, rb, tid);
        RO_LOAD_B(un);
        u = un;
    }
    { const int lane = lane0, r = lane & 31, h = lane >> 5, i = 32 * (w & 3) + r; __syncthreads(); RO_FINAL(); }
#undef RO_LOAD_A
#undef RO_LOAD_B
#undef RO_FINAL
}
struct Args { const float* in[20]; float* out; unsigned char* ws; int ph_lo, ph_hi, li, pad; };
DI int t5_bucket(int rel) {
    const int n = rel < 0 ? -rel : rel;
    const int b = n < 8 ? n : n < 12 ? 8 : n < 16 ? 9 : n < 23 ? 10 : n < 32 ? 11 : n < 46 ? 12 : n < 64 ? 13 : n < 91 ? 14 : 15;
    return b + (rel > 0 ? 16 : 0);
}

#define PH_BEGIN() int tid = threadIdx.x; asm volatile("" : "+v"(tid)); GAS unsigned char* wsg_ = (GAS unsigned char*)args.ws; asm volatile("" : "+s"(wsg_)); unsigned char* ws = (unsigned char*)wsg_;   \
    LAS unsigned char* const L = (LAS unsigned char*)lds; const int lane = tid & 63, wave = __builtin_amdgcn_readfirstlane(tid >> 6), G = gridDim.x; \
    const int vcu = (G % 8 == 0) ? ((int)blockIdx.x % 8) * (G / 8) + (int)blockIdx.x / 8 : (int)blockIdx.x; (void)lane; (void)wave; (void)vcu; (void)L
#ifndef PROBE_BARMASK
#define PROBE_BARMASK 0x3ffff
#endif
#define GRID_BAR(id) do { if (N_LAUNCHES == 1) { GAS unsigned* bpg_ = (GAS unsigned*)(args.ws + WS_CTL) + CW_BAR; asm volatile("" : "+s"(bpg_)); unsigned* bp_ = (unsigned*)bpg_; XcdBarrier b_; b_.bar = bp_; b_.x = xb_xcc_id(); \
    b_.st = (volatile LAS unsigned*)((LAS unsigned char*)lds + MISC_OFF) + 8; unsigned long long t0_ = 0; if (PROBE_KIND == 1 && (((PROBE_BARMASK) >> (id)) & 1) && threadIdx.x == 0) t0_ = __builtin_amdgcn_s_memrealtime(); xcd_barrier(b_); if (NREP(19) > 1) xcd_barrier(b_); if (PROBE_KIND == 1 && (((PROBE_BARMASK) >> (id)) & 1) && threadIdx.x == 0) atomicAdd((unsigned long long*)(args.ws + WS_TS), (unsigned long long)(__builtin_amdgcn_s_memrealtime() - t0_)); } } while (0)
#ifndef REPMASK
#define REPMASK 0
#endif
#ifndef PROBE_KIND
#define PROBE_KIND 0
#endif
#ifndef PROBE_K
#define PROBE_K 4
#endif
#ifndef PROBE_PHMASK
#define PROBE_PHMASK 0
#endif
#define WS_TS (960 * 1024)
#define NREP(k) ((((REPMASK) >> (k)) & 1) ? 2 : 1)
#ifndef PHMASK
#define PHMASK 0x3ffffff
#endif
#define IN(k) ((((PHMASK) >> (k)) & 1) && lo <= (k) && (k) < hi)
#define SPAN_T0(k) unsigned long long sp0_ = 0; if (PROBE_KIND == 2 && (((PROBE_PHMASK) >> (k)) & 1) && blockIdx.x == 0 && threadIdx.x == 0) sp0_ = __builtin_amdgcn_s_memrealtime()
#define SPAN_T1(k) do { if (PROBE_KIND == 2 && (((PROBE_PHMASK) >> (k)) & 1) && blockIdx.x == 0 && threadIdx.x == 0) atomicAdd((unsigned long long*)(args.ws + WS_TS) + 1, (unsigned long long)(__builtin_amdgcn_s_memrealtime() - sp0_)); } while (0)
#define BOTH(k) (IN(k) && IN((k) + 1))
constexpr int BQ_LAG = 1;
DI void bq_run(const Args& args, unsigned char* lds, const int phase, const bool drain) {
    int tid = threadIdx.x; asm volatile("" : "+v"(tid)); GAS unsigned char* wsg_ = (GAS unsigned char*)args.ws; asm volatile("" : "+s"(wsg_)); unsigned char* ws = (unsigned char*)wsg_;
    LAS unsigned char* const L = (LAS unsigned char*)lds; const int lane = tid & 63, wave = __builtin_amdgcn_readfirstlane(tid >> 6), G = gridDim.x;
    gu32* const head = (gu32*)(ws + WS_CTL) + CW_BQ_HEAD; gu32* const arr = (gu32*)(ws + WS_CTL) + CW_ARR + 64 * phase;
    volatile LAS unsigned* const word = (volatile LAS unsigned*)(L + MISC_OFF) + 16;
    LAS float* const scr = (LAS float*)(L + RING_OFF + wave * 16384);
    if (tid == 0) (void)__hip_atomic_fetch_add(arr, 1u, RLX_AGENT);
    for (;;) {
        __syncthreads();
        if (tid == 0) { unsigned h = BQ_ITEMS;
            if ((drain || __hip_atomic_load(arr, RLX_AGENT) + BQ_LAG < (unsigned)G) && __hip_atomic_load(head, RLX_AGENT) < (unsigned)BQ_ITEMS) h = __hip_atomic_fetch_add(head, 8u, RLX_AGENT);
            *word = h; }
        __syncthreads();
        const int it = (int)*word + wave;
        if (it >= BQ_ITEMS) { if ((int)*word >= BQ_ITEMS) break; else continue; }
        if (it < BQ_I1) p0_transpose_item<false>(args.in[17], DM, DFF, (bf16*)(ws + WS_W1), scr, it, lane, args.in[16]);
        else p0_transpose_item<false>(args.in[18], DFF, DM, (bf16*)(ws + WS_W2), scr, it - BQ_I1, lane);
    }
}

template <int g> DI void mixer_half(const Args& args, unsigned char* lds, const int lo, const int hi) {
        const int pb = 1 + 5 * g;
        const int nbs = g ? 64 : 32, nseq = g ? 2 : 4;
        if (IN(pb)) {
            PH_BEGIN();
            pg8::Gemm gm{(const bf16*)(ws + WS_XN) + (size_t)g * HTOK * DM, (const bf16*)(ws + WS_WIN), HTOK, INW, DM, 0}; pg8::StaticOrder S; S.init(HTOK, INW, G, (int)blockIdx.x);
            pg8::EpiProj E{(bf16*)(ws + WS_PROJ), HTOK, (const float*)(ws + WS_COS), (const float*)(ws + WS_SIN), g ? 8191 : 4095};
            _Pragma("unroll 1") for (int rep = 0; rep < NREP(1); ++rep) pg8::gemm_phase<pg8::EpiProj, pg8::StaticOrder, PG8_ALIGN, PG8_SP2>(L + RING_OFF, gm, S, E);
            bq_run(args, lds, pb, false);
            if (BOTH(pb)) GRID_BAR(pb);
        }
        if (IN(pb + 1)) {
            SPAN_T0(pb + 1);
          _Pragma("unroll 1") for (int rep = 0; rep < NREP(2); ++rep) {
            PH_BEGIN();
            bf16* const PROJ = (bf16*)(ws + WS_PROJ);
            const bool flip = (((int)blockIdx.x >> 3) & 1) != 0;
            if (!flip) {
                ret_kv_phase(L, PROJ, (bf16*)(ws + WS_ST), args.in[6], args.in[7], tid, G);
                __syncthreads();
                attn_phase<true, g>(L, PROJ, PJ(PROJ, 80, 0), PJ(PROJ, 84, 0), (bf16*)(ws + WS_Y), (const float*)(ws + WS_TB), args.in[8], tid, (int)blockIdx.x, G, 1024);
            } else {
                attn_phase<true, g>(L, PROJ, PJ(PROJ, 80, 0), PJ(PROJ, 84, 0), (bf16*)(ws + WS_Y), (const float*)(ws + WS_TB), args.in[8], tid, (int)blockIdx.x, G, 1024);
                __syncthreads();
                int tid2 = threadIdx.x; asm volatile("" : "+v"(tid2));
                ret_kv_phase(L, PROJ, (bf16*)(ws + WS_ST), args.in[6], args.in[7], tid2, G);
            }
          }
            bq_run(args, lds, pb + 1, false);
            if (BOTH(pb + 1)) GRID_BAR(pb + 1);
            SPAN_T1(pb + 1);
        }
        if (IN(pb + 2)) {
            SPAN_T0(pb + 2);
            PH_BEGIN();
            if (g == 0) {
                if ((int)blockIdx.x >= G - 24) {
                    pg8::Gemm gm{(const bf16*)(ws + WS_MEMN), (const bf16*)(ws + WS_WCKV), NMEM, 2 * MEMW, DM, 0}; pg8::StaticOrder S; S.init(NMEM, 2 * MEMW, 24, (int)blockIdx.x - (G - 24));
                    pg8::EpiBf16S<0, false> E{(bf16*)(ws + WS_KVM), 2 * MEMW, 1.0f, nullptr};
                    pg8::gemm_phase<pg8::EpiBf16S<0, false>, pg8::StaticOrder, PG8_ALIGN, PG8_SP2>(L + RING_OFF, gm, S, E);
                } else ret_scan((bf16*)(ws + WS_ST), nseq, nbs, args.in[6], args.in[7], blockIdx.x * NTHREADS + tid, (G - 24) * NTHREADS);
            } else ret_scan((bf16*)(ws + WS_ST), nseq, nbs, args.in[6], args.in[7], blockIdx.x * NTHREADS + tid, G * NTHREADS);
            bq_run(args, lds, pb + 2, false);
            if (BOTH(pb + 2)) GRID_BAR(pb + 2);
            SPAN_T1(pb + 2);
        }
        if (IN(pb + 3)) {
            SPAN_T0(pb + 3);
          _Pragma("unroll 1") for (int rep = 0; rep < NREP(4); ++rep) {
            PH_BEGIN();
            ret_out_phase(L, (const bf16*)(ws + WS_PROJ), (bf16*)(ws + WS_Y), (const bf16*)(ws + WS_ST), args.in[6], args.in[7], tid, G);
          }
            bq_run(args, lds, pb + 3, false);
            if (BOTH(pb + 3)) GRID_BAR(pb + 3);
            SPAN_T1(pb + 3);
        }
        if (IN(pb + 4)) {
            PH_BEGIN();
            pg8::Gemm gm{(const bf16*)(ws + WS_Y), (const bf16*)(ws + WS_WOUT), HTOK, DM, DM, 0}; pg8::StaticOrder S; S.init(HTOK, DM, G, (int)blockIdx.x);
            if (NREP(5) > 1) { pg8::EpiResB<true> E2{args.in[g], nullptr, (bf16*)(ws + WS_PROBE5), DM, (float*)(ws + WS_PROBE_SS)}; pg8::gemm_phase<pg8::EpiResB<true>, pg8::StaticOrder, PG8_ALIGN, PG8_SP2>(L + RING_OFF, gm, S, E2); }
            pg8::EpiResB<true> E{args.in[g], nullptr, (bf16*)(ws + WS_XN) + (size_t)g * HTOK * DM, DM, (float*)(ws + WS_SS) + g * HTOK};
            pg8::gemm_phase<pg8::EpiResB<true>, pg8::StaticOrder, PG8_ALIGN, PG8_SP2>(L + RING_OFF, gm, S, E);
            if (g == 1) bq_run(args, lds, pb + 4, false);
            if (g == 1 && BOTH(pb + 4)) GRID_BAR(pb + 4);
        }
}

__global__ void __launch_bounds__(NTHREADS, 2) hymba_fwd(Args args) {
    extern __shared__ __attribute__((aligned(16))) unsigned char lds[];
    {
        const int t0 = threadIdx.x;
        for (int u = t0; u < (LDS_BYTES - LDSCTL_OFF) / 4; u += NTHREADS) ((LAS unsigned*)((LAS unsigned char*)lds + LDSCTL_OFF))[u] = 0u;
        __syncthreads();
        if (N_LAUNCHES == 1) (void)xcd_barrier_post((unsigned*)(args.ws + WS_CTL) + CW_BAR, (volatile LAS unsigned*)((LAS unsigned char*)lds + MISC_OFF) + 8);
    }
    const int lo = args.ph_lo, hi = args.ph_hi;

    if (IN(0)) {
        SPAN_T0(0);
      _Pragma("unroll 1") for (int rep = 0; rep < NREP(0); ++rep) {
        PH_BEGIN();
        const int gw = vcu * NWAVES + wave, NGW = G * NWAVES, gtid = blockIdx.x * NTHREADS + tid, NT = G * NTHREADS;
        LAS float* scr = (LAS float*)(L + RING_OFF + wave * 16384);
        constexpr int I_IN = (DM / 64) * (INW / 32), I_OUT = (DM / 64) * (DM / 32), I_CQ = (DM / 64) * (MEMW / 32), I_CKV = (DM / 64) * (2 * MEMW / 32), I_CO = (MEMW / 64) * (DM / 32);
        constexpr int NITEMS = I_IN + I_OUT + I_CQ + I_CKV + I_CO;
        for (int it = gw; it < NITEMS; it += NGW) {
            int r = it;
            if (r < I_IN) { p0_transpose_item<true>(args.in[5], DM, INW, (bf16*)(ws + WS_WIN), scr, r, lane); continue; } r -= I_IN;
            if (r < I_OUT) { p0_transpose_item<false>(args.in[10], DM, DM, (bf16*)(ws + WS_WOUT), scr, r, lane); continue; } r -= I_OUT;
            if (r < I_CQ) { p0_transpose_item<false>(args.in[13], DM, MEMW, (bf16*)(ws + WS_WCQ), scr, r, lane, args.in[11]); continue; } r -= I_CQ;
            if (r < I_CKV) { p0_transpose_item<false>(args.in[14], DM, 2 * MEMW, (bf16*)(ws + WS_WCKV), scr, r, lane); continue; } r -= I_CKV;
            p0_transpose_item<false>(args.in[15], MEMW, DM, (bf16*)(ws + WS_WCO), scr, r, lane);
        }
        float* const COS = (float*)(ws + WS_COS); float* const SIN = (float*)(ws + WS_SIN); float* const TB = (float*)(ws + WS_TB);
        for (int e = gtid; e < 8192 * 64; e += NT) { const int pos = e >> 6, i = e & 63;
            const float inv = exp2f(-(float)i * (13.287712379549449f / 64.0f));
            const float ang = (float)pos * inv;
            double rev = (double)ang * 0.15915494309189535; rev -= floor(rev);
            const float rf = (float)rev;
            COS[e] = __builtin_amdgcn_cosf(rf); SIN[e] = __builtin_amdgcn_sinf(rf); }
        for (int e = gtid; e < 16 * TBW; e += NT) { const int hh = e / TBW, idx = e % TBW; const int rel = idx - 128;
            TB[e] = (idx <= 256) ? args.in[9][t5_bucket(rel) * 16 + hh] * LOG2E : 0.f; }
        bf16* const XN = (bf16*)(ws + WS_XN);
        for (int m = gw; m < NTOK; m += NGW) { const float* src = (m < HTOK) ? args.in[0] + (size_t)m * DM : args.in[1] + (size_t)(m - HTOK) * DM; rms_row_to_bf16(src, args.in[4], XN + (size_t)m * DM, lane); }
        for (int m = gw; m < NMEM; m += NGW) { const float* src = (m < 1024) ? args.in[2] + (size_t)m * DM : args.in[3] + (size_t)(m - 1024) * DM; rms_row_to_bf16(src, args.in[12], (bf16*)(ws + WS_MEMN) + (size_t)m * DM, lane); }
      }
        if (BOTH(0)) GRID_BAR(0);
        SPAN_T1(0);
    }

    mixer_half<0>(args, lds, lo, hi);
    mixer_half<1>(args, lds, lo, hi);

    if (IN(11)) {
        SPAN_T0(11);
        PH_BEGIN();
        pg8::Gemm gm{(const bf16*)(ws + WS_XN), (const bf16*)(ws + WS_WCQ), NTOK, MEMW, DM, 0}; pg8::StaticOrder S; S.init(NTOK, MEMW, G, (int)blockIdx.x);
        pg8::EpiBf16S<0, true> E{(bf16*)(ws + WS_QC), MEMW, 0.12751743074602224f, (const float*)(ws + WS_SS)};
        _Pragma("unroll 1") for (int rep = 0; rep < NREP(11); ++rep) pg8::gemm_phase<pg8::EpiBf16S<0, true>, pg8::StaticOrder, PG8_ALIGN, PG8_SP2>(L + RING_OFF, gm, S, E);
        __builtin_amdgcn_fence(__ATOMIC_ACQUIRE, "agent"); asm volatile("s_waitcnt vmcnt(0)" ::: "memory"); __syncthreads();
        const bf16* KVM = (const bf16*)(ws + WS_KVM);
        int tid2 = threadIdx.x; asm volatile("" : "+v"(tid2));
        pg8::Unit uu;
        _Pragma("unroll 1") for (int i = 0; S.next(i, uu); ++i) { const int ua = 4 * uu.pm + 2 * uu.pn;
            attn_phase<false, 0>(L, (const bf16*)(ws + WS_QC), KVM, KVM + MEMW, (bf16*)(ws + WS_OC), nullptr, nullptr, tid2, ua, 1, ua + 2); __syncthreads(); }
        bq_run(args, lds, 11, false);
        if (BOTH(11)) GRID_BAR(11);
        SPAN_T1(11);
    }
    if (IN(12)) {
        PH_BEGIN();
        pg8::Gemm gm{(const bf16*)(ws + WS_OC), (const bf16*)(ws + WS_WCO), NTOK, DM, MEMW, 0}; pg8::StaticOrder S; S.init(NTOK, DM, G, (int)blockIdx.x);
        if (NREP(12) > 1) { pg8::EpiResB<false> E2{nullptr, (const bf16*)(ws + WS_XN), (bf16*)(ws + WS_PROBE13), DM, (float*)(ws + WS_PROBE_SS)}; pg8::gemm_phase<pg8::EpiResB<false>, pg8::StaticOrder, PG8_ALIGN, PG8_SP2>(L + RING_OFF, gm, S, E2); }
        pg8::EpiResB<false> E{nullptr, (const bf16*)(ws + WS_XN), (bf16*)(ws + WS_XN), DM, (float*)(ws + WS_SS) + NTOK};
        pg8::gemm_phase<pg8::EpiResB<false>, pg8::StaticOrder, PG8_ALIGN, PG8_SP2>(L + RING_OFF, gm, S, E);
        bq_run(args, lds, 12, true);
        if (BOTH(12)) GRID_BAR(12);
    }
    constexpr int MTOK = NTOK / MLPG;
#pragma unroll
    for (int g = 0; g < MLPG; ++g) {
        if (IN(13 + 2 * g)) {
            PH_BEGIN();
            pg8::Gemm gm{(const bf16*)(ws + WS_XN) + (size_t)g * MTOK * DM, (const bf16*)(ws + WS_W1), MTOK, DFF, DM, 0}; pg8::StaticOrder S; S.init(MTOK, DFF, G, (int)blockIdx.x);
            pg8::EpiBf16S<1, true> E{(bf16*)(ws + WS_HID) + (size_t)(g & 1) * MTOK * DFF, DFF, 1.0f, (const float*)(ws + WS_SS) + NTOK + g * MTOK};
            _Pragma("unroll 1") for (int rep = 0; rep < NREP(13); ++rep) pg8::gemm_phase<pg8::EpiBf16S<1, true>, pg8::StaticOrder, PG8_ALIGN, PG8_SP2>(L + RING_OFF, gm, S, E);
            if (BOTH(13 + 2 * g)) GRID_BAR(13 + 2 * g);
        }
        if (IN(14 + 2 * g)) {
            PH_BEGIN();
            pg8::Gemm gm{(const bf16*)(ws + WS_HID) + (size_t)(g & 1) * MTOK * DFF, (const bf16*)(ws + WS_W2), MTOK, DM, DFF, 1}; pg8::StaticOrder S; S.init(MTOK, DM, G, (int)blockIdx.x, 1);
            if (NREP(14) > 1) { pg8::EpiResB<false> E2{nullptr, (const bf16*)(ws + WS_XN) + (size_t)g * MTOK * DM, (bf16*)(ws + WS_PROBE15), DM, (float*)(ws + WS_PROBE_SS)}; pg8::gemm_phase<pg8::EpiResB<false>, pg8::StaticOrder, PG8_ALIGN, PG8_SP2>(L + RING_OFF, gm, S, E2); }
            pg8::EpiResB<false> E{nullptr, (const bf16*)(ws + WS_XN) + (size_t)g * MTOK * DM, (bf16*)(ws + WS_XN) + (size_t)g * MTOK * DM, DM, (float*)(ws + WS_SS) + 2 * NTOK + g * MTOK};
            pg8::gemm_phase<pg8::EpiResB<false>, pg8::StaticOrder, PG8_ALIGN, PG8_SP2>(L + RING_OFF, gm, S, E);
            if (BOTH(14 + 2 * g) && (N_LAUNCHES != 1 || g == MLPG - 1)) GRID_BAR(14 + 2 * g);
        }
    }
    SPAN_T0(13 + 2 * MLPG);
    if (IN(13 + 2 * MLPG)) {
        PH_BEGIN();
        const bool poison = (N_LAUNCHES == 1) && (__hip_atomic_load((gu32*)((unsigned*)(ws + WS_CTL) + CW_BAR + XB_TMO), RLX_AGENT) != 0u);
        const int gw = vcu * NWAVES + wave, NGW = G * NWAVES; float* const o = args.out; const bf16* const X = (const bf16*)(ws + WS_XN); const float* const ss3 = (const float*)(ws + WS_SS) + 2 * NTOK;
        _Pragma("unroll 1") for (int rep = 0; rep < NREP(13 + 2 * MLPG); ++rep) for (int m = gw; m < NTOK; m += NGW) final_row(X + (size_t)m * DM, ss3[m], args.in[19], o + (size_t)m * DM, lane, poison);
    }
    if (PROBE_KIND != 0 && N_LAUNCHES == 1) {
        SPAN_T1(13 + 2 * MLPG);
        __syncthreads();
        if (blockIdx.x == 0 && threadIdx.x == 0) {
            const unsigned long long* ts = (const unsigned long long*)(args.ws + WS_TS);
            unsigned long long q = (PROBE_KIND == 1) ? __hip_atomic_load(ts, RLX_AGENT) / gridDim.x : __hip_atomic_load(ts + 1, RLX_AGENT);
            const unsigned long long t0 = __builtin_amdgcn_s_memrealtime(), want = q * PROBE_K;
            while (__builtin_amdgcn_s_memrealtime() - t0 < want) __builtin_amdgcn_s_sleep(8);
        }
        __syncthreads();
    }
#undef IN
#undef BOTH
}

extern "C" void kernel_launch(void* const* d_in, const int* in_sizes, int n_in, void* d_out, int out_size, void* d_ws, size_t ws_size, hipStream_t stream) {
    static int grid = 0;
    if (grid == 0) {
        if (n_in != 20 || out_size != NTOK * DM || ws_size < WS_END) { fprintf(stderr, "kernel_launch: shape/workspace mismatch (n_in %d, out %d, ws %zu, need %zu); nothing launched\n", n_in, out_size, ws_size, (size_t)WS_END); grid = -1; return; }
        int dev = 0, cus = 0, per_cu = 0;
        if (hipGetDevice(&dev) != hipSuccess || hipDeviceGetAttribute(&cus, hipDeviceAttributeMultiprocessorCount, dev) != hipSuccess) { grid = -1; return; }
        if (hipFuncSetAttribute((const void*)hymba_fwd, hipFuncAttributeMaxDynamicSharedMemorySize, LDS_BYTES) != hipSuccess) { fprintf(stderr, "kernel_launch: hipFuncSetAttribute failed\n"); grid = -1; return; }
        if (hipOccupancyMaxActiveBlocksPerMultiprocessor(&per_cu, (const void*)hymba_fwd, NTHREADS, LDS_BYTES) != hipSuccess || per_cu < 1)
            fprintf(stderr, "kernel_launch: note: occupancy query reports %d workgroups per CU\n", per_cu);
        (void)hipGetLastError();
        grid = cus;
    }
    if (grid < 0) return;
    if (hipMemsetAsync((char*)d_ws + WS_CTL, 0, CTL_ZERO_BYTES, stream) != hipSuccess) return;
    Args a{};
    for (int i = 0; i < 20; ++i) a.in[i] = (const float*)d_in[i];
    a.out = (float*)d_out; a.ws = (unsigned char*)d_ws; a.pad = 0;
    for (int li = 0; li < N_LAUNCHES; ++li) {
        a.ph_lo = (N_LAUNCHES == 1) ? 0 : li; a.ph_hi = (N_LAUNCHES == 1) ? NPHASE : li + 1; a.li = li;
        hipLaunchKernelGGL(hymba_fwd, dim3(grid), dim3(NTHREADS), LDS_BYTES, stream, a);
        const hipError_t le = hipPeekAtLastError();
        if (le != hipSuccess) { fprintf(stderr, "kernel_launch: launch %d failed: %s\n", li, hipGetErrorName(le)); break; }
    }
}
```

```cpp
#include <hip/hip_runtime.h>
#include <cstdio>
#include <cstdint>
namespace pg8 {
#define PG8_LAS __attribute__((address_space(3)))
typedef unsigned short bf16_t;
typedef short bf16x8 __attribute__((ext_vector_type(8)));
typedef float f32x4 __attribute__((ext_vector_type(4)));
typedef unsigned u32x4 __attribute__((ext_vector_type(4)));
constexpr int BM = 256, BK = 64, HALF = 128, HTB = HALF * BK * 2  , STAGE_BYTES = 8 * HTB, NXCD = 8, WGM = 8;

__host__ __device__ __forceinline__ int lds_byte(int r, int c) { const int st = (r >> 4) * 2 + (c >> 5), rr = r & 15, cc = c & 31, ob = rr * 64 + cc * 2; return st * 1024 + (ob ^ (((ob >> 9) & 1) << 5)); }
__host__ __device__ __forceinline__ void stage_rc(int b, int& R, int& C) { const int st = b / 1024, sb = b % 1024, swz = sb ^ (((sb >> 9) & 1) << 5); R = (st >> 1) * 16 + swz / 64; C = (st & 1) * 32 + (swz % 64) / 2; }
__host__ __device__ __forceinline__ int perm32(int rho) { const int n = rho >> 4, i = rho & 15; return 8 * (i >> 2) + 4 * n + (i & 3); }

struct Unit { int pm, pn; };
struct Gemm { const bf16_t* A; const bf16_t* Bt; int M, N, K; int ablk; };

struct StaticOrder {
    int nM, nN, nwg, G, c, rm;
    __host__ __device__ __forceinline__ void init(int M, int N, int G_, int c_, int rm_ = 0) { nM = M / BM; nN = N / BM; nwg = nM * nN; G = G_; c = c_; rm = (rm_ && G_ % NXCD == 0 && nwg % G_ == 0) ? 1 : 0; }
    __host__ __device__ __forceinline__ bool next(int i, Unit& u) const {
        const long L = (long)i * G + c; if (L >= nwg) return false;
        int wgid = (int)L; if (rm) wgid = i * G + (c % NXCD) * (G / NXCD) + c / NXCD; else { const int q = nwg / NXCD, r = nwg % NXCD, xcd = wgid % NXCD, off = wgid / NXCD; wgid = (xcd < r ? xcd * (q + 1) : r * (q + 1) + (xcd - r) * q) + off; }
        const int nig = WGM * nN, gid = wgid / nig, fm = gid * WGM, gsz = (nM - fm) < WGM ? (nM - fm) : WGM;
        u.pm = fm + ((wgid % nig) % gsz); u.pn = (wgid % nig) / gsz; return true;
    }
    __device__ __forceinline__ void a_ready(const Unit&) const {}
    __device__ __forceinline__ void done(const Unit&) const {}
};

typedef float f32x2 __attribute__((ext_vector_type(2)));
typedef __bf16 bf16x2_t __attribute__((ext_vector_type(2)));
__device__ __forceinline__ unsigned cvt_pk_bf16(float lo, float hi) { f32x2 v = {lo, hi}; bf16x2_t b = __builtin_convertvector(v, bf16x2_t); return __builtin_bit_cast(unsigned, b); }
__device__ __forceinline__ u32x4 pack8(const f32x4& v0, const f32x4& v1) { u32x4 w; w.x = cvt_pk_bf16(v0[0], v0[1]); w.y = cvt_pk_bf16(v0[2], v0[3]); w.z = cvt_pk_bf16(v1[0], v1[1]); w.w = cvt_pk_bf16(v1[2], v1[3]); return w; }

template <int ACT, bool RS> struct EpiBf16S {
    static constexpr bool PERM = true, AFTER_DRAIN = false;
    bf16_t* O; int ldc; float scale; const float* ss;
    __device__ __forceinline__ void operator()(const f32x4 (&acc)[2][2][4][2], const Unit& u, int wr, int wc, int fr, int fq) const {
        const int row0 = u.pm * BM + wr * 64 + fr, col0 = u.pn * BM + wc * 32 + 8 * fq;
        float rsv[2][4];
#pragma unroll
        for (int ai = 0; ai < 2; ++ai)
#pragma unroll
            for (int m = 0; m < 4; ++m) rsv[ai][m] = RS ? ss[row0 + ai * HALF + m * 16] : 0.f;
#pragma unroll
        for (int ai = 0; ai < 2; ++ai)
#pragma unroll
            for (int m = 0; m < 4; ++m) { const int row = row0 + ai * HALF + m * 16;
                bf16_t* rowp = ACT == 1 ? O + (size_t)u.pm * BM * ldc + (size_t)u.pn * 65536 + (size_t)(row - u.pm * BM) * 256 + (col0 - u.pn * BM) : O + (size_t)row * ldc + col0;
                float rs = scale;
                if (RS) rs = scale * __builtin_amdgcn_rsqf(rsv[ai][m] * (1.0f / 4096.0f) + 1e-6f);
#pragma unroll
                for (int bj = 0; bj < 2; ++bj) { f32x4 v0 = acc[ai][bj][m][0] * rs, v1 = acc[ai][bj][m][1] * rs;
                    if (ACT == 1) {
#pragma unroll
                        for (int e = 0; e < 4; ++e) { const float a = fmaxf(v0[e], 0.f), b = fmaxf(v1[e], 0.f); v0[e] = a * a; v1[e] = b * b; } }
                    *(u32x4*)(rowp + bj * HALF) = pack8(v0, v1); } }
    }
};
template <bool BASE_F32> struct EpiResB {
    static constexpr bool PERM = true, AFTER_DRAIN = false;
    const float* basef; const bf16_t* Xin; bf16_t* X; int ldc; float* ss;
    __device__ __forceinline__ void operator()(const f32x4 (&acc)[2][2][4][2], const Unit& u, int wr, int wc, int fr, int fq) const {
        const int row0 = u.pm * BM + wr * 64 + fr, col0 = u.pn * BM + wc * 32 + 8 * fq;
#pragma unroll
        for (int ai = 0; ai < 2; ++ai) {
            f32x4 bf[4][2][2]; u32x4 bw[4][2];
#pragma unroll
            for (int m = 0; m < 4; ++m) { const size_t off = (size_t)(row0 + ai * HALF + m * 16) * ldc + col0;
#pragma unroll
                for (int bj = 0; bj < 2; ++bj) {
                    if (BASE_F32) { bf[m][bj][0] = *(const f32x4*)(basef + off + bj * HALF); bf[m][bj][1] = *(const f32x4*)(basef + off + bj * HALF + 4); }
                    else bw[m][bj] = *(const u32x4*)(Xin + off + bj * HALF); } }
#pragma unroll
            for (int m = 0; m < 4; ++m) { const int row = row0 + ai * HALF + m * 16; const size_t off = (size_t)row * ldc + col0;
                float s = 0.f;
#pragma unroll
                for (int bj = 0; bj < 2; ++bj) {
                    f32x4 b0, b1;
                    if (BASE_F32) { b0 = bf[m][bj][0]; b1 = bf[m][bj][1]; }
                    else { const u32x4 w = bw[m][bj];
                        b0 = (f32x4){__uint_as_float(w.x << 16), __uint_as_float(w.x & 0xffff0000u), __uint_as_float(w.y << 16), __uint_as_float(w.y & 0xffff0000u)};
                        b1 = (f32x4){__uint_as_float(w.z << 16), __uint_as_float(w.z & 0xffff0000u), __uint_as_float(w.w << 16), __uint_as_float(w.w & 0xffff0000u)}; }
                    const f32x4 v0 = b0 + acc[ai][bj][m][0], v1 = b1 + acc[ai][bj][m][1];
                    s += (v0[0] * v0[0] + v0[1] * v0[1]) + (v0[2] * v0[2] + v0[3] * v0[3]) + (v1[0] * v1[0] + v1[1] * v1[1]) + (v1[2] * v1[2] + v1[3] * v1[3]);
                    *(u32x4*)(X + off + bj * HALF) = pack8(v0, v1); }
                s += __shfl_xor(s, 16); s += __shfl_xor(s, 32);
                if (fq == 0) (void)__hip_atomic_fetch_add(ss + row, s, __ATOMIC_RELAXED, __HIP_MEMORY_SCOPE_AGENT); }
        }
    }
};
struct EpiProj {
    static constexpr bool PERM = true, AFTER_DRAIN = false;
    bf16_t* O; int M; const float* cs; const float* sn; int posmask;
    __device__ __forceinline__ void operator()(const f32x4 (&acc)[2][2][4][2], const Unit& u, int wr, int wc, int fr, int fq) const {
        const int row0 = u.pm * BM + wr * 64 + fr;
        const int sec = u.pn >> 3;
        bf16_t* const obase = O + ((size_t)(2 * u.pn) * M + row0) * 128 + wc * 32 + 8 * fq;
        const size_t bjs = (size_t)M * 128;
        if (sec < 2) {
            const int i0 = 16 * wc + 4 * fq; const float ks = sec == 1 ? 0.08838834764831845f : 1.0f;
            f32x4 c4[2][4], s4[2][4];
#pragma unroll
            for (int ai = 0; ai < 2; ++ai)
#pragma unroll
                for (int m = 0; m < 4; ++m) { const int pos = (row0 + ai * HALF + m * 16) & posmask; c4[ai][m] = *(const f32x4*)(cs + (size_t)pos * 64 + i0); s4[ai][m] = *(const f32x4*)(sn + (size_t)pos * 64 + i0); }
#pragma unroll
            for (int ai = 0; ai < 2; ++ai)
#pragma unroll
                for (int m = 0; m < 4; ++m) { const f32x4 c = c4[ai][m] * ks, sv = s4[ai][m] * ks; bf16_t* rowp = obase + (size_t)(ai * HALF + m * 16) * 128;
#pragma unroll
                    for (int bj = 0; bj < 2; ++bj) { const f32x4 v0 = acc[ai][bj][m][0], v1 = acc[ai][bj][m][1]; f32x4 o0, o1;
                        o0[0] = v0[0] * c[0] - v0[1] * sv[0]; o0[1] = v0[0] * sv[0] + v0[1] * c[0];
                        o0[2] = v0[2] * c[1] - v0[3] * sv[1]; o0[3] = v0[2] * sv[1] + v0[3] * c[1];
                        o1[0] = v1[0] * c[2] - v1[1] * sv[2]; o1[1] = v1[0] * sv[2] + v1[1] * c[2];
                        o1[2] = v1[2] * c[3] - v1[3] * sv[3]; o1[3] = v1[2] * sv[3] + v1[3] * c[3];
                        *(u32x4*)(rowp + bj * bjs) = pack8(o0, o1); } }
        } else if (sec == 3) {
#pragma unroll
            for (int ai = 0; ai < 2; ++ai)
#pragma unroll
                for (int m = 0; m < 4; ++m) { bf16_t* rowp = obase + (size_t)(ai * HALF + m * 16) * 128;
#pragma unroll
                    for (int bj = 0; bj < 2; ++bj) { f32x4 v0 = acc[ai][bj][m][0], v1 = acc[ai][bj][m][1];
#pragma unroll
                        for (int e = 0; e < 4; ++e) { v0[e] = v0[e] * __builtin_amdgcn_rcpf(1.f + __builtin_amdgcn_exp2f(-1.4426950408889634f * v0[e]));
                                                      v1[e] = v1[e] * __builtin_amdgcn_rcpf(1.f + __builtin_amdgcn_exp2f(-1.4426950408889634f * v1[e])); }
                        *(u32x4*)(rowp + bj * bjs) = pack8(v0, v1); } }
        } else {
            const float sc = sec == 4 ? 0.12751743074602224f : 1.0f;
#pragma unroll
            for (int ai = 0; ai < 2; ++ai)
#pragma unroll
                for (int m = 0; m < 4; ++m) { bf16_t* rowp = obase + (size_t)(ai * HALF + m * 16) * 128;
#pragma unroll
                    for (int bj = 0; bj < 2; ++bj) *(u32x4*)(rowp + bj * bjs) = pack8(acc[ai][bj][m][0] * sc, acc[ai][bj][m][1] * sc); }
        }
    }
};
template <class Epi, class Sched, bool ALIGN_EPI = false, bool SP2 = false>
__device__ __forceinline__ void gemm_phase(PG8_LAS unsigned char* lds, const Gemm g, const Sched& S, const Epi& E) {
    int tid_ = threadIdx.x; asm volatile("" : "+v"(tid_));
    const int tid = tid_, wid = __builtin_amdgcn_readfirstlane(tid >> 6), lane = tid & 63, wr = wid >> 2, wc = wid & 3, fr = lane & 15, fq = lane >> 4;
    const int K = g.K, nt = K / BK;
    unsigned voffA[2], voffB[2];
#pragma unroll
    for (int i = 0; i < 2; ++i) { int R, C; stage_rc(tid * 16 + i * 8192, R, C); const int Rb = Epi::PERM ? ((R & ~31) + perm32(R & 31)) : R;
        voffA[i] = (unsigned)(R * (g.ablk ? 256 : K) + C) * 2u; voffB[i] = (unsigned)(Rb * K + C) * 2u; }
    const size_t kstep = (size_t)(BK * 2);
    const size_t hstep = (size_t)HALF * K * 2;
    const size_t tstep = 2 * hstep;
    const size_t hstepA = g.ablk ? (size_t)HALF * 256 * 2 : hstep;
#define PG8_KOFF(t_) (g.ablk ? (size_t)((t_) >> 2) * 131072 + (size_t)((t_) & 3) * 128 : (size_t)(t_) * kstep)
    const unsigned ldsw = (unsigned)wid * 1024u;
    const int aoff = lds_byte(wr * 64 + fr, fq * 8), boff = lds_byte(wc * 32 + fr, fq * 8);
#define PG8_SA(b, h) (((b) * 2 + (h)) * HTB)
#define PG8_SB(b, h) ((4 + (b) * 2 + (h)) * HTB)
#define PG8_STAGE(bufoff, gbase, voff) do { _Pragma("unroll") for (int _i = 0; _i < 2; ++_i) \
        __builtin_amdgcn_global_load_lds((const unsigned*)((const char*)(gbase) + (voff)[_i]), (PG8_LAS unsigned*)(lds + (bufoff) + ldsw + _i * 8192), 16, 0, 0); } while (0)
#define PG8_LDA(dst, b, h) do { _Pragma("unroll") for (int m = 0; m < 4; ++m) _Pragma("unroll") for (int k = 0; k < 2; ++k) dst[m][k] = *(const PG8_LAS bf16x8*)(lds + PG8_SA(b, h) + aoff + m * 2048 + k * 1024); } while (0)
#define PG8_LDB(dst, b, h) do { _Pragma("unroll") for (int n = 0; n < 2; ++n) _Pragma("unroll") for (int k = 0; k < 2; ++k) dst[n][k] = *(const PG8_LAS bf16x8*)(lds + PG8_SB(b, h) + boff + n * 2048 + k * 1024); } while (0)
#define PG8_MMA(ai, bj, At, Bt) do { __builtin_amdgcn_s_setprio(1); _Pragma("unroll") for (int m = 0; m < 4; ++m) _Pragma("unroll") for (int n = 0; n < 2; ++n) _Pragma("unroll") for (int k = 0; k < 2; ++k) \
        acc[ai][bj][m][n] = __builtin_amdgcn_mfma_f32_16x16x32_bf16(Bt[n][k], At[m][k], acc[ai][bj][m][n], 0, 0, 0); __builtin_amdgcn_s_setprio(0); } while (0)
#define PG8_WAIT_V(n) asm volatile("s_waitcnt vmcnt(" #n ")" ::: "memory")
#define PG8_WAIT_L(n) asm volatile("s_waitcnt lgkmcnt(" #n ")" ::: "memory")
#define PG8_BAR __builtin_amdgcn_s_barrier()
#define PG8_SCHED __builtin_amdgcn_sched_barrier(0)
    Unit cur, nxt; int ui = 0;
    if (!S.next(0, cur)) return;
    f32x4 acc[2][2][4][2];
#pragma unroll
    for (int a = 0; a < 2; ++a)
#pragma unroll
        for (int b = 0; b < 2; ++b)
#pragma unroll
            for (int m = 0; m < 4; ++m)
#pragma unroll
                for (int n = 0; n < 2; ++n) acc[a][b][m][n] = (f32x4){0.f, 0.f, 0.f, 0.f};
    bf16x8 At[4][2], B0[2][2], B1[2][2];
    const char* cA = (const char*)g.A + (size_t)cur.pm * tstep; const char* cB = (const char*)g.Bt + (size_t)cur.pn * tstep;
    S.a_ready(cur);
    if constexpr (SP2) {
        PG8_STAGE(PG8_SB(0, 0), cB, voffB); PG8_STAGE(PG8_SB(0, 1), cB + hstep, voffB); PG8_STAGE(PG8_SA(0, 0), cA, voffA); PG8_STAGE(PG8_SA(0, 1), cA + hstepA, voffA);
        if (wr == 1) PG8_BAR;
        PG8_WAIT_V(2); PG8_BAR;
        PG8_STAGE(PG8_SB(1, 0), cB + kstep, voffB); PG8_STAGE(PG8_SA(1, 0), cA + kstep, voffA); PG8_STAGE(PG8_SB(1, 1), cB + hstep + kstep, voffB);
        PG8_WAIT_V(6); PG8_BAR;
    } else {
        PG8_STAGE(PG8_SB(0, 0), cB, voffB); PG8_STAGE(PG8_SA(0, 0), cA, voffA); PG8_STAGE(PG8_SB(0, 1), cB + hstep, voffB); PG8_STAGE(PG8_SA(0, 1), cA + hstepA, voffA);
        if (wr == 1) PG8_BAR;
        PG8_WAIT_V(4); PG8_BAR;
        PG8_STAGE(PG8_SB(1, 0), cB + kstep, voffB); PG8_STAGE(PG8_SA(1, 0), cA + kstep, voffA); PG8_STAGE(PG8_SB(1, 1), cB + hstep + kstep, voffB);
        PG8_WAIT_V(6); PG8_BAR;
    }
    for (;;) {
        const bool has_next = S.next(ui + 1, nxt);
        const char* nA = has_next ? (const char*)g.A + (size_t)nxt.pm * tstep : cA; const char* nB = has_next ? (const char*)g.Bt + (size_t)nxt.pn * tstep : cB;
        for (int t = 0; t < nt; t += 2) {
            const bool last = (t == nt - 2);
            const char* a1 = cA + PG8_KOFF(t) + kstep;
            const char* a2 = last ? nA : cA + PG8_KOFF(t + 2); const char* b2 = last ? nB : cB + (size_t)(t + 2) * kstep;
            const char* a3 = a2 + kstep; const char* b3 = b2 + kstep;
            if (last && has_next) S.a_ready(nxt);
            if constexpr (SP2) {
            PG8_LDB(B0, 0, 0); PG8_LDB(B1, 0, 1); PG8_SCHED; PG8_LDA(At, 0, 0); PG8_STAGE(PG8_SA(1, 1), a1 + hstepA, voffA);
            PG8_WAIT_V(8); PG8_WAIT_L(0); PG8_BAR; PG8_MMA(0, 0, At, B0); PG8_MMA(0, 1, At, B1); PG8_BAR; PG8_SCHED;
            PG8_LDA(At, 0, 1); PG8_STAGE(PG8_SB(0, 0), b2, voffB); PG8_STAGE(PG8_SB(0, 1), b2 + hstep, voffB); PG8_STAGE(PG8_SA(0, 0), a2, voffA);
            PG8_WAIT_V(8); PG8_WAIT_L(0); PG8_BAR; PG8_MMA(1, 0, At, B0); PG8_MMA(1, 1, At, B1); PG8_BAR; PG8_SCHED;
            PG8_LDB(B0, 1, 0); PG8_LDB(B1, 1, 1); PG8_SCHED; PG8_LDA(At, 1, 0); PG8_STAGE(PG8_SA(0, 1), a2 + hstepA, voffA);
            PG8_WAIT_V(8); PG8_WAIT_L(0); PG8_BAR; PG8_MMA(0, 0, At, B0); PG8_MMA(0, 1, At, B1); PG8_BAR; PG8_SCHED;
            PG8_LDA(At, 1, 1); PG8_STAGE(PG8_SB(1, 0), b3, voffB); PG8_STAGE(PG8_SB(1, 1), b3 + hstep, voffB); PG8_STAGE(PG8_SA(1, 0), a3, voffA);
            PG8_WAIT_V(8); PG8_WAIT_L(0); PG8_BAR; PG8_MMA(1, 0, At, B0); PG8_MMA(1, 1, At, B1); PG8_BAR; PG8_SCHED;
            } else {
            PG8_LDB(B0, 0, 0); PG8_SCHED; PG8_LDA(At, 0, 0); PG8_STAGE(PG8_SA(1, 1), a1 + hstepA, voffA);
            PG8_WAIT_L(8); PG8_BAR; PG8_WAIT_L(0); PG8_MMA(0, 0, At, B0); PG8_BAR; PG8_SCHED;
            PG8_LDB(B1, 0, 1); PG8_STAGE(PG8_SB(0, 0), b2, voffB);
            PG8_BAR; PG8_WAIT_L(0); PG8_MMA(0, 1, At, B1); PG8_BAR;
            PG8_LDA(At, 0, 1); PG8_STAGE(PG8_SA(0, 0), a2, voffA);
            PG8_BAR; PG8_WAIT_L(0); PG8_MMA(1, 0, At, B0); PG8_BAR; PG8_SCHED;
            PG8_STAGE(PG8_SB(0, 1), b2 + hstep, voffB);
            PG8_WAIT_V(6); PG8_BAR; PG8_MMA(1, 1, At, B1); PG8_BAR;
            PG8_LDB(B0, 1, 0); PG8_SCHED; PG8_LDA(At, 1, 0); PG8_STAGE(PG8_SA(0, 1), a2 + hstepA, voffA);
            PG8_WAIT_L(8); PG8_BAR; PG8_WAIT_L(0); PG8_MMA(0, 0, At, B0); PG8_BAR; PG8_SCHED;
            PG8_LDB(B1, 1, 1); PG8_STAGE(PG8_SB(1, 0), b3, voffB);
            PG8_BAR; PG8_WAIT_L(0); PG8_MMA(0, 1, At, B1); PG8_BAR;
            PG8_LDA(At, 1, 1); PG8_STAGE(PG8_SA(1, 0), a3, voffA);
            PG8_BAR; PG8_WAIT_L(0); PG8_MMA(1, 0, At, B0); PG8_BAR; PG8_SCHED;
            PG8_STAGE(PG8_SB(1, 1), b3 + hstep, voffB);
            PG8_WAIT_V(6); PG8_BAR; PG8_MMA(1, 1, At, B1); PG8_BAR;
            }
        }
        if constexpr (ALIGN_EPI) { if (wr == 0) PG8_BAR; }
        if constexpr (!Epi::AFTER_DRAIN) { E(acc, cur, wr, wc, fr, fq); S.done(cur); }
        if (!has_next) break;
#pragma unroll
        for (int a = 0; a < 2; ++a)
#pragma unroll
            for (int b = 0; b < 2; ++b)
#pragma unroll
                for (int m = 0; m < 4; ++m)
#pragma unroll
                    for (int n = 0; n < 2; ++n) acc[a][b][m][n] = (f32x4){0.f, 0.f, 0.f, 0.f};
        cur = nxt; cA = nA; cB = nB; ++ui;
        if constexpr (ALIGN_EPI) { if (wr == 1) PG8_BAR; }
    }
    PG8_WAIT_V(0);
    if constexpr (!ALIGN_EPI) { if (wr == 0) PG8_BAR; }
    PG8_BAR;
    if constexpr (Epi::AFTER_DRAIN) { E.fused(acc, cur, wr, wc, fr, fq, lds, wid, lane); S.done(cur); }
#undef PG8_SA
#undef PG8_KOFF
#undef PG8_SB
#undef PG8_STAGE
#undef PG8_LDA
#undef PG8_LDB
#undef PG8_MMA
#undef PG8_WAIT_V
#undef PG8_WAIT_L
#undef PG8_BAR
#undef PG8_SCHED
}
}
#ifndef PG8_SP2
#define PG8_SP2 true
#endif
#ifndef PG8_ALIGN
#define PG8_ALIGN true
#endif

constexpr int NWAVES = 8, NTHREADS = 512;
constexpr int MLPG = 4;
constexpr int NPHASE = 14 + 2 * MLPG;
#ifndef MK_N_LAUNCHES
#define MK_N_LAUNCHES 1
#endif
constexpr int N_LAUNCHES = MK_N_LAUNCHES;

constexpr int DM = 4096, NTOK = 32768, HTOK = 16384, INW = 11264, DFF = 16384, MEMW = 512, NMEM = 1536, HD = 128;
constexpr int RETW = 2048, QA_OFF = 8192, KA_OFF = 10240, VA_OFF = 10752;
constexpr float RMS_EPS = 1e-6f, LOG2E = 1.4426950408889634f;
constexpr int TBW = 264;

constexpr size_t MiB = 1u << 20;
constexpr size_t WS_CTL = 0, CTL_ZERO_BYTES = 1 * MiB;
constexpr size_t WS_COS = 1 * MiB, WS_SIN = 3 * MiB, WS_TB = 5 * MiB;
constexpr size_t WS_MEMN = 6 * MiB, WS_KVM = 18 * MiB;
constexpr size_t WS_WIN = 24 * MiB, WS_WOUT = 112 * MiB, WS_WCQ = 144 * MiB, WS_WCKV = 148 * MiB, WS_WCO = 156 * MiB, WS_W1 = 160 * MiB, WS_W2 = 288 * MiB;
constexpr size_t WS_XN = 416 * MiB;
constexpr size_t WS_R = 672 * MiB;
constexpr size_t WS_PROJ = WS_R, WS_Y = WS_R + 352 * MiB, WS_ST = WS_Y + 128 * MiB, WS_END = WS_ST + 128 * MiB;
constexpr size_t WS_QC = WS_R, WS_OC = WS_R + 32 * MiB;
constexpr size_t WS_HID = WS_R;
constexpr size_t WS_PROBE5 = WS_PROJ, WS_PROBE13 = WS_R + 64 * MiB, WS_PROBE15 = WS_WIN, WS_PROBE_SS = 896 * 1024;
static_assert(WS_HID + (size_t)HTOK * DFF * 2 <= WS_END && WS_END == 1280 * MiB, "d_ws map");
constexpr int CW_TMO = 0, CW_BAR = 4096;
constexpr int CW_BQ_HEAD = 8192, CW_ARR = 8192 + 64;
constexpr int BQ_I1 = (DM / 64) * (DFF / 32), BQ_I2 = (DFF / 64) * (DM / 32), BQ_ITEMS = BQ_I1 + BQ_I2;
constexpr size_t WS_SS = 512 * 1024;

constexpr int RING_OFF = 0, RING_BYTES = 131072;
constexpr int LDSCTL_OFF = RING_BYTES, MISC_OFF = LDSCTL_OFF + 320;
constexpr int TAB_OFF = LDSCTL_OFF + 1024;
constexpr int LDS_BYTES = 163840;
static_assert(TAB_OFF + 16 * TBW * 4 <= LDS_BYTES, "LDS map");

#define GAS __attribute__((address_space(1)))
#define LAS __attribute__((address_space(3)))
#define DI __device__ __forceinline__
typedef unsigned short bf16;
typedef unsigned v4u __attribute__((ext_vector_type(4)));
typedef unsigned v2u __attribute__((ext_vector_type(2)));
typedef float f32x4 __attribute__((ext_vector_type(4)));
typedef float f32x16 __attribute__((ext_vector_type(16)));
typedef short bf16x8 __attribute__((ext_vector_type(8)));
typedef short v4i16_t __attribute__((ext_vector_type(4)));
typedef GAS unsigned gu32;
#define RLX_AGENT __ATOMIC_RELAXED, __HIP_MEMORY_SCOPE_AGENT
#define LDS_WAIT() asm volatile("s_waitcnt lgkmcnt(0)" ::: "memory")
#define VM_WAIT() asm volatile("s_waitcnt vmcnt(0)" ::: "memory")
DI unsigned f2bf(float f) { unsigned u = __builtin_bit_cast(unsigned, f); return (u + 0x7fffu + ((u >> 16) & 1u)) >> 16; }
DI unsigned pk2(float lo, float hi) { return pg8::cvt_pk_bf16(lo, hi); }
DI float bflo(unsigned w) { return __uint_as_float(w << 16); }
DI float bfhi(unsigned w) { return __uint_as_float(w & 0xffff0000u); }
DI float ex2(float x) { return __builtin_amdgcn_exp2f(x); }
#define XB_TMO      128
#define XB_XCNT(j)  (256  + 64 * (j))
#define XB_XSUB(j)  (1280 + 64 * (j))
#define XB_XGEN(j)  (2304 + 64 * (j))
#define XB_TOP      3328
#define XB_TOPGEN   3392
#define XCD_BAR_WORDS 3456
#define XB_SPIN_CAP (1u << 18)

__device__ __forceinline__ unsigned xb_ld(unsigned* p)              { return __hip_atomic_load(p, __ATOMIC_RELAXED, __HIP_MEMORY_SCOPE_AGENT); }
__device__ __forceinline__ unsigned xb_add(unsigned* p, unsigned v) { return __hip_atomic_fetch_add(p, v, __ATOMIC_RELAXED, __HIP_MEMORY_SCOPE_AGENT); }
__device__ __forceinline__ unsigned xb_xcc_id() { return (unsigned)__builtin_amdgcn_s_getreg((3 << 11) | 20) & 0xFu; }
#define XB_SPIN(cond, bar) do { unsigned _sp = 0; while (cond) { __builtin_amdgcn_s_sleep(1); \
    if ((++_sp & 255u) == 0u) { if (xb_ld(&(bar)[XB_TMO])) break; if (_sp > XB_SPIN_CAP) { atomicAdd(&(bar)[XB_TMO], 1u); break; } } } } while (0)

struct XcdBarrier {
    unsigned* bar; unsigned x;
    volatile LAS unsigned* st;
};

__device__ __forceinline__ XcdBarrier xcd_barrier_post(unsigned* bar, volatile LAS unsigned* st) {
    XcdBarrier b; b.bar = bar; b.x = xb_xcc_id(); b.st = st;
    if (threadIdx.x == 0) (void)xb_add(&bar[XB_XCNT(b.x)], 1u);
    return b;
}
__device__ __forceinline__ void xcd_barrier_complete(unsigned* bar, unsigned x, unsigned& nloc, unsigned& nx) {
    const unsigned G = gridDim.x * gridDim.y * gridDim.z;
    unsigned sum, cnt, mine, sp = 0u;
    for (;;) {
        sum = 0u; cnt = 0u; mine = 0u;
#pragma unroll
        for (unsigned j = 0; j < 16; ++j) { const unsigned c = xb_ld(&bar[XB_XCNT(j)]); sum += c; cnt += (c > 0u) ? 1u : 0u; mine = (j == x) ? c : mine; }
        if (sum == G) break;
        __builtin_amdgcn_s_sleep(1);
        if ((++sp & 255u) == 0u) { if (xb_ld(&bar[XB_TMO])) break; if (sp > XB_SPIN_CAP) { atomicAdd(&bar[XB_TMO], 1u); break; } }
    }
    nloc = mine > 0u ? mine : 1u; nx = cnt > 0u ? cnt : 1u;
}

__device__ __forceinline__ void xcd_barrier(const XcdBarrier& b) {
    asm volatile("s_waitcnt vmcnt(0)" ::: "memory");
    __syncthreads();
    if (threadIdx.x == 0) {
        unsigned* bar = b.bar;
        __builtin_amdgcn_s_waitcnt(0);
        unsigned nloc = b.st[0], nx = b.st[1];
        if (nloc == 0u) { xcd_barrier_complete(bar, b.x, nloc, nx); b.st[0] = nloc; b.st[1] = nx; }
        const unsigned old = xb_add(&bar[XB_XSUB(b.x)], 1u);
        const unsigned gen = old / nloc;
        if (old + 1u == (gen + 1u) * nloc) {
            __builtin_amdgcn_fence(__ATOMIC_RELEASE, "agent");
            asm volatile("s_waitcnt vmcnt(0)" ::: "memory");
            const unsigned og = xb_add(&bar[XB_TOP], 1u);
            const unsigned tg = og / nx;
            if (og + 1u == (tg + 1u) * nx) xb_add(&bar[XB_TOPGEN], 1u);
            else XB_SPIN(xb_ld(&bar[XB_TOPGEN]) == tg, bar);
            __builtin_amdgcn_fence(__ATOMIC_ACQUIRE, "agent");
            xb_add(&bar[XB_XGEN(b.x)], 1u);
            asm volatile("s_waitcnt vmcnt(0)" ::: "memory");
        } else {
            XB_SPIN(xb_ld(&bar[XB_XGEN(b.x)]) == gen, bar);
            __builtin_amdgcn_fence(__ATOMIC_ACQUIRE, "agent");
            asm volatile("s_waitcnt vmcnt(0)" ::: "memory");
        }
    }
    __syncthreads();
}

DI float wave_sum(float v) {
#pragma unroll
    for (int o = 1; o < 64; o <<= 1) v += __shfl_xor(v, o);
    return v;
}
template <bool ROPEPERM>
DI void p0_transpose_item(const float* W, int K, int N, bf16* WT, LAS float* scr, int item, int lane, const float* gain = nullptr) {
    const int nblk = N / 32, kb = item / nblk, nb = item % nblk, k0 = 64 * kb, n0 = 32 * nb;
    int ncol = n0 + (lane & 31);
    if (ROPEPERM && ncol < 4096) { const int o = ncol & 127; ncol = (ncol & ~127) + (o >> 1) + 64 * (o & 1); }
    float wv[32];
#pragma unroll
    for (int i = 0; i < 32; ++i) { const int kk = 2 * i + (lane >> 5); wv[i] = W[(size_t)(k0 + kk) * N + ncol]; }
    if (gain) {
#pragma unroll
        for (int i = 0; i < 32; ++i) wv[i] *= gain[k0 + 2 * i + (lane >> 5)]; }
#pragma unroll
    for (int i = 0; i < 32; ++i) { const int kk = 2 * i + (lane >> 5); scr[kk * 33 + (lane & 31)] = wv[i]; }
    LDS_WAIT(); asm volatile("" ::: "memory");
    const int c = lane & 7;
#pragma unroll
    for (int j = 0; j < 4; ++j) { const int n = (lane >> 3) + 8 * j; const LAS float* s = scr + (8 * c) * 33 + n;
        v4u o; o.x = pk2(s[0 * 33], s[1 * 33]); o.y = pk2(s[2 * 33], s[3 * 33]); o.z = pk2(s[4 * 33], s[5 * 33]); o.w = pk2(s[6 * 33], s[7 * 33]);
        *(GAS v4u*)(WT + (size_t)(n0 + n) * K + k0 + 8 * c) = o; }
    LDS_WAIT(); asm volatile("" ::: "memory");
}
DI void rms_row_to_bf16(const float* xrow, const float* gain, bf16* orow, int lane) {
    const GAS f32x4* xr = (const GAS f32x4*)xrow + lane;
    f32x4 v[16]; float s = 0.f;
#pragma unroll
    for (int j = 0; j < 16; ++j) { v[j] = xr[64 * j]; s += (v[j].x * v[j].x + v[j].y * v[j].y) + (v[j].z * v[j].z + v[j].w * v[j].w); }
    const float rstd = 1.0f / sqrtf(wave_sum(s) * (1.f / DM) + RMS_EPS);
    const GAS f32x4* gr = (const GAS f32x4*)gain + lane;
    GAS v2u* o8 = (GAS v2u*)orow + lane;
#pragma unroll
    for (int j = 0; j < 16; ++j) { const f32x4 g = gr[64 * j]; v2u w; w.x = pk2(v[j].x * rstd * g.x, v[j].y * rstd * g.y); w.y = pk2(v[j].z * rstd * g.z, v[j].w * rstd * g.w); o8[64 * j] = w; }
}
DI void final_row(const bf16* xrow, float ssrow, const float* gain, float* orow, int lane, bool poison) {
    float rstd = __builtin_amdgcn_rsqf(ssrow * (1.f / DM) + RMS_EPS);
    if (poison) rstd = __builtin_nanf("");
    const GAS v2u* xr = (const GAS v2u*)xrow + lane; const GAS f32x4* gr = (const GAS f32x4*)gain + lane; GAS f32x4* o = (GAS f32x4*)orow + lane;
    v2u v[16];
#pragma unroll
    for (int j = 0; j < 16; ++j) v[j] = xr[64 * j];
#pragma unroll
    for (int j = 0; j < 16; ++j) { const f32x4 g0 = gr[64 * j];
        o[64 * j] = (f32x4){bflo(v[j].x) * rstd * g0.x, bfhi(v[j].x) * rstd * g0.y, bflo(v[j].y) * rstd * g0.z, bfhi(v[j].y) * rstd * g0.w}; }
}

#define MFMA32(a, b, c) __builtin_amdgcn_mfma_f32_32x32x16_bf16((a), (b), (c), 0, 0, 0)
DI int crow(int reg, int h) { return (reg & 3) + 8 * (reg >> 2) + 4 * h; }
DI unsigned off_b(unsigned row, unsigned ch) { return 256u * row + 16u * (ch ^ (((row & 3u) << 2) | ((row >> 2) & 3u))); }
DI bf16x8 row_frag(const LAS unsigned char* img, int rowbase, int lane, int ks) { return *(const LAS bf16x8*)(img + off_b(rowbase + (lane & 31), 2 * ks + (lane >> 5))); }
DI v4i16_t tr4(const LAS unsigned char* p) { return __builtin_amdgcn_ds_read_tr16_b64_v4i16((LAS v4i16_t*)p); }
DI bf16x8 tr_frag_nat(const LAS unsigned char* img, int rowbase, int lane, int c, int ks) {
    const unsigned h = lane >> 5, blk = (lane >> 4) & 1, q = (lane & 15) >> 2, p = lane & 3;
    const unsigned r0 = rowbase + 16 * ks + 8 * h + q, ch = 4 * c + 2 * blk + (p >> 1);
    const v4i16_t lo = tr4(img + off_b(r0, ch) + 8 * (p & 1)), hi = tr4(img + off_b(r0 + 4, ch) + 8 * (p & 1));
    return __builtin_shufflevector(lo, hi, 0, 1, 2, 3, 4, 5, 6, 7);
}
DI bf16x8 tr_frag_perm(const LAS unsigned char* img, int rowbase, int lane, int c, int s) {
    const unsigned h = lane >> 5, blk = (lane >> 4) & 1, q = (lane & 15) >> 2, p = lane & 3;
    const unsigned r0 = rowbase + 16 * s + 4 * h + q, ch = 4 * c + 2 * blk + (p >> 1);
    const v4i16_t lo = tr4(img + off_b(r0, ch) + 8 * (p & 1)), hi = tr4(img + off_b(r0 + 8, ch) + 8 * (p & 1));
    return __builtin_shufflevector(lo, hi, 0, 1, 2, 3, 4, 5, 6, 7);
}
template <int S> DI bf16x8 pack_step(const f32x16& x) {
    v4u p; p.x = pk2(x[8 * S], x[8 * S + 1]); p.y = pk2(x[8 * S + 2], x[8 * S + 3]); p.z = pk2(x[8 * S + 4], x[8 * S + 5]); p.w = pk2(x[8 * S + 6], x[8 * S + 7]);
    return __builtin_bit_cast(bf16x8, p);
}
DI void ret_scan(bf16* ST, int nseq, int nchunk, const float* dec_f, const float* dec_b, int gtid, int nthreads) {
    const int ntask = nseq * 32 * 2048;
    for (int task = gtid; task < ntask; task += nthreads) {
        const int chain = task >> 11, eo = (task & 2047) * 8, seq = chain >> 5, hh = (chain >> 1) & 15, dir = chain & 1;
        const float lg = -expf(dir ? dec_b[hh] : dec_f[hh]), cd = ex2(128.f * lg * LOG2E);
        float s[8];
#pragma unroll
        for (int e = 0; e < 8; ++e) s[e] = 0.f;
        const ptrdiff_t cstride = (ptrdiff_t)16 * 2 * 16384 * (dir ? -1 : 1);
        bf16* p = ST + ((size_t)((seq * nchunk + (dir ? nchunk - 1 : 0)) * 16 + hh) * 2 + dir) * 16384 + eo;
        for (int cc = 0; cc < nchunk; cc += 8) {
            v4u v[8];
#pragma unroll
            for (int u = 0; u < 8; ++u) v[u] = *(const GAS v4u*)(p + u * cstride);
#pragma unroll
            for (int u = 0; u < 8; ++u) {
                v4u o; o.x = pk2(s[0], s[1]); o.y = pk2(s[2], s[3]); o.z = pk2(s[4], s[5]); o.w = pk2(s[6], s[7]);
                *(GAS v4u*)(p + u * cstride) = o;
                s[0] = s[0] * cd + bflo(v[u].x); s[1] = s[1] * cd + bfhi(v[u].x); s[2] = s[2] * cd + bflo(v[u].y); s[3] = s[3] * cd + bfhi(v[u].y);
                s[4] = s[4] * cd + bflo(v[u].z); s[5] = s[5] * cd + bfhi(v[u].z); s[6] = s[6] * cd + bflo(v[u].w); s[7] = s[7] * cd + bfhi(v[u].w);
            }
            p += 8 * cstride;
        }
    }
}
#define PJ(base, cb, row) ((base) + ((size_t)(cb) * HTOK + (size_t)(row)) * HD)
DI void tile_load(v4u (&r)[4], const bf16* g, size_t pitch, int tid) {
#pragma unroll
    for (int i = 0; i < 4; ++i) { const int n = tid + 512 * i, row = n >> 4, ch = n & 15; r[i] = *(const GAS v4u*)(g + (size_t)row * pitch + ch * 8); }
}
DI void tile_write(LAS unsigned char* img, const v4u (&r)[4], int tid) {
#pragma unroll
    for (int i = 0; i < 4; ++i) { const int n = tid + 512 * i, row = n >> 4, ch = n & 15; *(LAS v4u*)(img + off_b(row, ch)) = r[i]; }
}
DI void tile_write_scaled(LAS unsigned char* img, const v4u (&r)[4], int tid, float a, float b) {
#pragma unroll
    for (int i = 0; i < 4; ++i) { const int n = tid + 512 * i, row = n >> 4, ch = n & 15; const v4u v = r[i]; const float sc = ex2(a + b * (float)row);
        v4u o; o.x = pk2(bflo(v.x) * sc, bfhi(v.x) * sc); o.y = pk2(bflo(v.y) * sc, bfhi(v.y) * sc); o.z = pk2(bflo(v.z) * sc, bfhi(v.z) * sc); o.w = pk2(bflo(v.w) * sc, bfhi(v.w) * sc);
        *(LAS v4u*)(img + off_b(row, ch)) = o; }
}

template <bool WIN, int g>
DI void attn_phase(LAS unsigned char* L, const bf16* QB, const bf16* KB, const bf16* VB, bf16* OB, const float* TB, const float* sink, int tid, const int u_begin, const int G, const int NU) {
    constexpr int nbs = g ? 64 : 32;
    constexpr size_t qpitch = WIN ? HD : MEMW, kvpitch = WIN ? HD : 2 * MEMW, opitch = WIN ? DM : MEMW;
    const int lane0 = tid & 63, wave = __builtin_amdgcn_readfirstlane(tid >> 6);
    LAS float* const tb = (LAS float*)(L + TAB_OFF);
    if (WIN) for (int e = tid; e < 16 * TBW; e += NTHREADS) tb[e] = TB[e];
    int u = u_begin; if (u >= NU) return;
    int lo, hi, dk;
#define ATT_RANGE(uu, lo_, hi_) do { if (WIN) { const int nb_ = ((uu) >> 3) % nbs; lo_ = nb_ == 0 ? 0 : -1; hi_ = nb_ == nbs - 1 ? 1 : 2; } else { lo_ = 0; hi_ = 2; } } while (0)
#define ATT_KROW(uu, dd) (WIN ? (size_t)((((uu) & 7) >> 1) * HTOK + ((uu) >> 3) * 128 + (dd) * 128) : (size_t)(((((uu) >> 2) * 256) < HTOK ? ((((uu) >> 2) * 256) >> 12) * 256 : 1024 + (((((uu) >> 2) * 256) - HTOK) >> 13) * 256) + (dd) * 128))
#define ATT_KCOL(uu) (WIN ? 0 : ((uu) & 3) * HD)
    ATT_RANGE(u, lo, hi); dk = lo;
    v4u rk[4], rv[4];
    tile_load(rk, KB + ATT_KROW(u, dk) * kvpitch + ATT_KCOL(u), kvpitch, tid); tile_load(rv, VB + ATT_KROW(u, dk) * kvpitch + ATT_KCOL(u), kvpitch, tid);
    tile_write(L, rk, tid); tile_write(L + 32768, rv, tid);
    int un = u, dkn = dk + 1, lon = lo, hin = hi;
    if (dkn == hin) { un = u + G; if (un < NU) { ATT_RANGE(un, lon, hin); dkn = lon; } }
    if (un < NU) { tile_load(rk, KB + ATT_KROW(un, dkn) * kvpitch + ATT_KCOL(un), kvpitch, tid); tile_load(rv, VB + ATT_KROW(un, dkn) * kvpitch + ATT_KCOL(un), kvpitch, tid); }
    bf16x8 qf[8]; f32x16 o[4]; float m = 0.f, l = 0.f;
    int b = 0;
    for (;;) {
        int lane = lane0; asm volatile("" : "+v"(lane));
        const int r = lane & 31, h = lane >> 5;
        __syncthreads();
        LAS unsigned char* const imgK = L + b * 65536; LAS unsigned char* const imgV = imgK + 32768;
        const int qrow = WIN ? (u >> 3) * 128 + 32 * (wave & 3) : (u >> 2) * 256 + 32 * wave;
        const int qcol = WIN ? 0 : (u & 3) * HD;
        if (dk == lo) {
            const bf16* qptr = WIN ? PJ(QB, 64 + 2 * (u & 7) + (wave >> 2), qrow) : QB + (size_t)qrow * qpitch + qcol;
#pragma unroll
            for (int ks = 0; ks < 8; ++ks) qf[ks] = *(const GAS bf16x8*)(qptr + (size_t)r * qpitch + 16 * ks + 8 * h);
#pragma unroll
            for (int c = 0; c < 4; ++c)
#pragma unroll
                for (int i = 0; i < 16; ++i) o[c][i] = 0.f;
            if (WIN) { m = sink[2 * (u & 7) + (wave >> 2)] * LOG2E; l = 1.0f; } else { m = -1e30f; l = 0.f; }
        }
        const LAS float* const tbh = tb + (2 * (u & 7) + (wave >> 2)) * TBW;
        const int iq = 32 * (wave & 3) + r;
#pragma unroll
        for (int kh = 0; kh < 2; ++kh) {
            f32x16 st[2];
#pragma unroll
            for (int kt = 0; kt < 2; ++kt) {
#pragma unroll
                for (int i = 0; i < 16; ++i) st[kt][i] = 0.f;
#pragma unroll
                for (int ks = 0; ks < 8; ++ks) st[kt] = MFMA32(row_frag(imgK, 64 * kh + 32 * kt, lane, ks), qf[ks], st[kt]);
            }
            if (WIN) {
                const int relb = 128 * dk - iq + 128 + 64 * kh;
#pragma unroll
                for (int kt = 0; kt < 2; ++kt)
#pragma unroll
                    for (int i = 0; i < 16; ++i) { const int idx = relb + 32 * kt + crow(i, h); const bool ok = (unsigned)idx <= 256u;
                        const float bias = tbh[ok ? idx : 0]; st[kt][i] = ok ? st[kt][i] + bias : -1e30f; }
            }
            float mx = st[0][0];
#pragma unroll
            for (int kt = 0; kt < 2; ++kt)
#pragma unroll
                for (int i = 0; i < 16; ++i) mx = fmaxf(mx, st[kt][i]);
            mx = fmaxf(mx, __shfl_xor(mx, 32));
            const float mnew = fmaxf(m, mx), alpha = ex2(m - mnew); m = mnew;
            float rs = 0.f;
#pragma unroll
            for (int kt = 0; kt < 2; ++kt)
#pragma unroll
                for (int i = 0; i < 16; ++i) { const float p = ex2(st[kt][i] - mnew); st[kt][i] = p; rs += p; }
            rs += __shfl_xor(rs, 32);
            l = l * alpha + rs;
#pragma unroll
            for (int c = 0; c < 4; ++c)
#pragma unroll
                for (int i = 0; i < 16; ++i) o[c][i] *= alpha;
#pragma unroll
            for (int kt = 0; kt < 2; ++kt) {
                const bf16x8 p0 = pack_step<0>(st[kt]), p1 = pack_step<1>(st[kt]);
#pragma unroll
                for (int c = 0; c < 4; ++c) { o[c] = MFMA32(tr_frag_perm(imgV, 64 * kh + 32 * kt, lane, c, 0), p0, o[c]); o[c] = MFMA32(tr_frag_perm(imgV, 64 * kh + 32 * kt, lane, c, 1), p1, o[c]); }
            }
        }
        if (dk == hi - 1) {
            const float inv = 1.0f / l;
            bf16* optr = OB + (size_t)qrow * opitch + (WIN ? RETW + (2 * (u & 7) + (wave >> 2)) * HD : (u & 3) * HD);
#pragma unroll
            for (int c = 0; c < 4; ++c)
#pragma unroll
                for (int m2 = 0; m2 < 2; ++m2) {
                    v2u wa, wb; const int ga = 2 * m2, gb = 2 * m2 + 1;
                    wa.x = pk2(o[c][4 * ga] * inv, o[c][4 * ga + 1] * inv); wa.y = pk2(o[c][4 * ga + 2] * inv, o[c][4 * ga + 3] * inv);
                    wb.x = pk2(o[c][4 * gb] * inv, o[c][4 * gb + 1] * inv); wb.y = pk2(o[c][4 * gb + 2] * inv, o[c][4 * gb + 3] * inv);
                    const v2u sx = __builtin_amdgcn_permlane32_swap(wa.x, wb.x, false, false), sy = __builtin_amdgcn_permlane32_swap(wa.y, wb.y, false, false);
                    v4u w; w.x = sx.x; w.y = sy.x; w.z = sx.y; w.w = sy.y;
                    *(GAS v4u*)(optr + (size_t)r * opitch + 32 * c + 16 * m2 + 8 * h) = w; }
        }
        if (un >= NU) break;
        tile_write(L + (b ^ 1) * 65536, rk, tid); tile_write(L + (b ^ 1) * 65536 + 32768, rv, tid);
        u = un; dk = dkn; lo = lon; hi = hin; b ^= 1;
        dkn = dk + 1;
        if (dkn == hin) { un = u + G; if (un < NU) { ATT_RANGE(un, lon, hin); dkn = lon; } }
        if (un < NU) { tile_load(rk, KB + ATT_KROW(un, dkn) * kvpitch + ATT_KCOL(un), kvpitch, tid); tile_load(rv, VB + ATT_KROW(un, dkn) * kvpitch + ATT_KCOL(un), kvpitch, tid); }
    }
#undef ATT_RANGE
#undef ATT_KROW
#undef ATT_KCOL
}

DI void ret_kv_phase(LAS unsigned char* L, const bf16* PROJ, bf16* ST, const float* dec_f, const float* dec_b, int tid, int G) {
    constexpr int NU = 2048;
    const int lane0 = tid & 63, w = __builtin_amdgcn_readfirstlane(tid >> 6);
    int u = blockIdx.x; if (u >= NU) return;
    v4u rk[4], rv[4];
    { tile_load(rk, PJ(PROJ, 16 + (u & 15), (u >> 4) * 128), HD, tid); tile_load(rv, PJ(PROJ, 32 + (u & 15), (u >> 4) * 128), HD, tid); }
    for (;;) {
        int lane = lane0; asm volatile("" : "+v"(lane)); const int r = lane & 31, h = lane >> 5;
        const int hh = u & 15, c = u >> 4;
        const float lf2 = -expf(dec_f[hh]) * LOG2E, lb2 = -expf(dec_b[hh]) * LOG2E;
        __syncthreads();
        tile_write(L, rv, tid);
        tile_write_scaled(L + 32768, rk, tid, 127.f * lf2, -lf2);
        tile_write_scaled(L + 65536, rk, tid, 0.f, lb2);
        __syncthreads();
        const int un = u + G;
        if (un < NU) { tile_load(rk, PJ(PROJ, 16 + (un & 15), (un >> 4) * 128), HD, tid); tile_load(rv, PJ(PROJ, 32 + (un & 15), (un >> 4) * 128), HD, tid); }
        const int dir = w & 1, ce = w >> 1;
        const LAS unsigned char* imgK = L + 32768 + dir * 32768;
        f32x16 acc[4];
#pragma unroll
        for (int cc = 0; cc < 4; ++cc)
#pragma unroll
            for (int i = 0; i < 16; ++i) acc[cc][i] = 0.f;
#pragma unroll
        for (int ks = 0; ks < 8; ++ks) { const bf16x8 bfr = tr_frag_nat(L, 0, lane, ce, ks);
#pragma unroll
            for (int cd = 0; cd < 4; ++cd) acc[cd] = MFMA32(tr_frag_nat(imgK, 0, lane, cd, ks), bfr, acc[cd]); }
        bf16* dst = ST + ((size_t)(c * 16 + hh) * 2 + dir) * 16384 + (size_t)(32 * ce + r) * 128 + 4 * h;
#pragma unroll
        for (int cd = 0; cd < 4; ++cd)
#pragma unroll
            for (int g4 = 0; g4 < 4; ++g4) { v2u x; x.x = pk2(acc[cd][4 * g4], acc[cd][4 * g4 + 1]); x.y = pk2(acc[cd][4 * g4 + 2], acc[cd][4 * g4 + 3]); *(GAS v2u*)(dst + 32 * cd + 8 * g4) = x; }
        if (un >= NU) break;
        u = un;
    }
}

DI void ret_out_phase(LAS unsigned char* L, const bf16* PROJ, bf16* Y, const bf16* ST, const float* dec_f, const float* dec_b, int tid, int G) {
    constexpr int NU = 2048;
    const int lane0 = tid & 63, w = __builtin_amdgcn_readfirstlane(tid >> 6);
    LAS float* const part = (LAS float*)(L + TAB_OFF);
    LAS unsigned char* const A0 = L; LAS unsigned char* const A1 = L + 32768; LAS unsigned char* const B0 = L + 65536; LAS unsigned char* const B1 = L + 98304;
    int u = blockIdx.x; if (u >= NU) return;
    v4u ra[4], rb[4];
#define RO_LOAD_A(uu) do { tile_load(ra, PJ(PROJ, 16 + ((uu) & 15), ((uu) >> 4) * 128), HD, tid); tile_load(rb, PJ(PROJ, 32 + ((uu) & 15), ((uu) >> 4) * 128), HD, tid); } while (0)
#define RO_LOAD_B(uu) do { const bf16* stp_ = ST + (size_t)(uu) * 2 * 16384; tile_load(ra, stp_, 128, tid); tile_load(rb, stp_ + 16384, 128, tid); } while (0)
    RO_LOAD_A(u);
    tile_write(A0, ra, tid); tile_write(A1, rb, tid);
    RO_LOAD_B(u);
    const int eh = w >> 2;
    f32x16 y[2]; v2u gv[8];
    int fin_u = -1;
#define RO_FINAL() do { const float tot_ = part[w * 32 + r] + part[(w ^ 4) * 32 + r]; const float rstd_ = __builtin_amdgcn_rsqf(tot_ * (1.f / 128.f) + RMS_EPS); \
        bf16* yg_ = Y + (size_t)((fin_u >> 4) * 128 + i) * DM + (fin_u & 15) * HD; \
        _Pragma("unroll") for (int c2 = 0; c2 < 2; ++c2) _Pragma("unroll") for (int m2 = 0; m2 < 2; ++m2) { v2u xs[2]; \
            _Pragma("unroll") for (int q2 = 0; q2 < 2; ++q2) { const int g4 = 2 * m2 + q2; const v2u gq = gv[c2 * 4 + g4]; \
                xs[q2].x = pk2(y[c2][4 * g4] * rstd_ * bflo(gq.x), y[c2][4 * g4 + 1] * rstd_ * bfhi(gq.x)); xs[q2].y = pk2(y[c2][4 * g4 + 2] * rstd_ * bflo(gq.y), y[c2][4 * g4 + 3] * rstd_ * bfhi(gq.y)); } \
              \
            const v2u sx_ = __builtin_amdgcn_permlane32_swap(xs[0].x, xs[1].x, false, false), sy_ = __builtin_amdgcn_permlane32_swap(xs[0].y, xs[1].y, false, false); \
            v4u x4; x4.x = sx_.x; x4.y = sy_.x; x4.z = sx_.y; x4.w = sy_.y; \
            *(GAS v4u*)(yg_ + 32 * (2 * eh + c2) + 16 * m2 + 8 * h) = x4; } } while (0)
    for (;;) {
        const int un = u + G;
        int lane = lane0; asm volatile("" : "+v"(lane));
        const int r = lane & 31, h = lane >> 5, i = 32 * (w & 3) + r;
        __syncthreads();
        if (fin_u >= 0) RO_FINAL();
        const int hh = u & 15;
        const float lf2 = -expf(dec_f[hh]) * LOG2E, lb2 = -expf(dec_b[hh]) * LOG2E;
        bf16x8 qf[8];
        { const bf16* qg = PJ(PROJ, hh, (u >> 4) * 128 + i);
#pragma unroll
          for (int ks = 0; ks < 8; ++ks) qf[ks] = *(const GAS bf16x8*)(qg + 16 * ks + 8 * h); }
#pragma unroll
        for (int c2 = 0; c2 < 2; ++c2)
#pragma unroll
            for (int q = 0; q < 16; ++q) y[c2][q] = 0.f;
#pragma unroll
        for (int jt = 0; jt < 4; ++jt) {
            f32x16 st;
#pragma unroll
            for (int q = 0; q < 16; ++q) st[q] = 0.f;
#pragma unroll
            for (int ks = 0; ks < 8; ++ks) st = MFMA32(row_frag(A0, 32 * jt, lane, ks), qf[ks], st);
#pragma unroll
            for (int q = 0; q < 16; ++q) { const int d = i - (32 * jt + crow(q, h)); const float f = ex2((float)d * (d >= 0 ? lf2 : -lb2)); st[q] *= f; }
            const bf16x8 p0 = pack_step<0>(st), p1 = pack_step<1>(st);
#pragma unroll
            for (int c2 = 0; c2 < 2; ++c2) { y[c2] = MFMA32(tr_frag_perm(A1, 32 * jt, lane, 2 * eh + c2, 0), p0, y[c2]); y[c2] = MFMA32(tr_frag_perm(A1, 32 * jt, lane, 2 * eh + c2, 1), p1, y[c2]); }
        }
        tile_write(B0, ra, tid); tile_write(B1, rb, tid);
        if (un < NU) RO_LOAD_A(un);
        { const bf16* gg = PJ(PROJ, 48 + hh, (u >> 4) * 128 + i);
#pragma unroll
          for (int c2 = 0; c2 < 2; ++c2)
#pragma unroll
              for (int g4 = 0; g4 < 4; ++g4) gv[c2 * 4 + g4] = *(const GAS v2u*)(gg + 32 * (2 * eh + c2) + 8 * g4 + 4 * h); }
        __syncthreads();
        {
            const float xf = ex2((float)(i + 1) * lf2), xb = ex2((float)(128 - i) * lb2);
            f32x16 cc[2];
#pragma unroll
            for (int c2 = 0; c2 < 2; ++c2)
#pragma unroll
                for (int q = 0; q < 16; ++q) cc[c2][q] = 0.f;
#pragma unroll
            for (int ks = 0; ks < 8; ++ks)
#pragma unroll
                for (int c2 = 0; c2 < 2; ++c2) cc[c2] = MFMA32(row_frag(B0, 32 * (2 * eh + c2), lane, ks), qf[ks], cc[c2]);
#pragma unroll
            for (int c2 = 0; c2 < 2; ++c2)
#pragma unroll
                for (int q = 0; q < 16; ++q) { y[c2][q] += xf * cc[c2][q]; cc[c2][q] = 0.f; }
            __builtin_amdgcn_sched_barrier(0);
#pragma unroll
            for (int ks = 0; ks < 8; ++ks)
#pragma unroll
                for (int c2 = 0; c2 < 2; ++c2) cc[c2] = MFMA32(row_frag(B1, 32 * (2 * eh + c2), lane, ks), qf[ks], cc[c2]);
            float ss = 0.f;
#pragma unroll
            for (int c2 = 0; c2 < 2; ++c2)
#pragma unroll
                for (int q = 0; q < 16; ++q) { const float v = y[c2][q] + xb * cc[c2][q]; y[c2][q] = v; ss += v * v; }
            ss += __shfl_xor(ss, 32);
            if (h == 0) part[w * 32 + r] = ss;
            fin_u = u;
        }
        if (un >= NU) break;
        tile_write(A0, ra, tid); tile_write(A1, rb, tid);
        RO_LOAD_B(un);
        u = un;
    }
    { const int lane = lane0, r = lane & 31, h = lane >> 5, i = 32 * (w & 3) + r; __syncthreads(); RO_FINAL(); }
#undef RO_LOAD_A
#undef RO_LOAD_B
#undef RO_FINAL
}
struct Args { const float* in[20]; float* out; unsigned char* ws; int ph_lo, ph_hi, li, pad; };
DI int t5_bucket(int rel) {
    const int n = rel < 0 ? -rel : rel;
    const int b = n < 8 ? n : n < 12 ? 8 : n < 16 ? 9 : n < 23 ? 10 : n < 32 ? 11 : n < 46 ? 12 : n < 64 ? 13 : n < 91 ? 14 : 15;
    return b + (rel > 0 ? 16 : 0);
}

#define PH_BEGIN() int tid = threadIdx.x; asm volatile("" : "+v"(tid)); GAS unsigned char* wsg_ = (GAS unsigned char*)args.ws; asm volatile("" : "+s"(wsg_)); unsigned char* ws = (unsigned char*)wsg_;   \
    LAS unsigned char* const L = (LAS unsigned char*)lds; const int lane = tid & 63, wave = __builtin_amdgcn_readfirstlane(tid >> 6), G = gridDim.x; \
    const int vcu = (G % 8 == 0) ? ((int)blockIdx.x % 8) * (G / 8) + (int)blockIdx.x / 8 : (int)blockIdx.x; (void)lane; (void)wave; (void)vcu; (void)L
#ifndef PROBE_BARMASK
#define PROBE_BARMASK 0x3ffff
#endif
#define GRID_BAR(id) do { if (N_LAUNCHES == 1) { GAS unsigned* bpg_ = (GAS unsigned*)(args.ws + WS_CTL) + CW_BAR; asm volatile("" : "+s"(bpg_)); unsigned* bp_ = (unsigned*)bpg_; XcdBarrier b_; b_.bar = bp_; b_.x = xb_xcc_id(); \
    b_.st = (volatile LAS unsigned*)((LAS unsigned char*)lds + MISC_OFF) + 8; unsigned long long t0_ = 0; if (PROBE_KIND == 1 && (((PROBE_BARMASK) >> (id)) & 1) && threadIdx.x == 0) t0_ = __builtin_amdgcn_s_memrealtime(); xcd_barrier(b_); if (NREP(19) > 1) xcd_barrier(b_); if (PROBE_KIND == 1 && (((PROBE_BARMASK) >> (id)) & 1) && threadIdx.x == 0) atomicAdd((unsigned long long*)(args.ws + WS_TS), (unsigned long long)(__builtin_amdgcn_s_memrealtime() - t0_)); } } while (0)
#ifndef REPMASK
#define REPMASK 0
#endif
#ifndef PROBE_KIND
#define PROBE_KIND 0
#endif
#ifndef PROBE_K
#define PROBE_K 4
#endif
#ifndef PROBE_PHMASK
#define PROBE_PHMASK 0
#endif
#define WS_TS (960 * 1024)
#define NREP(k) ((((REPMASK) >> (k)) & 1) ? 2 : 1)
#ifndef PHMASK
#define PHMASK 0x3ffffff
#endif
#define IN(k) ((((PHMASK) >> (k)) & 1) && lo <= (k) && (k) < hi)
#define SPAN_T0(k) unsigned long long sp0_ = 0; if (PROBE_KIND == 2 && (((PROBE_PHMASK) >> (k)) & 1) && blockIdx.x == 0 && threadIdx.x == 0) sp0_ = __builtin_amdgcn_s_memrealtime()
#define SPAN_T1(k) do { if (PROBE_KIND == 2 && (((PROBE_PHMASK) >> (k)) & 1) && blockIdx.x == 0 && threadIdx.x == 0) atomicAdd((unsigned long long*)(args.ws + WS_TS) + 1, (unsigned long long)(__builtin_amdgcn_s_memrealtime() - sp0_)); } while (0)
#define BOTH(k) (IN(k) && IN((k) + 1))
constexpr int BQ_LAG = 1;
DI void bq_run(const Args& args, unsigned char* lds, const int phase, const bool drain) {
    int tid = threadIdx.x; asm volatile("" : "+v"(tid)); GAS unsigned char* wsg_ = (GAS unsigned char*)args.ws; asm volatile("" : "+s"(wsg_)); unsigned char* ws = (unsigned char*)wsg_;
    LAS unsigned char* const L = (LAS unsigned char*)lds; const int lane = tid & 63, wave = __builtin_amdgcn_readfirstlane(tid >> 6), G = gridDim.x;
    gu32* const head = (gu32*)(ws + WS_CTL) + CW_BQ_HEAD; gu32* const arr = (gu32*)(ws + WS_CTL) + CW_ARR + 64 * phase;
    volatile LAS unsigned* const word = (volatile LAS unsigned*)(L + MISC_OFF) + 16;
    LAS float* const scr = (LAS float*)(L + RING_OFF + wave * 16384);
    if (tid == 0) (void)__hip_atomic_fetch_add(arr, 1u, RLX_AGENT);
    for (;;) {
        __syncthreads();
        if (tid == 0) { unsigned h = BQ_ITEMS;
            if ((drain || __hip_atomic_load(arr, RLX_AGENT) + BQ_LAG < (unsigned)G) && __hip_atomic_load(head, RLX_AGENT) < (unsigned)BQ_ITEMS) h = __hip_atomic_fetch_add(head, 8u, RLX_AGENT);
            *word = h; }
        __syncthreads();
        const int it = (int)*word + wave;
        if (it >= BQ_ITEMS) { if ((int)*word >= BQ_ITEMS) break; else continue; }
        if (it < BQ_I1) p0_transpose_item<false>(args.in[17], DM, DFF, (bf16*)(ws + WS_W1), scr, it, lane, args.in[16]);
        else p0_transpose_item<false>(args.in[18], DFF, DM, (bf16*)(ws + WS_W2), scr, it - BQ_I1, lane);
    }
}

template <int g> DI void mixer_half(const Args& args, unsigned char* lds, const int lo, const int hi) {
        const int pb = 1 + 5 * g;
        const int nbs = g ? 64 : 32, nseq = g ? 2 : 4;
        if (IN(pb)) {
            PH_BEGIN();
            pg8::Gemm gm{(const bf16*)(ws + WS_XN) + (size_t)g * HTOK * DM, (const bf16*)(ws + WS_WIN), HTOK, INW, DM, 0}; pg8::StaticOrder S; S.init(HTOK, INW, G, (int)blockIdx.x);
            pg8::EpiProj E{(bf16*)(ws + WS_PROJ), HTOK, (const float*)(ws + WS_COS), (const float*)(ws + WS_SIN), g ? 8191 : 4095};
            _Pragma("unroll 1") for (int rep = 0; rep < NREP(1); ++rep) pg8::gemm_phase<pg8::EpiProj, pg8::StaticOrder, PG8_ALIGN, PG8_SP2>(L + RING_OFF, gm, S, E);
            bq_run(args, lds, pb, false);
            if (BOTH(pb)) GRID_BAR(pb);
        }
        if (IN(pb + 1)) {
            SPAN_T0(pb + 1);
          _Pragma("unroll 1") for (int rep = 0; rep < NREP(2); ++rep) {
            PH_BEGIN();
            bf16* const PROJ = (bf16*)(ws + WS_PROJ);
            const bool flip = (((int)blockIdx.x >> 3) & 1) != 0;
            if (!flip) {
                ret_kv_phase(L, PROJ, (bf16*)(ws + WS_ST), args.in[6], args.in[7], tid, G);
                __syncthreads();
                attn_phase<true, g>(L, PROJ, PJ(PROJ, 80, 0), PJ(PROJ, 84, 0), (bf16*)(ws + WS_Y), (const float*)(ws + WS_TB), args.in[8], tid, (int)blockIdx.x, G, 1024);
            } else {
                attn_phase<true, g>(L, PROJ, PJ(PROJ, 80, 0), PJ(PROJ, 84, 0), (bf16*)(ws + WS_Y), (const float*)(ws + WS_TB), args.in[8], tid, (int)blockIdx.x, G, 1024);
                __syncthreads();
                int tid2 = threadIdx.x; asm volatile("" : "+v"(tid2));
                ret_kv_phase(L, PROJ, (bf16*)(ws + WS_ST), args.in[6], args.in[7], tid2, G);
            }
          }
            bq_run(args, lds, pb + 1, false);
            if (BOTH(pb + 1)) GRID_BAR(pb + 1);
            SPAN_T1(pb + 1);
        }
        if (IN(pb + 2)) {
            SPAN_T0(pb + 2);
            PH_BEGIN();
            if (g == 0) {
                if ((int)blockIdx.x >= G - 24) {
                    pg8::Gemm gm{(const bf16*)(ws + WS_MEMN), (const bf16*)(ws + WS_WCKV), NMEM, 2 * MEMW, DM, 0}; pg8::StaticOrder S; S.init(NMEM, 2 * MEMW, 24, (int)blockIdx.x - (G - 24));
                    pg8::EpiBf16S<0, false> E{(bf16*)(ws + WS_KVM), 2 * MEMW, 1.0f, nullptr};
                    pg8::gemm_phase<pg8::EpiBf16S<0, false>, pg8::StaticOrder, PG8_ALIGN, PG8_SP2>(L + RING_OFF, gm, S, E);
                } else ret_scan((bf16*)(ws + WS_ST), nseq, nbs, args.in[6], args.in[7], blockIdx.x * NTHREADS + tid, (G - 24) * NTHREADS);
            } else ret_scan((bf16*)(ws + WS_ST), nseq, nbs, args.in[6], args.in[7], blockIdx.x * NTHREADS + tid, G * NTHREADS);
            bq_run(args, lds, pb + 2, false);
            if (BOTH(pb + 2)) GRID_BAR(pb + 2);
            SPAN_T1(pb + 2);
        }
        if (IN(pb + 3)) {
            SPAN_T0(pb + 3);
          _Pragma("unroll 1") for (int rep = 0; rep < NREP(4); ++rep) {
            PH_BEGIN();
            ret_out_phase(L, (const bf16*)(ws + WS_PROJ), (bf16*)(ws + WS_Y), (const bf16*)(ws + WS_ST), args.in[6], args.in[7], tid, G);
          }
            bq_run(args, lds, pb + 3, false);
            if (BOTH(pb + 3)) GRID_BAR(pb + 3);
            SPAN_T1(pb + 3);
        }
        if (IN(pb + 4)) {
            PH_BEGIN();
            pg8::Gemm gm{(const bf16*)(ws + WS_Y), (const bf16*)(ws + WS_WOUT), HTOK, DM, DM, 0}; pg8::StaticOrder S; S.init(HTOK, DM, G, (int)blockIdx.x);
            if (NREP(5) > 1) { pg8::EpiResB<true> E2{args.in[g], nullptr, (bf16*)(ws + WS_PROBE5), DM, (float*)(ws + WS_PROBE_SS)}; pg8::gemm_phase<pg8::EpiResB<true>, pg8::StaticOrder, PG8_ALIGN, PG8_SP2>(L + RING_OFF, gm, S, E2); }
            pg8::EpiResB<true> E{args.in[g], nullptr, (bf16*)(ws + WS_XN) + (size_t)g * HTOK * DM, DM, (float*)(ws + WS_SS) + g * HTOK};
            pg8::gemm_phase<pg8::EpiResB<true>, pg8::StaticOrder, PG8_ALIGN, PG8_SP2>(L + RING_OFF, gm, S, E);
            if (g == 1) bq_run(args, lds, pb + 4, false);
            if (g == 1 && BOTH(pb + 4)) GRID_BAR(pb + 4);
        }
}

__global__ void __launch_bounds__(NTHREADS, 2) hymba_fwd(Args args) {
    extern __shared__ __attribute__((aligned(16))) unsigned char lds[];
    {
        const int t0 = threadIdx.x;
        for (int u = t0; u < (LDS_BYTES - LDSCTL_OFF) / 4; u += NTHREADS) ((LAS unsigned*)((LAS unsigned char*)lds + LDSCTL_OFF))[u] = 0u;
        __syncthreads();
        if (N_LAUNCHES == 1) (void)xcd_barrier_post((unsigned*)(args.ws + WS_CTL) + CW_BAR, (volatile LAS unsigned*)((LAS unsigned char*)lds + MISC_OFF) + 8);
    }
    const int lo = args.ph_lo, hi = args.ph_hi;

    if (IN(0)) {
        SPAN_T0(0);
      _Pragma("unroll 1") for (int rep = 0; rep < NREP(0); ++rep) {
        PH_BEGIN();
        const int gw = vcu * NWAVES + wave, NGW = G * NWAVES, gtid = blockIdx.x * NTHREADS + tid, NT = G * NTHREADS;
        LAS float* scr = (LAS float*)(L + RING_OFF + wave * 16384);
        constexpr int I_IN = (DM / 64) * (INW / 32), I_OUT = (DM / 64) * (DM / 32), I_CQ = (DM / 64) * (MEMW / 32), I_CKV = (DM / 64) * (2 * MEMW / 32), I_CO = (MEMW / 64) * (DM / 32);
        constexpr int NITEMS = I_IN + I_OUT + I_CQ + I_CKV + I_CO;
        for (int it = gw; it < NITEMS; it += NGW) {
            int r = it;
            if (r < I_IN) { p0_transpose_item<true>(args.in[5], DM, INW, (bf16*)(ws + WS_WIN), scr, r, lane); continue; } r -= I_IN;
            if (r < I_OUT) { p0_transpose_item<false>(args.in[10], DM, DM, (bf16*)(ws + WS_WOUT), scr, r, lane); continue; } r -= I_OUT;
            if (r < I_CQ) { p0_transpose_item<false>(args.in[13], DM, MEMW, (bf16*)(ws + WS_WCQ), scr, r, lane, args.in[11]); continue; } r -= I_CQ;
            if (r < I_CKV) { p0_transpose_item<false>(args.in[14], DM, 2 * MEMW, (bf16*)(ws + WS_WCKV), scr, r, lane); continue; } r -= I_CKV;
            p0_transpose_item<false>(args.in[15], MEMW, DM, (bf16*)(ws + WS_WCO), scr, r, lane);
        }
        float* const COS = (float*)(ws + WS_COS); float* const SIN = (float*)(ws + WS_SIN); float* const TB = (float*)(ws + WS_TB);
        for (int e = gtid; e < 8192 * 64; e += NT) { const int pos = e >> 6, i = e & 63;
            const float inv = exp2f(-(float)i * (13.287712379549449f / 64.0f));
            const float ang = (float)pos * inv;
            double rev = (double)ang * 0.15915494309189535; rev -= floor(rev);
            const float rf = (float)rev;
            COS[e] = __builtin_amdgcn_cosf(rf); SIN[e] = __builtin_amdgcn_sinf(rf); }
        for (int e = gtid; e < 16 * TBW; e += NT) { const int hh = e / TBW, idx = e % TBW; const int rel = idx - 128;
            TB[e] = (idx <= 256) ? args.in[9][t5_bucket(rel) * 16 + hh] * LOG2E : 0.f; }
        bf16* const XN = (bf16*)(ws + WS_XN);
        for (int m = gw; m < NTOK; m += NGW) { const float* src = (m < HTOK) ? args.in[0] + (size_t)m * DM : args.in[1] + (size_t)(m - HTOK) * DM; rms_row_to_bf16(src, args.in[4], XN + (size_t)m * DM, lane); }
        for (int m = gw; m < NMEM; m += NGW) { const float* src = (m < 1024) ? args.in[2] + (size_t)m * DM : args.in[3] + (size_t)(m - 1024) * DM; rms_row_to_bf16(src, args.in[12], (bf16*)(ws + WS_MEMN) + (size_t)m * DM, lane); }
      }
        if (BOTH(0)) GRID_BAR(0);
        SPAN_T1(0);
    }

    mixer_half<0>(args, lds, lo, hi);
    mixer_half<1>(args, lds, lo, hi);

    if (IN(11)) {
        SPAN_T0(11);
        PH_BEGIN();
        pg8::Gemm gm{(const bf16*)(ws + WS_XN), (const bf16*)(ws + WS_WCQ), NTOK, MEMW, DM, 0}; pg8::StaticOrder S; S.init(NTOK, MEMW, G, (int)blockIdx.x);
        pg8::EpiBf16S<0, true> E{(bf16*)(ws + WS_QC), MEMW, 0.12751743074602224f, (const float*)(ws + WS_SS)};
        _Pragma("unroll 1") for (int rep = 0; rep < NREP(11); ++rep) pg8::gemm_phase<pg8::EpiBf16S<0, true>, pg8::StaticOrder, PG8_ALIGN, PG8_SP2>(L + RING_OFF, gm, S, E);
        __builtin_amdgcn_fence(__ATOMIC_ACQUIRE, "agent"); asm volatile("s_waitcnt vmcnt(0)" ::: "memory"); __syncthreads();
        const bf16* KVM = (const bf16*)(ws + WS_KVM);
        int tid2 = threadIdx.x; asm volatile("" : "+v"(tid2));
        pg8::Unit uu;
        _Pragma("unroll 1") for (int i = 0; S.next(i, uu); ++i) { const int ua = 4 * uu.pm + 2 * uu.pn;
            attn_phase<false, 0>(L, (const bf16*)(ws + WS_QC), KVM, KVM + MEMW, (bf16*)(ws + WS_OC), nullptr, nullptr, tid2, ua, 1, ua + 2); __syncthreads(); }
        bq_run(args, lds, 11, false);
        if (BOTH(11)) GRID_BAR(11);
        SPAN_T1(11);
    }
    if (IN(12)) {
        PH_BEGIN();
        pg8::Gemm gm{(const bf16*)(ws + WS_OC), (const bf16*)(ws + WS_WCO), NTOK, DM, MEMW, 0}; pg8::StaticOrder S; S.init(NTOK, DM, G, (int)blockIdx.x);
        if (NREP(12) > 1) { pg8::EpiResB<false> E2{nullptr, (const bf16*)(ws + WS_XN), (bf16*)(ws + WS_PROBE13), DM, (float*)(ws + WS_PROBE_SS)}; pg8::gemm_phase<pg8::EpiResB<false>, pg8::StaticOrder, PG8_ALIGN, PG8_SP2>(L + RING_OFF, gm, S, E2); }
        pg8::EpiResB<false> E{nullptr, (const bf16*)(ws + WS_XN), (bf16*)(ws + WS_XN), DM, (float*)(ws + WS_SS) + NTOK};
        pg8::gemm_phase<pg8::EpiResB<false>, pg8::StaticOrder, PG8_ALIGN, PG8_SP2>(L + RING_OFF, gm, S, E);
        bq_run(args, lds, 12, true);
        if (BOTH(12)) GRID_BAR(12);
    }
    constexpr int MTOK = NTOK / MLPG;
#pragma unroll
    for (int g = 0; g < MLPG; ++g) {
        if (IN(13 + 2 * g)) {
            PH_BEGIN();
            pg8::Gemm gm{(const bf16*)(ws + WS_XN) + (size_t)g * MTOK * DM, (const bf16*)(ws + WS_W1), MTOK, DFF, DM, 0}; pg8::StaticOrder S; S.init(MTOK, DFF, G, (int)blockIdx.x);
            pg8::EpiBf16S<1, true> E{(bf16*)(ws + WS_HID) + (size_t)(g & 1) * MTOK * DFF, DFF, 1.0f, (const float*)(ws + WS_SS) + NTOK + g * MTOK};
            _Pragma("unroll 1") for (int rep = 0; rep < NREP(13); ++rep) pg8::gemm_phase<pg8::EpiBf16S<1, true>, pg8::StaticOrder, PG8_ALIGN, PG8_SP2>(L + RING_OFF, gm, S, E);
            if (BOTH(13 + 2 * g)) GRID_BAR(13 + 2 * g);
        }
        if (IN(14 + 2 * g)) {
            PH_BEGIN();
            pg8::Gemm gm{(const bf16*)(ws + WS_HID) + (size_t)(g & 1) * MTOK * DFF, (const bf16*)(ws + WS_W2), MTOK, DM, DFF, 1}; pg8::StaticOrder S; S.init(MTOK, DM, G, (int)blockIdx.x, 1);
            if (NREP(14) > 1) { pg8::EpiResB<false> E2{nullptr, (const bf16*)(ws + WS_XN) + (size_t)g * MTOK * DM, (bf16*)(ws + WS_PROBE15), DM, (float*)(ws + WS_PROBE_SS)}; pg8::gemm_phase<pg8::EpiResB<false>, pg8::StaticOrder, PG8_ALIGN, PG8_SP2>(L + RING_OFF, gm, S, E2); }
            pg8::EpiResB<false> E{nullptr, (const bf16*)(ws + WS_XN) + (size_t)g * MTOK * DM, (bf16*)(ws + WS_XN) + (size_t)g * MTOK * DM, DM, (float*)(ws + WS_SS) + 2 * NTOK + g * MTOK};
            pg8::gemm_phase<pg8::EpiResB<false>, pg8::StaticOrder, PG8_ALIGN, PG8_SP2>(L + RING_OFF, gm, S, E);
            if (BOTH(14 + 2 * g) && (N_LAUNCHES != 1 || g == MLPG - 1)) GRID_BAR(14 + 2 * g);
        }
    }
    SPAN_T0(13 + 2 * MLPG);
    if (IN(13 + 2 * MLPG)) {
        PH_BEGIN();
        const bool poison = (N_LAUNCHES == 1) && (__hip_atomic_load((gu32*)((unsigned*)(ws + WS_CTL) + CW_BAR + XB_TMO), RLX_AGENT) != 0u);
        const int gw = vcu * NWAVES + wave, NGW = G * NWAVES; float* const o = args.out; const bf16* const X = (const bf16*)(ws + WS_XN); const float* const ss3 = (const float*)(ws + WS_SS) + 2 * NTOK;
        _Pragma("unroll 1") for (int rep = 0; rep < NREP(13 + 2 * MLPG); ++rep) for (int m = gw; m < NTOK; m += NGW) final_row(X + (size_t)m * DM, ss3[m], args.in[19], o + (size_t)m * DM, lane, poison);
    }
    if (PROBE_KIND != 0 && N_LAUNCHES == 1) {
        SPAN_T1(13 + 2 * MLPG);
        __syncthreads();
        if (blockIdx.x == 0 && threadIdx.x == 0) {
            const unsigned long long* ts = (const unsigned long long*)(args.ws + WS_TS);
            unsigned long long q = (PROBE_KIND == 1) ? __hip_atomic_load(ts, RLX_AGENT) / gridDim.x : __hip_atomic_load(ts + 1, RLX_AGENT);
            const unsigned long long t0 = __builtin_amdgcn_s_memrealtime(), want = q * PROBE_K;
            while (__builtin_amdgcn_s_memrealtime() - t0 < want) __builtin_amdgcn_s_sleep(8);
        }
        __syncthreads();
    }
#undef IN
#undef BOTH
}

extern "C" void kernel_launch(void* const* d_in, const int* in_sizes, int n_in, void* d_out, int out_size, void* d_ws, size_t ws_size, hipStream_t stream) {
    static int grid = 0;
    if (grid == 0) {
        if (n_in != 20 || out_size != NTOK * DM || ws_size < WS_END) { fprintf(stderr, "kernel_launch: shape/workspace mismatch (n_in %d, out %d, ws %zu, need %zu); nothing launched\n", n_in, out_size, ws_size, (size_t)WS_END); grid = -1; return; }
        int dev = 0, cus = 0, per_cu = 0;
        if (hipGetDevice(&dev) != hipSuccess || hipDeviceGetAttribute(&cus, hipDeviceAttributeMultiprocessorCount, dev) != hipSuccess) { grid = -1; return; }
        if (hipFuncSetAttribute((const void*)hymba_fwd, hipFuncAttributeMaxDynamicSharedMemorySize, LDS_BYTES) != hipSuccess) { fprintf(stderr, "kernel_launch: hipFuncSetAttribute failed\n"); grid = -1; return; }
        if (hipOccupancyMaxActiveBlocksPerMultiprocessor(&per_cu, (const void*)hymba_fwd, NTHREADS, LDS_BYTES) != hipSuccess || per_cu < 1)
            fprintf(stderr, "kernel_launch: note: occupancy query reports %d workgroups per CU\n", per_cu);
        (void)hipGetLastError();
        grid = cus;
    }
    if (grid < 0) return;
    if (hipMemsetAsync((char*)d_ws + WS_CTL, 0, CTL_ZERO_BYTES, stream) != hipSuccess) return;
    Args a{};
    for (int i = 0; i < 20; ++i) a.in[i] = (const float*)d_in[i];
    a.out = (float*)d_out; a.ws = (unsigned char*)d_ws; a.pad = 0;
    for (int li = 0; li < N_LAUNCHES; ++li) {
        a.ph_lo = (N_LAUNCHES == 1) ? 0 : li; a.ph_hi = (N_LAUNCHES == 1) ? NPHASE : li + 1; a.li = li;
        hipLaunchKernelGGL(hymba_fwd, dim3(grid), dim3(NTHREADS), LDS_BYTES, stream, a);
        const hipError_t le = hipPeekAtLastError();
        if (le != hipSuccess) { fprintf(stderr, "kernel_launch: launch %d failed: %s\n", li, hipGetErrorName(le)); break; }
    }
}
```
